# Optimizing an MI355X kernel written in HIP

```python
import jax, jax.numpy as jnp
from jax import lax
import numpy as np

D_MODEL = 1024
BATCH = 4
SEQ = 4096
DEPTH = 4

CHUNK = 64
N_EVEN = (DEPTH + 1) // 2
N_ODD = DEPTH // 2
EPS = 1e-6

POOL_GROUPS = 4
POOL_CH = D_MODEL // 8
POOL_WIDTH = POOL_GROUPS * POOL_CH
POOL_WINDOWS = (2, 4, 8, 16)

MLA_HEADS = 8
MLA_NOPE = D_MODEL // 16
MLA_ROPE = D_MODEL // 32
MLA_V = D_MODEL // 16
MLA_Q_RANK = D_MODEL // 4
MLA_KV_RANK = D_MODEL // 8
ROPE_THETA = 10000.0
Q_BLOCK = 128
EVEN_IN = POOL_WIDTH + MLA_Q_RANK + MLA_KV_RANK + MLA_ROPE
EVEN_MIX = POOL_WIDTH + MLA_HEADS * MLA_V

CA_HEADS = 8
CA_HEAD_DIM = D_MODEL // 16
CA_LEFT_CHUNKS = 8
REL_CLIP = 128

SGU_GROUPS = 4
SGU_CH = D_MODEL // 8
SGU_WIDTH = SGU_GROUPS * SGU_CH
SGU_CHUNK = 128
ODD_IN = 3 * CA_HEADS * CA_HEAD_DIM + 2 * SGU_WIDTH
ODD_MIX = CA_HEADS * CA_HEAD_DIM + SGU_WIDTH

D_FF = 2816
N_EXPERTS = 8
TOP_K = 2
EXPERT_FF = 3584

kernel_name = 'hybrid_chunk_causal_pool_mla_relattn_sgu_moe'


def rms_norm(x, g):
    xf = x.astype(jnp.float32)
    y = xf * lax.rsqrt(jnp.mean(xf * xf, axis=-1, keepdims=True) + EPS)
    return (y * g.astype(jnp.float32)).astype(x.dtype)


def layer_norm(x, g, b):
    xf = x.astype(jnp.float32)
    mu = jnp.mean(xf, axis=-1, keepdims=True)
    xc = xf - mu
    y = xc * lax.rsqrt(jnp.mean(xc * xc, axis=-1, keepdims=True) + EPS)
    return (y * g.astype(jnp.float32) + b.astype(jnp.float32)).astype(x.dtype)


def swiglu(x, w_gate, w_up, w_down):
    return (jax.nn.silu(x @ w_gate) * (x @ w_up)) @ w_down


def rope_tables(s):
    inv = 1.0 / (ROPE_THETA ** (jnp.arange(0, MLA_ROPE, 2, dtype=jnp.float32) / MLA_ROPE))
    ang = jnp.arange(s, dtype=jnp.float32)[:, None] * inv[None, :]
    return jnp.cos(ang), jnp.sin(ang)


def apply_rope(x, cos, sin):
    x1, x2 = jnp.split(x, 2, axis=-1)
    return jnp.concatenate([x1 * cos - x2 * sin, x2 * cos + x1 * sin], axis=-1).astype(x.dtype)


def multiscale_pool(a, w_pool, scale):
    b, s, g, c = a.shape
    af = a.astype(jnp.float32)
    cs = jnp.concatenate([jnp.zeros((b, 1, g, c), jnp.float32), jnp.cumsum(af, axis=1)], axis=1)
    t = jnp.arange(s)[:, None]
    win = jnp.array(POOL_WINDOWS, dtype=jnp.int32)[None, :]
    lo = jnp.maximum(t + 1 - win, 0)
    lo_sum = cs[:, lo, jnp.arange(g)[None, :]]
    count = (t + 1 - lo).astype(jnp.float32)[None, :, :, None]
    pooled = ((cs[:, 1:] - lo_sum) / count - af).astype(a.dtype)
    y = jnp.einsum('bsgc,gcd->bsgd', pooled, w_pool) * scale
    return y.reshape(b, s, g * c)


def mla_attention(q, k, v):
    b, s, h, dq = q.shape
    nqb = s // Q_BLOCK
    scale = dq ** -0.5
    k_chunk = jnp.arange(s) // CHUNK
    q_blocks = q.reshape(b, nqb, Q_BLOCK, h, dq).transpose(1, 0, 2, 3, 4)

    def block(args):
        qb, start = args
        q_chunk = (start + jnp.arange(Q_BLOCK)) // CHUNK
        sc = jnp.einsum('bqhd,bkhd->bhqk', qb, k, preferred_element_type=jnp.float32) * scale
        sc = jnp.where(k_chunk[None, :] <= q_chunk[:, None], sc, -jnp.inf)
        p = jax.nn.softmax(sc, axis=-1).astype(v.dtype)
        return jnp.einsum('bhqk,bkhd->bqhd', p, v)

    out = lax.map(block, (q_blocks, jnp.arange(nqb) * Q_BLOCK))
    return out.transpose(1, 0, 2, 3, 4).reshape(b, s, h, v.shape[-1])


def chunk_band_attention(q, k, v, rel_bias):
    b, s, h, d = q.shape
    nc = s // CHUNK
    band = (CA_LEFT_CHUNKS + 1) * CHUNK
    qc = q.reshape(b, nc, CHUNK, h, d)

    def gather_band(t):
        tp = jnp.pad(t.reshape(b, nc, CHUNK, h, d), ((0, 0), (CA_LEFT_CHUNKS, 0), (0, 0), (0, 0), (0, 0)))
        return jnp.concatenate([tp[:, j:j + nc] for j in range(CA_LEFT_CHUNKS + 1)], axis=2)

    kb, vb = gather_band(k), gather_band(v)
    sc = jnp.einsum('bnqhd,bnkhd->bhnqk', qc, kb, preferred_element_type=jnp.float32) * (d ** -0.5)
    rel = jnp.arange(CHUNK)[:, None] + CA_LEFT_CHUNKS * CHUNK - jnp.arange(band)[None, :]
    bias = rel_bias[:, jnp.clip(rel, -REL_CLIP, REL_CLIP) + REL_CLIP].astype(jnp.float32)
    valid = (jnp.arange(nc)[:, None] - CA_LEFT_CHUNKS + jnp.arange(band)[None, :] // CHUNK) >= 0
    sc = jnp.where(valid[None, None, :, None, :], sc + bias[:, None], -jnp.inf)
    p = jax.nn.softmax(sc, axis=-1).astype(vb.dtype)
    out = jnp.einsum('bhnqk,bnkhd->bnqhd', p, vb)
    return out.reshape(b, s, h, d)


def spatial_gating(u, v, norm_g, norm_b, w_s, b_s):
    b, s, g, c = v.shape
    n = s // SGU_CHUNK
    vn = layer_norm(v, norm_g, norm_b).reshape(b, n, SGU_CHUNK, g, c)
    causal = jnp.tril(jnp.ones((SGU_CHUNK, SGU_CHUNK), dtype=bool))
    w = jnp.where(causal[None], w_s, jnp.zeros_like(w_s))
    mixed = jnp.einsum('gts,bnsgc->bntgc', w, vn) + b_s.T[None, None, :, :, None]
    return u * mixed.reshape(b, s, g, c)


def moe_swiglu(h, router, w_gate, w_up, w_down):
    b, s, d = h.shape
    t = h.reshape(b * s, d)
    logits = (t @ router).astype(jnp.float32)
    top_val, top_idx = lax.top_k(logits, TOP_K)
    top_w = jax.nn.softmax(top_val, axis=-1)
    gates = jnp.sum(jax.nn.one_hot(top_idx, N_EXPERTS, dtype=jnp.float32) * top_w[..., None], axis=1)
    out = jnp.zeros((b * s, d), jnp.float32)
    for e in range(N_EXPERTS):
        out = out + gates[:, e:e + 1] * swiglu(t, w_gate[e], w_up[e], w_down[e]).astype(jnp.float32)
    return out.astype(h.dtype).reshape(b, s, d)


def even_mixer(h, w_in, pool_w, pool_scale, q_norm, w_q_up, kv_norm, w_kv_up, w_out, cos, sin):
    b, s, _ = h.shape
    z = h @ w_in
    a, cq, ckv, kr = jnp.split(z, [POOL_WIDTH, POOL_WIDTH + MLA_Q_RANK, POOL_WIDTH + MLA_Q_RANK + MLA_KV_RANK], axis=-1)
    pool = multiscale_pool(a.reshape(b, s, POOL_GROUPS, POOL_CH), pool_w, pool_scale)
    q = (rms_norm(cq, q_norm) @ w_q_up).reshape(b, s, MLA_HEADS, MLA_NOPE + MLA_ROPE)
    q_nope, q_rope = jnp.split(q, [MLA_NOPE], axis=-1)
    kv = (rms_norm(ckv, kv_norm) @ w_kv_up).reshape(b, s, MLA_HEADS, MLA_NOPE + MLA_V)
    k_nope, v = jnp.split(kv, [MLA_NOPE], axis=-1)
    q_rope = apply_rope(q_rope, cos[None, :, None], sin[None, :, None])
    k_rope = apply_rope(kr, cos[None], sin[None])
    qf = jnp.concatenate([q_nope, q_rope], axis=-1)
    kf = jnp.concatenate([k_nope, jnp.broadcast_to(k_rope[:, :, None], (b, s, MLA_HEADS, MLA_ROPE))], axis=-1)
    att = mla_attention(qf, kf, v).reshape(b, s, MLA_HEADS * MLA_V)
    return jnp.concatenate([pool, att], axis=-1) @ w_out


def odd_mixer(h, w_in, rel_bias, sgu_norm_g, sgu_norm_b, sgu_w, sgu_b, w_out):
    b, s, _ = h.shape
    z = h @ w_in
    qkv, uv = jnp.split(z, [3 * CA_HEADS * CA_HEAD_DIM], axis=-1)
    q, k, v = [t.reshape(b, s, CA_HEADS, CA_HEAD_DIM) for t in jnp.split(qkv, 3, axis=-1)]
    att = chunk_band_attention(q, k, v, rel_bias).reshape(b, s, CA_HEADS * CA_HEAD_DIM)
    u, gv = jnp.split(jax.nn.gelu(uv), 2, axis=-1)
    sg = spatial_gating(u.reshape(b, s, SGU_GROUPS, SGU_CH), gv.reshape(b, s, SGU_GROUPS, SGU_CH),
                        sgu_norm_g, sgu_norm_b, sgu_w, sgu_b).reshape(b, s, SGU_WIDTH)
    return jnp.concatenate([att, sg], axis=-1) @ w_out


def setup_inputs(seed: int = 0) -> dict:
    key = jax.random.key(seed)
    ks = iter(jax.random.split(key, 32))
    nrm = lambda shape, scale: jax.random.normal(next(ks), shape, jnp.float32) * scale
    gain = lambda shape: 1.0 + nrm(shape, 0.1)
    E, O, D = N_EVEN, N_ODD, D_MODEL
    res = (2 * DEPTH) ** -0.5
    return {
        'x': nrm((BATCH, SEQ, D), 1.0),
        'ev_norm_mix': gain((E, D)),
        'ev_w_in': nrm((E, D, EVEN_IN), D ** -0.5),
        'ev_pool_w': nrm((E, POOL_GROUPS, POOL_CH, POOL_CH), POOL_CH ** -0.5),
        'ev_pool_scale': gain((E, POOL_GROUPS, POOL_CH)),
        'ev_q_norm': gain((E, MLA_Q_RANK)),
        'ev_w_q_up': nrm((E, MLA_Q_RANK, MLA_HEADS * (MLA_NOPE + MLA_ROPE)), MLA_Q_RANK ** -0.5),
        'ev_kv_norm': gain((E, MLA_KV_RANK)),
        'ev_w_kv_up': nrm((E, MLA_KV_RANK, MLA_HEADS * (MLA_NOPE + MLA_V)), MLA_KV_RANK ** -0.5),
        'ev_w_out': nrm((E, EVEN_MIX, D), EVEN_MIX ** -0.5 * res),
        'ev_norm_ffn': gain((E, D)),
        'ev_ffn_w_gate': nrm((E, D, D_FF), D ** -0.5),
        'ev_ffn_w_up': nrm((E, D, D_FF), D ** -0.5),
        'ev_ffn_w_down': nrm((E, D_FF, D), D_FF ** -0.5 * res),
        'od_norm_mix': gain((O, D)),
        'od_w_in': nrm((O, D, ODD_IN), D ** -0.5),
        'od_rel_bias': nrm((O, CA_HEADS, 2 * REL_CLIP + 1), 0.5),
        'od_sgu_norm_g': gain((O, SGU_GROUPS, SGU_CH)),
        'od_sgu_norm_b': nrm((O, SGU_GROUPS, SGU_CH), 0.02),
        'od_sgu_w': nrm((O, SGU_GROUPS, SGU_CHUNK, SGU_CHUNK), SGU_CHUNK ** -0.5),
        'od_sgu_b': gain((O, SGU_GROUPS, SGU_CHUNK)),
        'od_w_out': nrm((O, ODD_MIX, D), ODD_MIX ** -0.5 * res),
        'od_norm_ffn': gain((O, D)),
        'od_router': nrm((O, D, N_EXPERTS), D ** -0.5),
        'od_moe_w_gate': nrm((O, N_EXPERTS, D, EXPERT_FF), D ** -0.5),
        'od_moe_w_up': nrm((O, N_EXPERTS, D, EXPERT_FF), D ** -0.5),
        'od_moe_w_down': nrm((O, N_EXPERTS, EXPERT_FF, D), EXPERT_FF ** -0.5 * res),
        'final_norm': gain((D,)),
    }


def reference(x, ev_norm_mix, ev_w_in, ev_pool_w, ev_pool_scale, ev_q_norm, ev_w_q_up, ev_kv_norm,
              ev_w_kv_up, ev_w_out, ev_norm_ffn, ev_ffn_w_gate, ev_ffn_w_up, ev_ffn_w_down,
              od_norm_mix, od_w_in, od_rel_bias, od_sgu_norm_g, od_sgu_norm_b, od_sgu_w, od_sgu_b,
              od_w_out, od_norm_ffn, od_router, od_moe_w_gate, od_moe_w_up, od_moe_w_down, final_norm):
    cos, sin = rope_tables(x.shape[1])
    for layer in range(DEPTH):
        i = layer // 2
        if layer % 2 == 0:
            h = rms_norm(x, ev_norm_mix[i])
            x = x + even_mixer(h, ev_w_in[i], ev_pool_w[i], ev_pool_scale[i], ev_q_norm[i], ev_w_q_up[i],
                               ev_kv_norm[i], ev_w_kv_up[i], ev_w_out[i], cos, sin)
            h = rms_norm(x, ev_norm_ffn[i])
            x = x + swiglu(h, ev_ffn_w_gate[i], ev_ffn_w_up[i], ev_ffn_w_down[i])
        else:
            h = rms_norm(x, od_norm_mix[i])
            x = x + odd_mixer(h, od_w_in[i], od_rel_bias[i], od_sgu_norm_g[i], od_sgu_norm_b[i],
                              od_sgu_w[i], od_sgu_b[i], od_w_out[i])
            h = rms_norm(x, od_norm_ffn[i])
            x = x + moe_swiglu(h, od_router[i], od_moe_w_gate[i], od_moe_w_up[i], od_moe_w_down[i])
    return rms_norm(x, final_norm)
```

```cpp
#include <hip/hip_runtime.h>
#include <cstdio>
#include <cstdint>

#ifndef MK_N_LAUNCHES
#define MK_N_LAUNCHES 0
#endif

#define LAS __attribute__((address_space(3)))
#define GAS __attribute__((address_space(1)))
typedef unsigned short bf16_t;
typedef short bf16x8 __attribute__((ext_vector_type(8)));
typedef short s16x4 __attribute__((ext_vector_type(4)));
typedef float f32x4 __attribute__((ext_vector_type(4)));
typedef float f32x2 __attribute__((ext_vector_type(2)));
typedef float f32x16 __attribute__((ext_vector_type(16)));
typedef unsigned u32x4 __attribute__((ext_vector_type(4)));
typedef unsigned u32x2 __attribute__((ext_vector_type(2)));

constexpr int NTOK = 16384, DM = 1024, SEQ = 4096;
constexpr float EPS = 1e-6f;
constexpr float LOG2E = 1.4426950408889634f;
constexpr float QS_MLA = 0.10206207261596575f * LOG2E;
constexpr float QS_BAND = 0.125f * LOG2E;
constexpr int FF = 2816, EFF = 3584, NEXP = 8;
constexpr int MOE_ROWS = 34816;

constexpr size_t MiB = 1u << 20, KiB = 1024;
constexpr size_t WS_CTL = 0, CTL_ZERO_BYTES = 3 * MiB;
constexpr int CW_TMO = 0, CW_CNT = 64, CW_BAR = 4096;
constexpr size_t WS_SSQ = 1 * MiB;
constexpr size_t WS_TAB = 3 * MiB;
constexpr size_t T_COS = WS_TAB, T_SIN = WS_TAB + 256 * KiB, T_RQ = WS_TAB + 512 * KiB, T_RKV = WS_TAB + 576 * KiB, T_TE = WS_TAB + 640 * KiB,
                 T_TP = WS_TAB + 704 * KiB, T_TW = WS_TAB + 832 * KiB, T_PAIR = WS_TAB + 960 * KiB, T_DGATE = WS_TAB + 1088 * KiB, T_DRS = WS_TAB + 1280 * KiB;
constexpr size_t WS_W = 5 * MiB;
constexpr size_t E_WIN = 0, E_WQ = 1048576, E_WKV = 1245184, E_WOUT = 1507328, E_WGU = 2555904, E_WDN = 8323072, E_SIZE = 11206656;
constexpr size_t O_WIN = 0, O_WOUT = 2621440, O_WGU = 3670016, O_WDN = 62390272, O_SIZE = 91750400;
constexpr size_t WS_WE = WS_W, WS_WO = WS_W + 2 * E_SIZE * 2;
static_assert(WS_WO + 2 * O_SIZE * 2 <= 400 * MiB, "weights");
constexpr size_t WS_XB = 400 * MiB;
constexpr size_t WS_R = 432 * MiB;
constexpr size_t R_Z = WS_R, R_Q = WS_R + 32 * MiB, R_K = WS_R + 56 * MiB, R_V = WS_R + 80 * MiB, R_MIX = WS_R + 96 * MiB, R_ACT = WS_R;
constexpr size_t R_QKV = WS_R, R_UV = WS_R + 48 * MiB, R_HS = WS_R, R_ACT2 = WS_R + 68 * MiB, R_Y = WS_R;
constexpr size_t WS_END = WS_R + 306 * MiB;
static_assert((size_t)MOE_ROWS * EFF * 2 <= 238 * MiB && (size_t)MOE_ROWS * 1024 * 2 <= 68 * MiB, "moe buffers");

constexpr int RING_BYTES = 131072, LDSCTL_OFF = RING_BYTES, MISC_OFF = LDSCTL_OFF + 320, LDS_BYTES = 147456;
constexpr int NWAVES = 8;

#define RLX_AGENT __ATOMIC_RELAXED, __HIP_MEMORY_SCOPE_AGENT
#define LDS_WAIT() asm volatile("s_waitcnt lgkmcnt(0)" ::: "memory")
#define VM_WAIT() asm volatile("s_waitcnt vmcnt(0)" ::: "memory")

__device__ __forceinline__ unsigned cvt_pk_bf16(float lo, float hi) { unsigned r; asm volatile("v_cvt_pk_bf16_f32 %0, %1, %2" : "=v"(r) : "v"(lo), "v"(hi)); return r; }
__device__ __forceinline__ float bf2f(unsigned short b) { return __uint_as_float(((unsigned)b) << 16); }
__device__ __forceinline__ float bflo(unsigned w) { return __uint_as_float(w << 16); }
__device__ __forceinline__ float bfhi(unsigned w) { return __uint_as_float(w & 0xffff0000u); }
__device__ __forceinline__ unsigned short f2bf(float f) { return (unsigned short)(cvt_pk_bf16(f, 0.f) & 0xffffu); }
__device__ __forceinline__ float wave_sum(float v) {
#pragma unroll
    for (int o = 1; o < 64; o <<= 1) v += __shfl_xor(v, o);
    return v;
}
typedef unsigned long long u64;
__device__ __forceinline__ u64 ssq_fix(float s) { return (u64)((double)s * 4294967296.0); }
__device__ __forceinline__ float ssq_get(const u64* p, int row) { return (float)((double)p[row] * (1.0 / 4294967296.0)); }
__device__ __forceinline__ float rstd_of(const u64* p, int row) { return rsqrtf(ssq_get(p, row) * (1.0f / DM) + EPS); }
__device__ __forceinline__ float fast_exp2(float x) { return __builtin_amdgcn_exp2f(x); }
__device__ __forceinline__ float fast_rcp(float x) { return __builtin_amdgcn_rcpf(x); }
__device__ __forceinline__ float sigmoidf_(float x) { return fast_rcp(1.0f + fast_exp2(-x * LOG2E)); }

__device__ __forceinline__ int opaque_tid() { int t = threadIdx.x; asm volatile("" : "+v"(t)); return t; }

namespace pg8 {
constexpr int BM = 256, BK = 64, HALF = 128, HTB = HALF * BK * 2, STAGE_BYTES = 8 * HTB, NXCD = 8, WGM = 8;
__host__ __device__ __forceinline__ int lds_byte(int r, int c) { const int st = (r >> 4) * 2 + (c >> 5), rr = r & 15, cc = c & 31, ob = rr * 64 + cc * 2; return st * 1024 + (ob ^ (((ob >> 9) & 1) << 5)); }
__host__ __device__ __forceinline__ void stage_rc(int b, int& R, int& C) { const int st = b / 1024, sb = b % 1024, swz = sb ^ (((sb >> 9) & 1) << 5); R = (st >> 1) * 16 + swz / 64; C = (st & 1) * 32 + (swz % 64) / 2; }
__host__ __device__ __forceinline__ int perm32(int rho) { const int n = rho >> 4, i = rho & 15; return 8 * (i >> 2) + 4 * n + (i & 3); }

struct Unit { int pm, pn; const char* a; const char* b; };
struct Gemm { int lda, ldb, K; };

__device__ __forceinline__ void tile_of(int L, int nM, int nN, int& pm, int& pn) {
    const int nwg = nM * nN;
    int wgid = L; { const int q = nwg / NXCD, r = nwg % NXCD, xcd = wgid % NXCD, off = wgid / NXCD; wgid = (xcd < r ? xcd * (q + 1) : r * (q + 1) + (xcd - r) * q) + off; }
    const int nig = WGM * nN, gid = wgid / nig, fm = gid * WGM, gsz = (nM - fm) < WGM ? (nM - fm) : WGM;
    pm = fm + ((wgid % nig) % gsz); pn = (wgid % nig) / gsz;
}
struct DenseOrder {
    const char* A; const char* Bt; int lda, ldb, nM, nN, G, c;
    __device__ __forceinline__ void init(const void* A_, int lda_, const void* Bt_, int ldb_, int M, int N, int G_, int c_) { A = (const char*)A_; Bt = (const char*)Bt_; lda = lda_; ldb = ldb_; nM = M / BM; nN = N / BM; G = G_; c = c_; }
    __device__ __forceinline__ bool next(int i, Unit& u) const {
        const long L = (long)i * G + c; if (L >= (long)nM * nN) return false;
        tile_of((int)L, nM, nN, u.pm, u.pn);
        u.a = A + (size_t)u.pm * BM * lda * 2; u.b = Bt + (size_t)u.pn * BM * ldb * 2; return true;
    }
};
struct MoeOrder {
    const char* A; const char* Bt; size_t bstride; int lda, ldb, nM, nN, G, c; int tend[8];
    __device__ __forceinline__ bool next(int i, Unit& u) const {
        const long L = (long)i * G + c; if (L >= (long)nM * nN) return false;
        tile_of((int)L, nM, nN, u.pm, u.pn);
        int e = 0;
#pragma unroll
        for (int k = 0; k < 7; ++k) e += (u.pm >= tend[k]) ? 1 : 0;
        u.a = A + (size_t)u.pm * BM * lda * 2; u.b = Bt + (size_t)e * bstride + (size_t)u.pn * BM * ldb * 2; return true;
    }
};

template <class Epi, class Sched, bool ALIGN_EPI = true>
__device__ __forceinline__ void gemm_phase(LAS unsigned char* lds, const Gemm g, const Sched& S, const Epi& E) {
    const int tid = opaque_tid(), wid = __builtin_amdgcn_readfirstlane(tid >> 6), lane = tid & 63, wr = wid >> 2, wc = wid & 3, fr = lane & 15, fq = lane >> 4;
    int K = g.K; asm volatile("" : "+s"(K));
    const int nt = K / BK;
    unsigned voffA[2], voffB[2];
#pragma unroll
    for (int i = 0; i < 2; ++i) { int R, C; stage_rc(tid * 16 + i * 8192, R, C); const int Rb = Epi::PERM ? ((R & ~31) + perm32(R & 31)) : R;
        voffA[i] = (unsigned)(R * g.lda + C) * 2u; voffB[i] = (unsigned)(Rb * g.ldb + C) * 2u; }
    const size_t kstep = (size_t)(BK * 2);
    const size_t hstepA = (size_t)HALF * g.lda * 2, hstepB = (size_t)HALF * g.ldb * 2;
    const unsigned ldsw = (unsigned)wid * 1024u;
    const int aoff = lds_byte(wr * 64 + fr, fq * 8), boff = lds_byte(wc * 32 + fr, fq * 8);
#define PG8_SA(b, h) (((b) * 2 + (h)) * HTB)
#define PG8_SB(b, h) ((4 + (b) * 2 + (h)) * HTB)
#define PG8_STAGE(bufoff, gbase, voff) do { _Pragma("unroll") for (int _i = 0; _i < 2; ++_i) \
        __builtin_amdgcn_global_load_lds((const unsigned*)((const char*)(gbase) + (voff)[_i]), (LAS unsigned*)(lds + (bufoff) + ldsw + _i * 8192), 16, 0, 0); } while (0)
#define PG8_LDA(dst, b, h) do { _Pragma("unroll") for (int m = 0; m < 4; ++m) _Pragma("unroll") for (int k = 0; k < 2; ++k) dst[m][k] = *(const LAS bf16x8*)(lds + PG8_SA(b, h) + aoff + m * 2048 + k * 1024); } while (0)
#define PG8_LDB(dst, b, h) do { _Pragma("unroll") for (int n = 0; n < 2; ++n) _Pragma("unroll") for (int k = 0; k < 2; ++k) dst[n][k] = *(const LAS bf16x8*)(lds + PG8_SB(b, h) + boff + n * 2048 + k * 1024); } while (0)
#define PG8_MMA(ai, bj, At, Bt) do { __builtin_amdgcn_s_setprio(1); _Pragma("unroll") for (int m = 0; m < 4; ++m) _Pragma("unroll") for (int n = 0; n < 2; ++n) _Pragma("unroll") for (int k = 0; k < 2; ++k) \
        acc[ai][bj][m][n] = __builtin_amdgcn_mfma_f32_16x16x32_bf16(Bt[n][k], At[m][k], acc[ai][bj][m][n], 0, 0, 0); __builtin_amdgcn_s_setprio(0); } while (0)
#define PG8_WAIT_V(n) asm volatile("s_waitcnt vmcnt(" #n ")" ::: "memory")
#define PG8_WAIT_L(n) asm volatile("s_waitcnt lgkmcnt(" #n ")" ::: "memory")
#define PG8_BAR __builtin_amdgcn_s_barrier()
#define PG8_SCHED __builtin_amdgcn_sched_barrier(0)
    Unit cur, nxt; int ui = 0;
    if (!S.next(0, cur)) return;
    f32x4 acc[2][2][4][2];
#pragma unroll
    for (int a = 0; a < 2; ++a)
#pragma unroll
        for (int b = 0; b < 2; ++b)
#pragma unroll
            for (int m = 0; m < 4; ++m)
#pragma unroll
                for (int n = 0; n < 2; ++n) acc[a][b][m][n] = (f32x4){0.f, 0.f, 0.f, 0.f};
    bf16x8 At[4][2], B0[2][2], B1[2][2];
    const char* cA = cur.a; const char* cB = cur.b;
    PG8_STAGE(PG8_SB(0, 0), cB, voffB); PG8_STAGE(PG8_SB(0, 1), cB + hstepB, voffB); PG8_STAGE(PG8_SA(0, 0), cA, voffA); PG8_STAGE(PG8_SA(0, 1), cA + hstepA, voffA);
    if (wr == 1) PG8_BAR;
    PG8_WAIT_V(2); PG8_BAR;
    PG8_STAGE(PG8_SB(1, 0), cB + kstep, voffB); PG8_STAGE(PG8_SA(1, 0), cA + kstep, voffA); PG8_STAGE(PG8_SB(1, 1), cB + hstepB + kstep, voffB);
    PG8_WAIT_V(6); PG8_BAR;
    for (;;) {
        const bool has_next = S.next(ui + 1, nxt);
        const char* nA = has_next ? nxt.a : cA; const char* nB = has_next ? nxt.b : cB;
        for (int t = 0; t < nt; t += 2) {
            const bool last = (t == nt - 2);
            const char* a1 = cA + (size_t)(t + 1) * kstep;
            const char* a2 = last ? nA : cA + (size_t)(t + 2) * kstep; const char* b2 = last ? nB : cB + (size_t)(t + 2) * kstep;
            const char* a3 = a2 + kstep; const char* b3 = b2 + kstep;
            PG8_LDB(B0, 0, 0); PG8_LDB(B1, 0, 1); PG8_SCHED; PG8_LDA(At, 0, 0); PG8_STAGE(PG8_SA(1, 1), a1 + hstepA, voffA);
            PG8_WAIT_V(8); PG8_WAIT_L(0); PG8_BAR; PG8_MMA(0, 0, At, B0); PG8_MMA(0, 1, At, B1); PG8_BAR; PG8_SCHED;
            PG8_LDA(At, 0, 1); PG8_STAGE(PG8_SB(0, 0), b2, voffB); PG8_STAGE(PG8_SB(0, 1), b2 + hstepB, voffB); PG8_STAGE(PG8_SA(0, 0), a2, voffA);
            PG8_WAIT_V(8); PG8_WAIT_L(0); PG8_BAR; PG8_MMA(1, 0, At, B0); PG8_MMA(1, 1, At, B1); PG8_BAR; PG8_SCHED;
            PG8_LDB(B0, 1, 0); PG8_LDB(B1, 1, 1); PG8_SCHED; PG8_LDA(At, 1, 0); PG8_STAGE(PG8_SA(0, 1), a2 + hstepA, voffA);
            PG8_WAIT_V(8); PG8_WAIT_L(0); PG8_BAR; PG8_MMA(0, 0, At, B0); PG8_MMA(0, 1, At, B1); PG8_BAR; PG8_SCHED;
            PG8_LDA(At, 1, 1); PG8_STAGE(PG8_SB(1, 0), b3, voffB); PG8_STAGE(PG8_SB(1, 1), b3 + hstepB, voffB); PG8_STAGE(PG8_SA(1, 0), a3, voffA);
            PG8_WAIT_V(8); PG8_WAIT_L(0); PG8_BAR; PG8_MMA(1, 0, At, B0); PG8_MMA(1, 1, At, B1); PG8_BAR; PG8_SCHED;
        }
        if constexpr (ALIGN_EPI) { if (wr == 0) PG8_BAR; }
        { int fr_ = fr, fq_ = fq; asm volatile("" : "+v"(fr_), "+v"(fq_)); E(acc, cur, wr, wc, fr_, fq_); }
        if (!has_next) break;
#pragma unroll
        for (int a = 0; a < 2; ++a)
#pragma unroll
            for (int b = 0; b < 2; ++b)
#pragma unroll
                for (int m = 0; m < 4; ++m)
#pragma unroll
                    for (int n = 0; n < 2; ++n) acc[a][b][m][n] = (f32x4){0.f, 0.f, 0.f, 0.f};
        cur = nxt; cA = nA; cB = nB; ++ui;
        if constexpr (ALIGN_EPI) { if (wr == 1) PG8_BAR; }
    }
    PG8_WAIT_V(0);
    if constexpr (!ALIGN_EPI) { if (wr == 0) PG8_BAR; }
    PG8_BAR;
#undef PG8_SA
#undef PG8_SB
#undef PG8_STAGE
#undef PG8_LDA
#undef PG8_LDB
#undef PG8_MMA
#undef PG8_WAIT_V
#undef PG8_WAIT_L
#undef PG8_BAR
#undef PG8_SCHED
}

typedef f32x4 Acc[2][2][4][2];

struct EpiZ { static constexpr bool PERM = true;
    bf16_t* O; int ldc; const u64* ssq;
    __device__ __forceinline__ void operator()(const Acc& acc, const Unit& u, int wr, int wc, int fr, int fq) const {
        const int row0 = u.pm * BM + wr * 64 + fr, col0 = u.pn * BM + wc * 32 + 8 * fq;
#pragma unroll
        for (int ai = 0; ai < 2; ++ai)
#pragma unroll
            for (int m = 0; m < 4; ++m) { const int row = row0 + ai * HALF + m * 16; const float rs = rstd_of(ssq, row);
                bf16_t* rowp = O + (size_t)row * ldc + col0;
#pragma unroll
                for (int bj = 0; bj < 2; ++bj) { const f32x4 v0 = acc[ai][bj][m][0] * rs, v1 = acc[ai][bj][m][1] * rs;
                    u32x4 w; w.x = cvt_pk_bf16(v0[0], v0[1]); w.y = cvt_pk_bf16(v0[2], v0[3]); w.z = cvt_pk_bf16(v1[0], v1[1]); w.w = cvt_pk_bf16(v1[2], v1[3]);
                    *(u32x4*)(rowp + bj * HALF) = w; } }
    }
};
struct EpiQ { static constexpr bool PERM = false;
    bf16_t* O; const float* rq; const float* cosT; const float* sinT;
    __device__ __forceinline__ void operator()(const Acc& acc, const Unit& u, int wr, int wc, int fr, int fq) const {
        const int row0 = u.pm * BM + wr * 64 + fr;
#pragma unroll
        for (int ai = 0; ai < 2; ++ai)
#pragma unroll
            for (int m = 0; m < 4; ++m) { const int row = row0 + ai * HALF + m * 16; const float rs = rq[row] * QS_MLA; const int pos = row & (SEQ - 1);
                const f32x4 cs = *(const f32x4*)(cosT + pos * 16 + 4 * fq), sn = *(const f32x4*)(sinT + pos * 16 + 4 * fq);
#pragma unroll
                for (int bj = 0; bj < 2; ++bj) { const int cb = u.pn * BM + bj * HALF + wc * 32; const bool rope = ((cb >> 5) % 3) == 2;
                    f32x4 v0 = acc[ai][bj][m][0] * rs, v1 = acc[ai][bj][m][1] * rs;
                    if (rope) { const f32x4 o0 = v0 * cs - v1 * sn, o1 = v1 * cs + v0 * sn; v0 = o0; v1 = o1; }
                    u32x2 w0, w1; w0.x = cvt_pk_bf16(v0[0], v0[1]); w0.y = cvt_pk_bf16(v0[2], v0[3]); w1.x = cvt_pk_bf16(v1[0], v1[1]); w1.y = cvt_pk_bf16(v1[2], v1[3]);
                    bf16_t* p = O + (size_t)row * 768 + cb + 4 * fq;
                    *(u32x2*)(p) = w0; *(u32x2*)(p + 16) = w1; } }
    }
};
struct EpiKV { static constexpr bool PERM = true;
    bf16_t* Kb; bf16_t* Vb; const float* rkv;
    __device__ __forceinline__ void operator()(const Acc& acc, const Unit& u, int wr, int wc, int fr, int fq) const {
        const int row0 = u.pm * BM + wr * 64 + fr;
#pragma unroll
        for (int ai = 0; ai < 2; ++ai)
#pragma unroll
            for (int m = 0; m < 4; ++m) { const int row = row0 + ai * HALF + m * 16; const float rs = rkv[row];
#pragma unroll
                for (int bj = 0; bj < 2; ++bj) { const int h = 2 * u.pn + bj; const f32x4 v0 = acc[ai][bj][m][0] * rs, v1 = acc[ai][bj][m][1] * rs;
                    u32x4 w; w.x = cvt_pk_bf16(v0[0], v0[1]); w.y = cvt_pk_bf16(v0[2], v0[3]); w.z = cvt_pk_bf16(v1[0], v1[1]); w.w = cvt_pk_bf16(v1[2], v1[3]);
                    bf16_t* p = (wc < 2) ? (Kb + (size_t)row * 768 + 96 * h + 32 * wc + 8 * fq) : (Vb + (size_t)row * 512 + 64 * h + 32 * (wc - 2) + 8 * fq);
                    *(u32x4*)p = w; } }
    }
};
struct EpiRes { static constexpr bool PERM = false;
    const float* base; float* X; bf16_t* XB; u64* ssq_next;
    __device__ __forceinline__ void operator()(const Acc& acc, const Unit& u, int wr, int wc, int fr, int fq) const {
        const int row0 = u.pm * BM + wr * 64 + fr, col0 = u.pn * BM + wc * 32 + 4 * fq;
#pragma unroll
        for (int ai = 0; ai < 2; ++ai)
#pragma unroll
            for (int m = 0; m < 4; ++m) { const int row = row0 + ai * HALF + m * 16; const size_t off = (size_t)row * DM + col0; float s = 0.f;
#pragma unroll
                for (int bj = 0; bj < 2; ++bj)
#pragma unroll
                    for (int n = 0; n < 2; ++n) { const f32x4 o = *(const f32x4*)(base + off + bj * HALF + n * 16) + acc[ai][bj][m][n];
                        *(f32x4*)(X + off + bj * HALF + n * 16) = o; s += (o[0] * o[0] + o[1] * o[1]) + (o[2] * o[2] + o[3] * o[3]);
                        u32x2 w; w.x = cvt_pk_bf16(o[0], o[1]); w.y = cvt_pk_bf16(o[2], o[3]); *(u32x2*)(XB + off + bj * HALF + n * 16) = w; }
                s += __shfl_xor(s, 16); s += __shfl_xor(s, 32);
                if (fq == 0) __hip_atomic_fetch_add(ssq_next + row, ssq_fix(s), RLX_AGENT);
                asm volatile("" ::: "memory"); }
    }
};
template <int MODE> struct EpiSwiGLU { static constexpr bool PERM = true;
    bf16_t* O; int ldc; const void* rsrc;
    __device__ __forceinline__ void operator()(const Acc& acc, const Unit& u, int wr, int wc, int fr, int fq) const {
        const int row0 = u.pm * BM + wr * 64 + fr, col0 = u.pn * HALF + wc * 32 + 8 * fq;
#pragma unroll
        for (int ai = 0; ai < 2; ++ai)
#pragma unroll
            for (int m = 0; m < 4; ++m) { const int row = row0 + ai * HALF + m * 16; const float rs = MODE == 0 ? rstd_of((const u64*)rsrc, row) : ((const float*)rsrc)[row];
                float o[8];
#pragma unroll
                for (int n = 0; n < 2; ++n)
#pragma unroll
                    for (int i = 0; i < 4; ++i) { const float gg = acc[ai][0][m][n][i] * rs, uu = acc[ai][1][m][n][i] * rs; o[n * 4 + i] = gg * sigmoidf_(gg) * uu; }
                u32x4 w; w.x = cvt_pk_bf16(o[0], o[1]); w.y = cvt_pk_bf16(o[2], o[3]); w.z = cvt_pk_bf16(o[4], o[5]); w.w = cvt_pk_bf16(o[6], o[7]);
                *(u32x4*)(O + (size_t)row * ldc + col0) = w; }
    }
};
struct EpiOddIn { static constexpr bool PERM = true;
    bf16_t* QKV; bf16_t* UV; const u64* ssq;
    __device__ __forceinline__ void operator()(const Acc& acc, const Unit& u, int wr, int wc, int fr, int fq) const {
        const int row0 = u.pm * BM + wr * 64 + fr; const bool isuv = u.pn >= 6; const float qsc = u.pn < 2 ? QS_BAND : 1.0f;
#pragma unroll
        for (int ai = 0; ai < 2; ++ai)
#pragma unroll
            for (int m = 0; m < 4; ++m) { const int row = row0 + ai * HALF + m * 16; const float rs = rstd_of(ssq, row);
#pragma unroll
                for (int bj = 0; bj < 2; ++bj) { float o[8];
#pragma unroll
                    for (int n = 0; n < 2; ++n)
#pragma unroll
                        for (int i = 0; i < 4; ++i) { float v = acc[ai][bj][m][n][i] * rs;
                            if (isuv) { const float t = 0.7978845608028654f * (v + 0.044715f * v * v * v); v = v * sigmoidf_(2.0f * t); } else v *= qsc;
                            o[n * 4 + i] = v; }
                    u32x4 w; w.x = cvt_pk_bf16(o[0], o[1]); w.y = cvt_pk_bf16(o[2], o[3]); w.z = cvt_pk_bf16(o[4], o[5]); w.w = cvt_pk_bf16(o[6], o[7]);
                    bf16_t* p = isuv ? (UV + (size_t)row * 1024 + (u.pn - 6) * BM + bj * HALF + wc * 32 + 8 * fq) : (QKV + (size_t)row * 1536 + u.pn * BM + bj * HALF + wc * 32 + 8 * fq);
                    *(u32x4*)p = w; } }
    }
};
struct EpiY { static constexpr bool PERM = true;
    bf16_t* O; const float* gate;
    __device__ __forceinline__ void operator()(const Acc& acc, const Unit& u, int wr, int wc, int fr, int fq) const {
        const int row0 = u.pm * BM + wr * 64 + fr, col0 = u.pn * BM + wc * 32 + 8 * fq;
#pragma unroll
        for (int ai = 0; ai < 2; ++ai)
#pragma unroll
            for (int m = 0; m < 4; ++m) { const int row = row0 + ai * HALF + m * 16; const float rs = gate[row];
                bf16_t* rowp = O + (size_t)row * DM + col0;
#pragma unroll
                for (int bj = 0; bj < 2; ++bj) { const f32x4 v0 = acc[ai][bj][m][0] * rs, v1 = acc[ai][bj][m][1] * rs;
                    u32x4 w; w.x = cvt_pk_bf16(v0[0], v0[1]); w.y = cvt_pk_bf16(v0[2], v0[3]); w.z = cvt_pk_bf16(v1[0], v1[1]); w.w = cvt_pk_bf16(v1[2], v1[3]);
                    *(u32x4*)(rowp + bj * HALF) = w; } }
    }
};
}

#define XB_TMO      128
#define XB_XCNT(j)  (256  + 64 * (j))
#define XB_XSUB(j)  (1280 + 64 * (j))
#define XB_XGEN(j)  (2304 + 64 * (j))
#define XB_TOP      3328
#define XB_TOPGEN   3392
#define XCD_BAR_WORDS 3456
#define XB_SPIN_CAP (1u << 18)
__device__ __forceinline__ unsigned xb_ld(unsigned* p)              { return __hip_atomic_load(p, __ATOMIC_RELAXED, __HIP_MEMORY_SCOPE_AGENT); }
__device__ __forceinline__ unsigned xb_add(unsigned* p, unsigned v) { return __hip_atomic_fetch_add(p, v, __ATOMIC_RELAXED, __HIP_MEMORY_SCOPE_AGENT); }
__device__ __forceinline__ unsigned xb_xcc_id() { return (unsigned)__builtin_amdgcn_s_getreg((3 << 11) | 20) & 0xFu; }
#define XB_SPIN(cond, bar) do { unsigned _sp = 0; while (cond) { __builtin_amdgcn_s_sleep(1); \
    if ((++_sp & 255u) == 0u) { if (xb_ld(&(bar)[XB_TMO])) break; if (_sp > XB_SPIN_CAP) { atomicAdd(&(bar)[XB_TMO], 1u); break; } } } } while (0)
struct XcdBarrier { unsigned* bar; unsigned x; volatile LAS unsigned* st; };
__device__ __forceinline__ XcdBarrier xcd_barrier_post(unsigned* bar, volatile LAS unsigned* st) {
    XcdBarrier b; b.bar = bar; b.x = xb_xcc_id(); b.st = st;
    if (threadIdx.x == 0) (void)xb_add(&bar[XB_XCNT(b.x)], 1u);
    return b;
}
__device__ __forceinline__ void xcd_barrier_complete(unsigned* bar, unsigned x, unsigned& nloc, unsigned& nx) {
    const unsigned G = gridDim.x * gridDim.y * gridDim.z;
    unsigned sum, cnt, mine, sp = 0u;
    for (;;) {
        sum = 0u; cnt = 0u; mine = 0u;
#pragma unroll
        for (unsigned j = 0; j < 16; ++j) { const unsigned c = xb_ld(&bar[XB_XCNT(j)]); sum += c; cnt += (c > 0u) ? 1u : 0u; mine = (j == x) ? c : mine; }
        if (sum == G) break;
        __builtin_amdgcn_s_sleep(1);
        if ((++sp & 255u) == 0u) { if (xb_ld(&bar[XB_TMO])) break; if (sp > XB_SPIN_CAP) { atomicAdd(&bar[XB_TMO], 1u); break; } }
    }
    nloc = mine > 0u ? mine : 1u; nx = cnt > 0u ? cnt : 1u;
}
__device__ __forceinline__ void xcd_barrier(const XcdBarrier& b) {
    asm volatile("s_waitcnt vmcnt(0)" ::: "memory");
    __syncthreads();
    if (threadIdx.x == 0) {
        unsigned* bar = b.bar;
        __builtin_amdgcn_s_waitcnt(0);
        unsigned nloc = b.st[0], nx = b.st[1];
        if (nloc == 0u) { xcd_barrier_complete(bar, b.x, nloc, nx); b.st[0] = nloc; b.st[1] = nx; }
        const unsigned old = xb_add(&bar[XB_XSUB(b.x)], 1u);
        const unsigned gen = old / nloc;
        if (old + 1u == (gen + 1u) * nloc) {
            __builtin_amdgcn_fence(__ATOMIC_RELEASE, "agent");
            asm volatile("s_waitcnt vmcnt(0)" ::: "memory");
            const unsigned og = xb_add(&bar[XB_TOP], 1u);
            const unsigned tg = og / nx;
            if (og + 1u == (tg + 1u) * nx) xb_add(&bar[XB_TOPGEN], 1u);
            else XB_SPIN(xb_ld(&bar[XB_TOPGEN]) == tg, bar);
            __builtin_amdgcn_fence(__ATOMIC_ACQUIRE, "agent");
            xb_add(&bar[XB_XGEN(b.x)], 1u);
            asm volatile("s_waitcnt vmcnt(0)" ::: "memory");
        } else {
            XB_SPIN(xb_ld(&bar[XB_XGEN(b.x)]) == gen, bar);
            __builtin_amdgcn_fence(__ATOMIC_ACQUIRE, "agent");
            asm volatile("s_waitcnt vmcnt(0)" ::: "memory");
        }
    }
    __syncthreads();
}

struct Frame {
    LAS unsigned char* lds;
    unsigned* ctl;
    int tid, lane, wave, vcu, G;
    __device__ __forceinline__ void refresh() { tid = opaque_tid(); lane = tid & 63; wave = __builtin_amdgcn_readfirstlane(tid >> 6); }
};

struct XJob { const float* W; const float* gain; bf16_t* WT; int K, N, ldt, mode, nb; size_t sb, db; int istart; };
__device__ __forceinline__ void xpose_item(const XJob& J, int item, LAS float* scr, int lane) {
    const int nblk = J.N / 32, per = (J.K / 64) * nblk, e = item / per, r = item % per, kb = r / nblk, nbk = r % nblk, k0 = 64 * kb, n0 = 32 * nbk;
    const float* W = J.W + (size_t)e * J.sb; bf16_t* WT = J.WT + (size_t)e * J.db;
#pragma unroll 8
    for (int i = 0; i < 32; ++i) { const int kk = 2 * i + (lane >> 5); float v = W[(size_t)(k0 + kk) * J.N + n0 + (lane & 31)]; if (J.gain) v *= J.gain[k0 + kk]; scr[kk * 33 + (lane & 31)] = v; }
    LDS_WAIT(); asm volatile("" ::: "memory");
    const int c = lane & 7;
#pragma unroll
    for (int j = 0; j < 4; ++j) { const int n = (lane >> 3) + 8 * j; const LAS float* s = scr + (8 * c) * 33 + n;
        u32x4 o; o.x = cvt_pk_bf16(s[0 * 33], s[1 * 33]); o.y = cvt_pk_bf16(s[2 * 33], s[3 * 33]); o.z = cvt_pk_bf16(s[4 * 33], s[5 * 33]); o.w = cvt_pk_bf16(s[6 * 33], s[7 * 33]);
        const int ng = n0 + n; const int row = J.mode == 0 ? ng : ((ng >> 7) * 256 + (ng & 127) + (J.mode == 2 ? 128 : 0));
        *(u32x4*)(WT + (size_t)row * J.ldt + k0 + 8 * c) = o; }
    LDS_WAIT(); asm volatile("" ::: "memory");
}
constexpr int NJT = 12;
__device__ __forceinline__ void make_job(int i, int t, const float* const* in, unsigned char* ws, XJob& J) {
    J.gain = nullptr; J.mode = 0; J.nb = 1; J.sb = 0; J.db = 0; J.istart = 0;
    bf16_t* WE = (bf16_t*)(ws + WS_WE) + (size_t)i * E_SIZE; bf16_t* WO = (bf16_t*)(ws + WS_WO) + (size_t)i * O_SIZE;
    switch (t) {
    case 0: J.W = in[2] + (size_t)i * 1024 * 928; J.gain = in[1] + i * 1024; J.WT = WE + E_WIN; J.K = 1024; J.N = 928; J.ldt = 1024; break;
    case 1: J.W = in[6] + (size_t)i * 256 * 768; J.gain = in[5] + i * 256; J.WT = WE + E_WQ; J.K = 256; J.N = 768; J.ldt = 256; break;
    case 2: J.W = in[8] + (size_t)i * 128 * 1024; J.gain = in[7] + i * 128; J.WT = WE + E_WKV; J.K = 128; J.N = 1024; J.ldt = 256; break;
    case 3: J.W = in[9] + (size_t)i * 1024 * 1024 + (size_t)512 * 1024; J.WT = WE + E_WOUT + 512; J.K = 512; J.N = 1024; J.ldt = 1024; break;
    case 4: J.W = in[11] + (size_t)i * 1024 * FF; J.gain = in[10] + i * 1024; J.WT = WE + E_WGU; J.K = 1024; J.N = FF; J.ldt = 1024; J.mode = 1; break;
    case 5: J.W = in[12] + (size_t)i * 1024 * FF; J.gain = in[10] + i * 1024; J.WT = WE + E_WGU; J.K = 1024; J.N = FF; J.ldt = 1024; J.mode = 2; break;
    case 6: J.W = in[13] + (size_t)i * FF * 1024; J.WT = WE + E_WDN; J.K = FF; J.N = 1024; J.ldt = FF; break;
    case 7: J.W = in[15] + (size_t)i * 1024 * 2560; J.gain = in[14] + i * 1024; J.WT = WO + O_WIN; J.K = 1024; J.N = 2560; J.ldt = 1024; break;
    case 8: J.W = in[21] + (size_t)i * 1024 * 1024; J.WT = WO + O_WOUT; J.K = 1024; J.N = 1024; J.ldt = 1024; break;
    case 9: J.W = in[24] + (size_t)i * NEXP * 1024 * EFF; J.gain = in[22] + i * 1024; J.WT = WO + O_WGU; J.K = 1024; J.N = EFF; J.ldt = 1024; J.mode = 1; J.nb = NEXP; J.sb = (size_t)1024 * EFF; J.db = (size_t)2 * EFF * 1024; break;
    case 10: J.W = in[25] + (size_t)i * NEXP * 1024 * EFF; J.gain = in[22] + i * 1024; J.WT = WO + O_WGU; J.K = 1024; J.N = EFF; J.ldt = 1024; J.mode = 2; J.nb = NEXP; J.sb = (size_t)1024 * EFF; J.db = (size_t)2 * EFF * 1024; break;
    default: J.W = in[26] + (size_t)i * NEXP * EFF * 1024; J.WT = WO + O_WDN; J.K = EFF; J.N = 1024; J.ldt = EFF; J.nb = NEXP; J.sb = (size_t)EFF * 1024; J.db = (size_t)1024 * EFF; break;
    }
}
__host__ __device__ constexpr int job_items_t(int t) {
    return t == 0 ? 16 * 29 : t == 1 ? 4 * 24 : t == 2 ? 2 * 32 : t == 3 ? 8 * 32 : t == 4 ? 16 * 88 : t == 5 ? 16 * 88 : t == 6 ? 44 * 32 : t == 7 ? 16 * 80 : t == 8 ? 16 * 32 : t == 9 ? 8 * 16 * 112 : t == 10 ? 8 * 16 * 112 : 8 * 56 * 32;
}
__host__ __device__ constexpr int job_start_t(int t) { int a = 0; for (int k = 0; k < t; ++k) a += job_items_t(k); return a; }
constexpr int ITEMS_PER_PAIR = job_start_t(NJT);

__device__ __forceinline__ void p0_prologue(Frame& F, const float* const* in, unsigned char* ws) {
    F.refresh();
    LAS float* scr = (LAS float*)(F.lds + F.wave * 12288);
    const int gw = F.vcu * NWAVES + F.wave, NGW = F.G * NWAVES;
    for (int it = gw; it < 2 * ITEMS_PER_PAIR; it += NGW) {
        const int i = it / ITEMS_PER_PAIR, r = it % ITEMS_PER_PAIR;
        int t = 0;
#pragma unroll
        for (int k = 1; k < NJT; ++k) t += (r >= job_start_t(k)) ? 1 : 0;
        int st = 0;
#pragma unroll
        for (int k = 1; k < NJT; ++k) st = (t == k) ? job_start_t(k) : st;
        XJob J; make_job(i, t, in, ws, J);
        xpose_item(J, r - st, scr, F.lane);
    }
    const int gt = F.vcu * 512 + F.tid, NGT = F.G * 512;
    for (int i = 0; i < 2; ++i) {
        bf16_t* WE = (bf16_t*)(ws + WS_WE) + (size_t)i * E_SIZE;
        for (int x = gt; x < 96 * 1024 / 8; x += NGT) *(u32x4*)(WE + E_WIN + (size_t)928 * 1024 + (size_t)x * 8) = (u32x4){0u, 0u, 0u, 0u};
        for (int x = gt; x < 1024 * 16; x += NGT) { const int r = x >> 4, c = x & 15; *(u32x4*)(WE + E_WKV + (size_t)r * 256 + 128 + c * 8) = (u32x4){0u, 0u, 0u, 0u}; }
        const float* pw = in[3] + (size_t)i * 4 * 128 * 128; const float* ps = in[4] + (size_t)i * 512; const float* wo = in[9] + (size_t)i * 1024 * 1024;
        for (int x = gt; x < 512 * 1024; x += NGT) { const int n = x & 1023, k = x >> 10, g = k >> 7, c = k & 127; float a = 0.f;
            const float* pr = pw + ((size_t)g * 128 + c) * 128; const float* sr = ps + g * 128; const float* wr_ = wo + (size_t)(g * 128) * 1024 + n;
#pragma unroll 8
            for (int d = 0; d < 128; ++d) a += pr[d] * sr[d] * wr_[(size_t)d * 1024];
            WE[E_WOUT + (size_t)n * 1024 + k] = f2bf(a); }
    }
    { float* cosT = (float*)(ws + T_COS); float* sinT = (float*)(ws + T_SIN);
      for (int x = gt; x < SEQ * 16; x += NGT) { const int pos = x >> 4, j = x & 15;
          const float inv = 1.0f / powf(10000.0f, (float)(2 * j) / 32.0f); const float angf = (float)pos * inv;
          double a = (double)angf; const double twopi = 6.283185307179586476925; a -= twopi * rint(a / twopi);
          const double y = a * 0.125, y2 = y * y;
          double s = y * (1.0 + y2 * (-1.0 / 6 + y2 * (1.0 / 120 + y2 * (-1.0 / 5040 + y2 * (1.0 / 362880 + y2 * (-1.0 / 39916800 + y2 * (1.0 / 6227020800.0)))))));
          double c = 1.0 + y2 * (-0.5 + y2 * (1.0 / 24 + y2 * (-1.0 / 720 + y2 * (1.0 / 40320 + y2 * (-1.0 / 3628800 + y2 * (1.0 / 479001600.0 + y2 * (-1.0 / 87178291200.0)))))));
#pragma unroll
          for (int k = 0; k < 3; ++k) { const double s2 = 2.0 * s * c, c2 = c * c - s * s; s = s2; c = c2; }
          cosT[x] = (float)c; sinT[x] = (float)s; } }
    { const float* x = in[0]; bf16_t* XB = (bf16_t*)(ws + WS_XB); u64* ssq = (u64*)(ws + WS_SSQ);
      for (int m = gw; m < NTOK; m += NGW) { const f32x4* xr = (const f32x4*)(x + (size_t)m * DM) + F.lane; float s = 0.f;
#pragma unroll
          for (int j = 0; j < 4; ++j) { const f32x4 v = xr[64 * j]; s += (v[0] * v[0] + v[1] * v[1]) + (v[2] * v[2] + v[3] * v[3]);
              u32x2 w; w.x = cvt_pk_bf16(v[0], v[1]); w.y = cvt_pk_bf16(v[2], v[3]); *((u32x2*)(XB + (size_t)m * DM) + F.lane + 64 * j) = w; }
          s = wave_sum(s); if (F.lane == 0) ssq[m] = ssq_fix(s); } }
}

__device__ __forceinline__ void p_even_mid(Frame& F, unsigned char* ws) {
    F.refresh();
    const bf16_t* Z = (const bf16_t*)(ws + R_Z); bf16_t* MIX = (bf16_t*)(ws + R_MIX); bf16_t* Kb = (bf16_t*)(ws + R_K);
    float* RQ = (float*)(ws + T_RQ); float* RKV = (float*)(ws + T_RKV); const float* cosT = (const float*)(ws + T_COS); const float* sinT = (const float*)(ws + T_SIN);
    for (int blk = F.vcu; blk < NTOK / 64; blk += F.G) {
        const int rb = blk * 64;
        { const int c = F.tid, g = c >> 7, w = 2 << g;
          for (int r = 0; r < 64; ++r) { const int t = rb + r, p = t & (SEQ - 1); const int cnt = (p + 1 < w) ? (p + 1) : w; float s = 0.f;
              for (int j = 0; j < cnt; ++j) s += bf2f(Z[(size_t)(t - j) * 1024 + c]);
              const float self = bf2f(Z[(size_t)t * 1024 + c]);
              MIX[(size_t)t * 1024 + c] = f2bf(s / (float)cnt - self); } }
        for (int r = F.wave; r < 64; r += NWAVES) { const int t = rb + r, p = t & (SEQ - 1); const bf16_t* zr = Z + (size_t)t * 1024;
            const u32x2 q = *((const u32x2*)(zr + 512) + F.lane); const unsigned kv = *((const unsigned*)(zr + 768) + F.lane);
            float sq = bflo(q.x) * bflo(q.x) + bfhi(q.x) * bfhi(q.x) + bflo(q.y) * bflo(q.y) + bfhi(q.y) * bfhi(q.y);
            float sk = bflo(kv) * bflo(kv) + bfhi(kv) * bfhi(kv);
            sq = wave_sum(sq); sk = wave_sum(sk);
            if (F.lane == 0) { RQ[t] = rsqrtf(sq * (1.0f / 256.0f) + EPS); RKV[t] = rsqrtf(sk * (1.0f / 128.0f) + EPS); }
            if (F.lane < 16) { const int j = F.lane; const float x1 = bf2f(zr[896 + j]), x2 = bf2f(zr[912 + j]); const float c = cosT[p * 16 + j], s = sinT[p * 16 + j];
                const bf16_t o1 = f2bf(x1 * c - x2 * s), o2 = f2bf(x2 * c + x1 * s); bf16_t* kr = Kb + (size_t)t * 768;
#pragma unroll
                for (int h = 0; h < 8; ++h) { kr[96 * h + 64 + j] = o1; kr[96 * h + 80 + j] = o2; } } }
    }
}

__device__ __forceinline__ int crow(int r, int hi) { return (r & 3) + 8 * (r >> 2) + 4 * hi; }
__device__ __forceinline__ s16x4 vtr(const LAS unsigned char* p) { return __builtin_bit_cast(s16x4, __builtin_amdgcn_ds_read_tr16_b64_v4i16((LAS s16x4*)p)); }

template <int DQK, bool BAND>
__device__ __forceinline__ void attn_unit(const bf16_t* __restrict__ Qp, int ldq, const bf16_t* __restrict__ Kp, int ldk, const bf16_t* __restrict__ Vp, int ldv,
                                          bf16_t* Op, int ldo, int b, int qb, LAS unsigned char* lds, const float* bias_g) {
    constexpr int KSTR = (DQK + 8) * 2, KBUF = 64 * KSTR, VBUF = 8192, KCH = DQK / 8, NKS = DQK / 16;
    const int tid = opaque_tid(), lane = tid & 63, wave = __builtin_amdgcn_readfirstlane(tid >> 6), r32 = lane & 31, hi = lane >> 5;
    LAS unsigned char* Kl = lds; LAS unsigned char* Vl = lds + 2 * KBUF;
    LAS float* sc = (LAS float*)(lds + 2 * KBUF + 2 * VBUF) + wave * 32;
    LAS float* biasL = (LAS float*)(lds + 2 * KBUF + 2 * VBUF + 1024);
    const int chunkw = 4 * qb + (wave >> 1), t1 = 4 * qb + 3, t0 = BAND ? ((4 * qb - 8) > 0 ? (4 * qb - 8) : 0) : 0;
    const size_t rowb = (size_t)b * SEQ;
    if (BAND) { if (tid < 257) biasL[tid] = bias_g[tid] * LOG2E; }
    bf16x8 qf[NKS];
    { const bf16_t* qrow = Qp + (rowb + 256 * qb + 32 * wave + r32) * ldq + 8 * hi;
#pragma unroll
      for (int ks = 0; ks < NKS; ++ks) qf[ks] = *(const bf16x8*)(qrow + 16 * ks); }
    const int kkey0 = tid / KCH, kch0 = tid % KCH; const int idx1 = tid + 512; const bool has1 = idx1 < 64 * KCH; const int kkey1 = has1 ? idx1 / KCH : 0, kch1 = has1 ? idx1 % KCH : 0;
    const int vkey = tid >> 3, vch = tid & 7;
    const bf16_t* kg0 = Kp + (rowb + kkey0) * ldk + 8 * kch0; const bf16_t* kg1 = Kp + (rowb + kkey1) * ldk + 8 * kch1; const bf16_t* vg = Vp + (rowb + vkey) * ldv + 8 * vch;
    const int kl0 = kkey0 * KSTR + kch0 * 16, kl1 = kkey1 * KSTR + kch1 * 16, vl = (vch >> 2) * 4096 + vkey * 64 + (vch & 3) * 16;
    u32x4 kr0, kr1 = (u32x4){0u, 0u, 0u, 0u}, vr;
    { const size_t to = (size_t)t0 * 64; kr0 = *(const u32x4*)(kg0 + to * ldk); if (has1) kr1 = *(const u32x4*)(kg1 + to * ldk); vr = *(const u32x4*)(vg + to * ldv);
      *(LAS u32x4*)(Kl + kl0) = kr0; if (has1) *(LAS u32x4*)(Kl + kl1) = kr1; *(LAS u32x4*)(Vl + vl) = vr; }
    __syncthreads();
    float m_run = -INFINITY, l_run = 0.f; f32x16 o0 = {}, o1 = {};
    const int vtoff = (16 * ((lane >> 4) & 1) + 4 * (lane & 3)) * 2 + (4 * hi + ((lane & 15) >> 2)) * 64;
    for (int t = t0; t <= t1; ++t) {
        const int cur = (t - t0) & 1; const bool more = t < t1;
        if (more) { const size_t to = (size_t)(t + 1) * 64; kr0 = *(const u32x4*)(kg0 + to * ldk); if (has1) kr1 = *(const u32x4*)(kg1 + to * ldk); vr = *(const u32x4*)(vg + to * ldv); }
        const bool active = BAND ? (t <= chunkw && t >= chunkw - 8) : (t <= chunkw);
        if (active) {
            const LAS unsigned char* Ks = Kl + cur * KBUF; const LAS unsigned char* Vs = Vl + cur * VBUF;
            f32x16 s0 = {}, s1 = {};
#pragma unroll
            for (int ks = 0; ks < NKS; ++ks) {
                const bf16x8 k0 = *(const LAS bf16x8*)(Ks + r32 * KSTR + ks * 32 + hi * 16);
                const bf16x8 k1 = *(const LAS bf16x8*)(Ks + (32 + r32) * KSTR + ks * 32 + hi * 16);
                s0 = __builtin_amdgcn_mfma_f32_32x32x16_bf16(k0, qf[ks], s0, 0, 0, 0);
                s1 = __builtin_amdgcn_mfma_f32_32x32x16_bf16(k1, qf[ks], s1, 0, 0, 0);
            }
            if (BAND) {
                if (t <= chunkw - 3) { const float cb = biasL[256];
#pragma unroll
                    for (int r = 0; r < 16; ++r) { s0[r] += cb; s1[r] += cb; } }
                else { const int qpos = 256 * qb + 32 * wave + r32, kb0 = 64 * t;
#pragma unroll
                    for (int r = 0; r < 16; ++r) { const int rel = qpos - (kb0 + crow(r, hi)); int i0 = rel < -128 ? -128 : (rel > 128 ? 128 : rel); int rel1 = rel - 32; int i1 = rel1 < -128 ? -128 : (rel1 > 128 ? 128 : rel1);
                        s0[r] += biasL[i0 + 128]; s1[r] += biasL[i1 + 128]; } }
            }
            float mx = s0[0];
#pragma unroll
            for (int r = 1; r < 16; ++r) mx = fmaxf(mx, s0[r]);
#pragma unroll
            for (int r = 0; r < 16; ++r) mx = fmaxf(mx, s1[r]);
            mx = fmaxf(mx, __shfl_xor(mx, 32));
            const float m_new = fmaxf(m_run, mx), alpha = fast_exp2(m_run - m_new); m_run = m_new;
            float ps = 0.f;
#pragma unroll
            for (int r = 0; r < 16; ++r) { s0[r] = fast_exp2(s0[r] - m_new); s1[r] = fast_exp2(s1[r] - m_new); ps += s0[r] + s1[r]; }
            l_run = l_run * alpha + ps;
            if (hi == 0) sc[r32] = alpha;
            LDS_WAIT();
#pragma unroll
            for (int r = 0; r < 16; ++r) { const float a = sc[crow(r, hi)]; o0[r] *= a; o1[r] *= a; }
            LDS_WAIT();
#pragma unroll
            for (int hf = 0; hf < 2; ++hf)
#pragma unroll
                for (int s2 = 0; s2 < 2; ++s2) {
                    u32x4 pw;
                    if (hf == 0) { pw.x = cvt_pk_bf16(s0[8 * s2 + 0], s0[8 * s2 + 1]); pw.y = cvt_pk_bf16(s0[8 * s2 + 2], s0[8 * s2 + 3]); pw.z = cvt_pk_bf16(s0[8 * s2 + 4], s0[8 * s2 + 5]); pw.w = cvt_pk_bf16(s0[8 * s2 + 6], s0[8 * s2 + 7]); }
                    else         { pw.x = cvt_pk_bf16(s1[8 * s2 + 0], s1[8 * s2 + 1]); pw.y = cvt_pk_bf16(s1[8 * s2 + 2], s1[8 * s2 + 3]); pw.z = cvt_pk_bf16(s1[8 * s2 + 4], s1[8 * s2 + 5]); pw.w = cvt_pk_bf16(s1[8 * s2 + 6], s1[8 * s2 + 7]); }
                    const bf16x8 pa = __builtin_bit_cast(bf16x8, pw);
                    const LAS unsigned char* vb = Vs + (32 * hf + 16 * s2) * 64 + vtoff;
#pragma unroll
                    for (int dh = 0; dh < 2; ++dh) {
                        const s16x4 lo = vtr(vb + dh * 4096), hh = vtr(vb + dh * 4096 + 8 * 64);
                        const bf16x8 vf = (bf16x8){lo[0], lo[1], lo[2], lo[3], hh[0], hh[1], hh[2], hh[3]};
                        if (dh == 0) o0 = __builtin_amdgcn_mfma_f32_32x32x16_bf16(pa, vf, o0, 0, 0, 0);
                        else         o1 = __builtin_amdgcn_mfma_f32_32x32x16_bf16(pa, vf, o1, 0, 0, 0);
                    }
                }
        }
        if (more) { const int nx = cur ^ 1; *(LAS u32x4*)(Kl + nx * KBUF + kl0) = kr0; if (has1) *(LAS u32x4*)(Kl + nx * KBUF + kl1) = kr1; *(LAS u32x4*)(Vl + nx * VBUF + vl) = vr; }
        __syncthreads();
    }
    { const float lt = l_run + __shfl_xor(l_run, 32);
      if (hi == 0) sc[r32] = fast_rcp(lt);
      LDS_WAIT();
      bf16_t* orow = Op + (rowb + 256 * qb + 32 * wave) * ldo + r32;
#pragma unroll
      for (int r = 0; r < 16; ++r) { const int q = crow(r, hi); const float inv = sc[q];
          orow[(size_t)q * ldo] = f2bf(o0[r] * inv); orow[(size_t)q * ldo + 32] = f2bf(o1[r] * inv); }
      LDS_WAIT(); }
}

__device__ __forceinline__ void sgu_unit(const bf16_t* UV, const float* ng, const float* nb, const float* W, const float* bs, bf16_t* MIX, int b, int n, int g, LAS unsigned char* lds) {
    LAS float* vn = (LAS float*)lds;
    const int tid = opaque_tid(); const size_t t0 = (size_t)b * SEQ + (size_t)n * 128;
    { const int s = tid >> 2, qd = tid & 3; const bf16_t* src = UV + (t0 + s) * 1024 + 512 + g * 128 + 32 * qd;
      float x[32];
#pragma unroll
      for (int j = 0; j < 4; ++j) { const u32x4 v = *((const u32x4*)src + j); x[8 * j + 0] = bflo(v.x); x[8 * j + 1] = bfhi(v.x); x[8 * j + 2] = bflo(v.y); x[8 * j + 3] = bfhi(v.y); x[8 * j + 4] = bflo(v.z); x[8 * j + 5] = bfhi(v.z); x[8 * j + 6] = bflo(v.w); x[8 * j + 7] = bfhi(v.w); }
      float sm = 0.f;
#pragma unroll
      for (int j = 0; j < 32; ++j) sm += x[j];
      sm += __shfl_xor(sm, 1); sm += __shfl_xor(sm, 2);
      const float mu = sm * (1.0f / 128.0f); float vs = 0.f;
#pragma unroll
      for (int j = 0; j < 32; ++j) { x[j] -= mu; vs += x[j] * x[j]; }
      vs += __shfl_xor(vs, 1); vs += __shfl_xor(vs, 2);
      const float rstd = rsqrtf(vs * (1.0f / 128.0f) + EPS);
#pragma unroll
      for (int j = 0; j < 32; ++j) { const int c = 32 * qd + j; vn[s * 128 + c] = x[j] * rstd * ng[g * 128 + c] + nb[g * 128 + c]; } }
    __syncthreads();
    { const int c = tid & 127, tq = __builtin_amdgcn_readfirstlane(tid >> 7);
      for (int k = 0; k < 32; ++k) { const int t = tq + 4 * k; const float* wrow = W + ((size_t)g * 128 + t) * 128; float a = 0.f;
          for (int s = 0; s <= t; ++s) a += wrow[s] * vn[s * 128 + c];
          const float u = bf2f(UV[(t0 + t) * 1024 + g * 128 + c]);
          MIX[(t0 + t) * 1024 + 512 + g * 128 + c] = f2bf(u * (a + bs[g * 128 + t])); } }
    __syncthreads();
}

__device__ __forceinline__ void p_route(Frame& F, unsigned char* ws, const float* X, const u64* ssq, const float* gain, const float* router, unsigned* cnt) {
    F.refresh();
    LAS float* RW = (LAS float*)F.lds;
    LAS int* hist = (LAS int*)(F.lds + 32768);
    LAS int* gbase = (LAS int*)(F.lds + 32768 + 64);
    LAS int* pe = (LAS int*)(F.lds + 32768 + 128);
    LAS float* pwt = (LAS float*)(F.lds + 32768 + 128 + 1024);
    int* TE = (int*)(ws + T_TE); int* TP = (int*)(ws + T_TP); float* TW = (float*)(ws + T_TW);
    for (int idx = F.tid; idx < 8192; idx += 512) { const int k = idx >> 3, e = idx & 7; RW[e * 1024 + k] = router[idx] * gain[k]; }
    for (int blk = F.vcu; blk < NTOK / 64; blk += F.G) {
        if (F.tid < 8) hist[F.tid] = 0;
        __syncthreads();
        for (int r = F.wave; r < 64; r += NWAVES) { const int t = blk * 64 + r; const f32x4* xr = (const f32x4*)(X + (size_t)t * DM) + F.lane;
            float lg[8];
#pragma unroll
            for (int e = 0; e < 8; ++e) lg[e] = 0.f;
#pragma unroll
            for (int j = 0; j < 4; ++j) { const f32x4 v = xr[64 * j];
#pragma unroll
                for (int e = 0; e < 8; ++e) { const f32x4 w = *(const LAS f32x4*)(RW + e * 1024 + 256 * j + 4 * F.lane); lg[e] += (v[0] * w[0] + v[1] * w[1]) + (v[2] * w[2] + v[3] * w[3]); } }
#pragma unroll
            for (int e = 0; e < 8; ++e) lg[e] = wave_sum(lg[e]);
            if (F.lane == 0) { const float rs = rstd_of(ssq, t);
                int e1 = 0; float v1 = lg[0];
#pragma unroll
                for (int e = 1; e < 8; ++e) if (lg[e] > v1) { v1 = lg[e]; e1 = e; }
                int e2 = -1; float v2 = -INFINITY;
#pragma unroll
                for (int e = 0; e < 8; ++e) if (e != e1 && lg[e] > v2) { v2 = lg[e]; e2 = e; }
                const float w1 = 1.0f / (1.0f + __expf((v2 - v1) * rs)), w2 = 1.0f - w1;
                const int p1 = __hip_atomic_fetch_add(&hist[e1], 1, __ATOMIC_RELAXED, __HIP_MEMORY_SCOPE_WORKGROUP), p2 = __hip_atomic_fetch_add(&hist[e2], 1, __ATOMIC_RELAXED, __HIP_MEMORY_SCOPE_WORKGROUP);
                pe[r * 4 + 0] = e1; pe[r * 4 + 1] = e2; pe[r * 4 + 2] = p1; pe[r * 4 + 3] = p2; pwt[r * 2 + 0] = w1; pwt[r * 2 + 1] = w2; } }
        __syncthreads();
        if (F.tid < 8) gbase[F.tid] = (int)__hip_atomic_fetch_add(cnt + F.tid, (unsigned)hist[F.tid], RLX_AGENT);
        __syncthreads();
        if (F.tid < 64) { const int r = F.tid, t = blk * 64 + r; const int e1 = pe[r * 4 + 0], e2 = pe[r * 4 + 1];
            TE[t] = e1 | (e2 << 8); TP[2 * t] = gbase[e1] + pe[r * 4 + 2]; TP[2 * t + 1] = gbase[e2] + pe[r * 4 + 3]; TW[2 * t] = pwt[r * 2 + 0]; TW[2 * t + 1] = pwt[r * 2 + 1]; }
        __syncthreads();
    }
}
__device__ __forceinline__ void moe_offsets(const unsigned* cnt, int (&off)[9], int (&cn)[8]) {
    int a = 0;
#pragma unroll
    for (int e = 0; e < 8; ++e) { cn[e] = (int)__hip_atomic_load(cnt + e, RLX_AGENT); off[e] = a; a += (cn[e] + 255) & ~255; }
    off[8] = a;
}
__device__ __forceinline__ void p_gather(Frame& F, unsigned char* ws, const u64* ssq, const unsigned* cnt) {
    F.refresh();
    int off[9], cn[8]; moe_offsets(cnt, off, cn);
    const bf16_t* XB = (const bf16_t*)(ws + WS_XB); bf16_t* HS = (bf16_t*)(ws + R_HS);
    const int* TE = (const int*)(ws + T_TE); const int* TP = (const int*)(ws + T_TP); const float* TW = (const float*)(ws + T_TW);
    int* PAIR = (int*)(ws + T_PAIR); float* DGATE = (float*)(ws + T_DGATE); float* DRS = (float*)(ws + T_DRS);
    const int gw = F.vcu * NWAVES + F.wave, NGW = F.G * NWAVES;
    for (int t = gw; t < NTOK; t += NGW) { const int te = TE[t]; const float rs = rstd_of(ssq, t);
        const u32x4 a0 = *((const u32x4*)(XB + (size_t)t * DM) + F.lane), a1 = *((const u32x4*)(XB + (size_t)t * DM) + 64 + F.lane);
#pragma unroll
        for (int k = 0; k < 2; ++k) { const int e = (te >> (8 * k)) & 255; int o = 0;
#pragma unroll
            for (int q = 0; q < 8; ++q) o = (q == e) ? off[q] : o;
            const int dest = o + TP[2 * t + k];
            *((u32x4*)(HS + (size_t)dest * DM) + F.lane) = a0; *((u32x4*)(HS + (size_t)dest * DM) + 64 + F.lane) = a1;
            if (F.lane == 0) { PAIR[2 * t + k] = dest; DGATE[dest] = TW[2 * t + k]; DRS[dest] = rs; } } }
#pragma unroll
    for (int e = 0; e < 8; ++e) { const int lo = off[e] + cn[e], hi = off[e + 1];
        for (int r = lo + gw; r < hi; r += NGW) { *((u32x4*)(HS + (size_t)r * DM) + F.lane) = (u32x4){0u, 0u, 0u, 0u}; *((u32x4*)(HS + (size_t)r * DM) + 64 + F.lane) = (u32x4){0u, 0u, 0u, 0u};
            if (F.lane == 0) { DGATE[r] = 0.f; DRS[r] = 0.f; } } }
}
__device__ __forceinline__ void p_combine(Frame& F, unsigned char* ws, float* X, u64* ssq_next, const float* fnorm, bool final_) {
    F.refresh();
    const bf16_t* Y = (const bf16_t*)(ws + R_Y); bf16_t* XB = (bf16_t*)(ws + WS_XB); const int* PAIR = (const int*)(ws + T_PAIR);
    const int gw = F.vcu * NWAVES + F.wave, NGW = F.G * NWAVES;
    for (int t = gw; t < NTOK; t += NGW) { const int p1 = PAIR[2 * t], p2 = PAIR[2 * t + 1];
        f32x4* xr = (f32x4*)(X + (size_t)t * DM) + F.lane; const u32x2* y1 = (const u32x2*)(Y + (size_t)p1 * DM) + F.lane; const u32x2* y2 = (const u32x2*)(Y + (size_t)p2 * DM) + F.lane;
        f32x4 v[4]; float s = 0.f;
#pragma unroll
        for (int j = 0; j < 4; ++j) { const f32x4 x = xr[64 * j]; const u32x2 a = y1[64 * j], bb = y2[64 * j];
            f32x4 o; o[0] = x[0] + bflo(a.x) + bflo(bb.x); o[1] = x[1] + bfhi(a.x) + bfhi(bb.x); o[2] = x[2] + bflo(a.y) + bflo(bb.y); o[3] = x[3] + bfhi(a.y) + bfhi(bb.y);
            v[j] = o; s += (o[0] * o[0] + o[1] * o[1]) + (o[2] * o[2] + o[3] * o[3]); }
        s = wave_sum(s);
        if (!final_) {
#pragma unroll
            for (int j = 0; j < 4; ++j) { xr[64 * j] = v[j]; u32x2 w; w.x = cvt_pk_bf16(v[j][0], v[j][1]); w.y = cvt_pk_bf16(v[j][2], v[j][3]); *((u32x2*)(XB + (size_t)t * DM) + F.lane + 64 * j) = w; }
            if (F.lane == 0) ssq_next[t] = ssq_fix(s);
        } else { const float rs = rsqrtf(s * (1.0f / DM) + EPS);
#pragma unroll
            for (int j = 0; j < 4; ++j) { const f32x4 g = *((const f32x4*)fnorm + F.lane + 64 * j); xr[64 * j] = v[j] * rs * g; } }
    }
}

constexpr int NPH = 31;
struct Args { const float* in[28]; float* out; unsigned char* ws; int ph_lo, ph_hi; };
__global__ void __launch_bounds__(NWAVES * 64, 2) mk_fwd(Args args) {
    extern __shared__ __attribute__((aligned(16))) unsigned char lds_raw[];
    Frame F;
    F.lds = (LAS unsigned char*)lds_raw;
    F.refresh();
    F.G = gridDim.x; { const int bx = blockIdx.x; F.vcu = (F.G % 8 == 0) ? (bx % 8) * (F.G / 8) + bx / 8 : bx; }
    unsigned char* ws = args.ws;
    F.ctl = (unsigned*)(ws + WS_CTL);
    volatile LAS unsigned* MISC = (volatile LAS unsigned*)(F.lds + MISC_OFF);
    for (int u = F.tid; u < (LDS_BYTES - LDSCTL_OFF) / 4; u += NWAVES * 64) ((LAS unsigned*)(F.lds + LDSCTL_OFF))[u] = 0u;
    __syncthreads();
    const int lo = args.ph_lo, hi = args.ph_hi;
    XcdBarrier bar = xcd_barrier_post(F.ctl + CW_BAR + lo * XCD_BAR_WORDS, MISC + 8);
#ifndef PH_MASK
#define PH_MASK 0xFFFF
#endif
#define PT(t) (((PH_MASK) >> (t)) & 1)
#define IN(k) (lo <= (k) && (k) < hi)
#define SEAM(k) do { if ((k) + 1 < hi) xcd_barrier(bar); } while (0)
    const float* const* in = args.in;
    float* X = args.out;
    u64* SSQ = (u64*)(ws + WS_SSQ);
    bf16_t* XB = (bf16_t*)(ws + WS_XB);
    const int bx = (int)blockIdx.x;

    if (PT(0) && IN(0)) { asm volatile("; PHASE_MARK 0"); p0_prologue(F, in, ws); SEAM(0); }

    for (int lp = 0; lp < 2; ++lp) {
        const int pb = 1 + 15 * lp;
        bf16_t* WE = (bf16_t*)(ws + WS_WE) + (size_t)lp * E_SIZE; bf16_t* WO = (bf16_t*)(ws + WS_WO) + (size_t)lp * O_SIZE;
        u64* ssq0 = SSQ + (size_t)(4 * lp) * NTOK;
        if (PT(1) && IN(pb + 0)) { asm volatile("; PHASE_MARK 1");
            pg8::DenseOrder S; S.init(XB, DM, WE + E_WIN, DM, NTOK, 1024, F.G, bx);
            pg8::EpiZ E{(bf16_t*)(ws + R_Z), 1024, ssq0};
            pg8::gemm_phase(F.lds, pg8::Gemm{DM, DM, DM}, S, E);
            SEAM(pb + 0);
        }
        if (PT(2) && IN(pb + 1)) { asm volatile("; PHASE_MARK 2"); p_even_mid(F, ws); SEAM(pb + 1); }
        if (PT(3) && IN(pb + 2)) { asm volatile("; PHASE_MARK 3");
            { pg8::DenseOrder S; S.init((const bf16_t*)(ws + R_Z) + 512, 1024, WE + E_WQ, 256, NTOK, 768, F.G, bx);
              pg8::EpiQ E{(bf16_t*)(ws + R_Q), (const float*)(ws + T_RQ), (const float*)(ws + T_COS), (const float*)(ws + T_SIN)};
              pg8::gemm_phase(F.lds, pg8::Gemm{1024, 256, 256}, S, E); }
            { pg8::DenseOrder S; S.init((const bf16_t*)(ws + R_Z) + 768, 1024, WE + E_WKV, 256, NTOK, 1024, F.G, bx);
              pg8::EpiKV E{(bf16_t*)(ws + R_K), (bf16_t*)(ws + R_V), (const float*)(ws + T_RKV)};
              pg8::gemm_phase(F.lds, pg8::Gemm{1024, 256, 256}, S, E); }
            SEAM(pb + 2);
        }
        if (PT(4) && IN(pb + 3)) { asm volatile("; PHASE_MARK 4");
            const bf16_t* Q = (const bf16_t*)(ws + R_Q); const bf16_t* Kb = (const bf16_t*)(ws + R_K); const bf16_t* Vb = (const bf16_t*)(ws + R_V); bf16_t* MIX = (bf16_t*)(ws + R_MIX);
            for (int pi = F.vcu; pi < 256; pi += F.G) { const int bh = pi >> 3, s = pi & 7, b = bh >> 3, h = bh & 7;
#pragma unroll 1
                for (int k = 0; k < 2; ++k) { const int qb = k == 0 ? (15 - s) : s;
                    attn_unit<96, false>(Q + 96 * h, 768, Kb + 96 * h, 768, Vb + 64 * h, 512, MIX + 512 + 64 * h, 1024, b, qb, F.lds, nullptr); } }
            SEAM(pb + 3);
        }
        if (PT(5) && IN(pb + 4)) { asm volatile("; PHASE_MARK 5");
            pg8::DenseOrder S; S.init((const bf16_t*)(ws + R_MIX), 1024, WE + E_WOUT, 1024, NTOK, 1024, F.G, bx);
            pg8::EpiRes E{lp == 0 ? in[0] : X, X, XB, ssq0 + NTOK};
            pg8::gemm_phase(F.lds, pg8::Gemm{1024, 1024, 1024}, S, E);
            SEAM(pb + 4);
        }
        if (PT(6) && IN(pb + 5)) { asm volatile("; PHASE_MARK 6");
            pg8::DenseOrder S; S.init(XB, DM, WE + E_WGU, DM, NTOK, 2 * FF, F.G, bx);
            pg8::EpiSwiGLU<0> E{(bf16_t*)(ws + R_ACT), FF, ssq0 + NTOK};
            pg8::gemm_phase(F.lds, pg8::Gemm{DM, DM, DM}, S, E);
            SEAM(pb + 5);
        }
        if (PT(7) && IN(pb + 6)) { asm volatile("; PHASE_MARK 7");
            pg8::DenseOrder S; S.init((const bf16_t*)(ws + R_ACT), FF, WE + E_WDN, FF, NTOK, 1024, F.G, bx);
            pg8::EpiRes E{X, X, XB, ssq0 + 2 * NTOK};
            pg8::gemm_phase(F.lds, pg8::Gemm{FF, FF, FF}, S, E);
            SEAM(pb + 6);
        }
        if (PT(8) && IN(pb + 7)) { asm volatile("; PHASE_MARK 8");
            pg8::DenseOrder S; S.init(XB, DM, WO + O_WIN, DM, NTOK, 2560, F.G, bx);
            pg8::EpiOddIn E{(bf16_t*)(ws + R_QKV), (bf16_t*)(ws + R_UV), ssq0 + 2 * NTOK};
            pg8::gemm_phase(F.lds, pg8::Gemm{DM, DM, DM}, S, E);
            SEAM(pb + 7);
        }
        if (PT(9) && IN(pb + 8)) { asm volatile("; PHASE_MARK 9");
            const bf16_t* QKV = (const bf16_t*)(ws + R_QKV); const bf16_t* UV = (const bf16_t*)(ws + R_UV); bf16_t* MIX = (bf16_t*)(ws + R_MIX);
            const float* rb = in[16] + (size_t)lp * 8 * 257;
            for (int u = F.vcu; u < 512; u += F.G) { const int bh = u >> 4, qb = u & 15, b = bh >> 3, h = bh & 7;
                attn_unit<64, true>(QKV + 64 * h, 1536, QKV + 512 + 64 * h, 1536, QKV + 1024 + 64 * h, 1536, MIX + 64 * h, 1024, b, qb, F.lds, rb + h * 257); }
            for (int u = F.vcu; u < 512; u += F.G) { const int g = u & 3, n = (u >> 2) & 31, b = u >> 7;
                sgu_unit(UV, in[17] + (size_t)lp * 512, in[18] + (size_t)lp * 512, in[19] + (size_t)lp * 4 * 128 * 128, in[20] + (size_t)lp * 512, MIX, b, n, g, F.lds); }
            SEAM(pb + 8);
        }
        if (PT(10) && IN(pb + 9)) { asm volatile("; PHASE_MARK 10");
            pg8::DenseOrder S; S.init((const bf16_t*)(ws + R_MIX), 1024, WO + O_WOUT, 1024, NTOK, 1024, F.G, bx);
            pg8::EpiRes E{X, X, XB, ssq0 + 3 * NTOK};
            pg8::gemm_phase(F.lds, pg8::Gemm{1024, 1024, 1024}, S, E);
            SEAM(pb + 9);
        }
        unsigned* cnt = F.ctl + CW_CNT + 64 * lp;
        if (PT(11) && IN(pb + 10)) { asm volatile("; PHASE_MARK 11"); p_route(F, ws, X, ssq0 + 3 * NTOK, in[22] + (size_t)lp * 1024, in[23] + (size_t)lp * 8192, cnt); SEAM(pb + 10); }
        if (PT(12) && IN(pb + 11)) { asm volatile("; PHASE_MARK 12"); p_gather(F, ws, ssq0 + 3 * NTOK, cnt); SEAM(pb + 11); }
        if (PT(13) && IN(pb + 12)) { asm volatile("; PHASE_MARK 13");
            int off[9], cn[8]; moe_offsets(cnt, off, cn);
            pg8::MoeOrder S; S.A = (const char*)(ws + R_HS); S.Bt = (const char*)(WO + O_WGU); S.bstride = (size_t)2 * EFF * 1024 * 2; S.lda = 1024; S.ldb = 1024; S.nM = off[8] >> 8; S.nN = 2 * EFF / 256; S.G = F.G; S.c = bx;
#pragma unroll
            for (int e = 0; e < 8; ++e) S.tend[e] = off[e + 1] >> 8;
            pg8::EpiSwiGLU<1> E{(bf16_t*)(ws + R_ACT2), EFF, (const float*)(ws + T_DRS)};
            pg8::gemm_phase(F.lds, pg8::Gemm{1024, 1024, 1024}, S, E);
            SEAM(pb + 12);
        }
        if (PT(14) && IN(pb + 13)) { asm volatile("; PHASE_MARK 14");
            int off[9], cn[8]; moe_offsets(cnt, off, cn);
            pg8::MoeOrder S; S.A = (const char*)(ws + R_ACT2); S.Bt = (const char*)(WO + O_WDN); S.bstride = (size_t)1024 * EFF * 2; S.lda = EFF; S.ldb = EFF; S.nM = off[8] >> 8; S.nN = 4; S.G = F.G; S.c = bx;
#pragma unroll
            for (int e = 0; e < 8; ++e) S.tend[e] = off[e + 1] >> 8;
            pg8::EpiY E{(bf16_t*)(ws + R_Y), (const float*)(ws + T_DGATE)};
            pg8::gemm_phase(F.lds, pg8::Gemm{EFF, EFF, EFF}, S, E);
            SEAM(pb + 13);
        }
        if (PT(15) && IN(pb + 14)) { asm volatile("; PHASE_MARK 15"); p_combine(F, ws, X, ssq0 + 4 * NTOK, in[27], lp == 1); SEAM(pb + 14); }
    }
#undef IN
#undef SEAM
}

extern "C" void kernel_launch(void* const* d_in, const int* in_sizes, int n_in, void* d_out, int out_size, void* d_ws, size_t ws_size, hipStream_t stream) {
    static int grid = 0;
    if (grid == 0) {
        if (n_in != 28 || in_sizes[0] != NTOK * DM || out_size != NTOK * DM || ws_size < WS_END) { fprintf(stderr, "kernel_launch: unexpected shapes / workspace (%d inputs, ws %zu, need %zu); nothing launched\n", n_in, ws_size, (size_t)WS_END); grid = -1; return; }
        int dev = 0, cus = 0, per_cu = 0;
        if (hipGetDevice(&dev) != hipSuccess || hipDeviceGetAttribute(&cus, hipDeviceAttributeMultiprocessorCount, dev) != hipSuccess) { grid = -1; return; }
        if (hipFuncSetAttribute((const void*)mk_fwd, hipFuncAttributeMaxDynamicSharedMemorySize, LDS_BYTES) != hipSuccess) { fprintf(stderr, "kernel_launch: hipFuncSetAttribute failed\n"); grid = -1; return; }
        if (hipOccupancyMaxActiveBlocksPerMultiprocessor(&per_cu, (const void*)mk_fwd, NWAVES * 64, LDS_BYTES) != hipSuccess || per_cu < 1) fprintf(stderr, "kernel_launch: occupancy query reports %d\n", per_cu);
        (void)hipGetLastError();
        grid = cus;
        if (grid > 256) grid = 256;
        grid &= ~7;
    }
    if (grid <= 0) return;
    if (hipMemsetAsync((char*)d_ws + WS_CTL, 0, CTL_ZERO_BYTES, stream) != hipSuccess) return;
    Args a{};
    for (int i = 0; i < 28; ++i) a.in[i] = (const float*)d_in[i];
    a.out = (float*)d_out; a.ws = (unsigned char*)d_ws;
#if MK_N_LAUNCHES == 1
    a.ph_lo = 0; a.ph_hi = NPH;
    hipLaunchKernelGGL(mk_fwd, dim3(grid), dim3(NWAVES * 64), LDS_BYTES, stream, a);
#else
    for (int p = 0; p < NPH; ++p) { a.ph_lo = p; a.ph_hi = p + 1; hipLaunchKernelGGL(mk_fwd, dim3(grid), dim3(NWAVES * 64), LDS_BYTES, stream, a); }
#endif
}
```

```cpp
#include <hip/hip_runtime.h>
#include <cstdio>
#include <cstdint>

#ifndef MK_N_LAUNCHES
#define MK_N_LAUNCHES 1
#endif

#define LAS __attribute__((address_space(3)))
#define GAS __attribute__((address_space(1)))
typedef unsigned short bf16_t;
typedef short bf16x8 __attribute__((ext_vector_type(8)));
typedef short s16x4 __attribute__((ext_vector_type(4)));
typedef float f32x4 __attribute__((ext_vector_type(4)));
typedef float f32x2 __attribute__((ext_vector_type(2)));
typedef float f32x16 __attribute__((ext_vector_type(16)));
typedef unsigned u32x4 __attribute__((ext_vector_type(4)));
typedef unsigned u32x2 __attribute__((ext_vector_type(2)));

constexpr int NTOK = 16384, DM = 1024, SEQ = 4096;
constexpr float EPS = 1e-6f;
constexpr float LOG2E = 1.4426950408889634f;
constexpr float QS_MLA = 0.10206207261596575f * LOG2E;
constexpr float QS_BAND = 0.125f * LOG2E;
constexpr int FF = 2816, EFF = 3584, NEXP = 8;
constexpr int MOE_ROWS = 34816;

constexpr size_t MiB = 1u << 20, KiB = 1024;
constexpr size_t WS_CTL = 0, CTL_ZERO_BYTES = 3 * MiB;
constexpr int CW_TMO = 0, CW_CNT = 64, CW_BAR = 4096;
constexpr size_t WS_SSQ = 1 * MiB;
constexpr size_t WS_TAB = 3 * MiB;
constexpr size_t T_COS = WS_TAB, T_SIN = WS_TAB + 256 * KiB, T_RQ = WS_TAB + 512 * KiB, T_RKV = WS_TAB + 576 * KiB, T_TE = WS_TAB + 640 * KiB,
                 T_TP = WS_TAB + 704 * KiB, T_TW = WS_TAB + 832 * KiB, T_PAIR = WS_TAB + 960 * KiB, T_DGATE = WS_TAB + 1088 * KiB, T_DRS = WS_TAB + 1280 * KiB;
constexpr size_t WS_W = 5 * MiB;
constexpr size_t E_WIN = 0, E_WQ = 1048576, E_WKV = 1245184, E_WOUT = 1507328, E_WGU = 2555904, E_WDN = 8323072, E_SIZE = 11206656;
constexpr size_t O_WIN = 0, O_WOUT = 2621440, O_WGU = 3670016, O_WDN = 62390272, O_SIZE = 91750400;
constexpr size_t WS_WE = WS_W, WS_WO = WS_W + 2 * E_SIZE * 2;
static_assert(WS_WO + 2 * O_SIZE * 2 <= 400 * MiB, "weights");
constexpr size_t WS_XB = 400 * MiB;
constexpr size_t WS_R = 432 * MiB;
constexpr size_t R_Z = WS_R, R_Q = WS_R + 32 * MiB, R_K = WS_R + 56 * MiB, R_V = WS_R + 80 * MiB, R_MIX = WS_R + 96 * MiB, R_ACT = WS_R;
constexpr size_t R_QKV = WS_R, R_UV = WS_R + 48 * MiB, R_HS = WS_R, R_ACT2 = WS_R + 68 * MiB, R_Y = WS_R;
constexpr size_t WS_END = WS_R + 306 * MiB;
static_assert((size_t)MOE_ROWS * EFF * 2 <= 238 * MiB && (size_t)MOE_ROWS * 1024 * 2 <= 68 * MiB, "moe buffers");

constexpr int RING_BYTES = 131072, LDSCTL_OFF = RING_BYTES, MISC_OFF = LDSCTL_OFF + 320, LDS_BYTES = 147456;
constexpr int NWAVES = 8;

#define RLX_AGENT __ATOMIC_RELAXED, __HIP_MEMORY_SCOPE_AGENT
#define LDS_WAIT() asm volatile("s_waitcnt lgkmcnt(0)" ::: "memory")
#define VM_WAIT() asm volatile("s_waitcnt vmcnt(0)" ::: "memory")

__device__ __forceinline__ unsigned cvt_pk_bf16(float lo, float hi) { unsigned r; asm volatile("v_cvt_pk_bf16_f32 %0, %1, %2" : "=v"(r) : "v"(lo), "v"(hi)); return r; }
__device__ __forceinline__ float bf2f(unsigned short b) { return __uint_as_float(((unsigned)b) << 16); }
__device__ __forceinline__ float bflo(unsigned w) { return __uint_as_float(w << 16); }
__device__ __forceinline__ float bfhi(unsigned w) { return __uint_as_float(w & 0xffff0000u); }
__device__ __forceinline__ unsigned short f2bf(float f) { return (unsigned short)(cvt_pk_bf16(f, 0.f) & 0xffffu); }
__device__ __forceinline__ float wave_sum(float v) {
#pragma unroll
    for (int o = 1; o < 64; o <<= 1) v += __shfl_xor(v, o);
    return v;
}
typedef unsigned long long u64;
__device__ __forceinline__ u64 ssq_fix(float s) { return (u64)((double)s * 4294967296.0); }
__device__ __forceinline__ float ssq_get(const u64* p, int row) { return (float)((double)p[row] * (1.0 / 4294967296.0)); }
__device__ __forceinline__ float rstd_of(const u64* p, int row) { return rsqrtf(ssq_get(p, row) * (1.0f / DM) + EPS); }
__device__ __forceinline__ float fast_exp2(float x) { return __builtin_amdgcn_exp2f(x); }
__device__ __forceinline__ float fast_rcp(float x) { return __builtin_amdgcn_rcpf(x); }
__device__ __forceinline__ float sigmoidf_(float x) { return fast_rcp(1.0f + fast_exp2(-x * LOG2E)); }

__device__ __forceinline__ int opaque_tid() { int t = threadIdx.x; asm volatile("" : "+v"(t)); return t; }

namespace pg8 {
constexpr int BM = 256, BK = 64, HALF = 128, HTB = HALF * BK * 2, STAGE_BYTES = 8 * HTB, NXCD = 8, WGM = 8;
__host__ __device__ __forceinline__ int lds_byte(int r, int c) { const int st = (r >> 4) * 2 + (c >> 5), rr = r & 15, cc = c & 31, ob = rr * 64 + cc * 2; return st * 1024 + (ob ^ (((ob >> 9) & 1) << 5)); }
__host__ __device__ __forceinline__ void stage_rc(int b, int& R, int& C) { const int st = b / 1024, sb = b % 1024, swz = sb ^ (((sb >> 9) & 1) << 5); R = (st >> 1) * 16 + swz / 64; C = (st & 1) * 32 + (swz % 64) / 2; }
__host__ __device__ __forceinline__ int perm32(int rho) { const int n = rho >> 4, i = rho & 15; return 8 * (i >> 2) + 4 * n + (i & 3); }

struct Unit { int pm, pn; const char* a; const char* b; };
struct Gemm { int lda, ldb, K; };

__device__ __forceinline__ void tile_of(int L, int nM, int nN, int& pm, int& pn) {
    const int nwg = nM * nN;
    int wgid = L; { const int q = nwg / NXCD, r = nwg % NXCD, xcd = wgid % NXCD, off = wgid / NXCD; wgid = (xcd < r ? xcd * (q + 1) : r * (q + 1) + (xcd - r) * q) + off; }
    const int nig = WGM * nN, gid = wgid / nig, fm = gid * WGM, gsz = (nM - fm) < WGM ? (nM - fm) : WGM;
    pm = fm + ((wgid % nig) % gsz); pn = (wgid % nig) / gsz;
}
struct DenseOrder {
    const char* A; const char* Bt; int lda, ldb, nM, nN, G, c;
    __device__ __forceinline__ void init(const void* A_, int lda_, const void* Bt_, int ldb_, int M, int N, int G_, int c_) { A = (const char*)A_; Bt = (const char*)Bt_; lda = lda_; ldb = ldb_; nM = M / BM; nN = N / BM; G = G_; c = c_; }
    __device__ __forceinline__ bool next(int i, Unit& u) const {
        const long L = (long)i * G + c; if (L >= (long)nM * nN) return false;
        tile_of((int)L, nM, nN, u.pm, u.pn);
        u.a = A + (size_t)u.pm * BM * lda * 2; u.b = Bt + (size_t)u.pn * BM * ldb * 2; return true;
    }
};
struct MoeOrder {
    const char* A; const char* Bt; size_t bstride; int lda, ldb, nM, nN, G, c; int tend[8];
    __device__ __forceinline__ bool next(int i, Unit& u) const {
        const long L = (long)i * G + c; if (L >= (long)nM * nN) return false;
        tile_of((int)L, nM, nN, u.pm, u.pn);
        int e = 0;
#pragma unroll
        for (int k = 0; k < 7; ++k) e += (u.pm >= tend[k]) ? 1 : 0;
        u.a = A + (size_t)u.pm * BM * lda * 2; u.b = Bt + (size_t)e * bstride + (size_t)u.pn * BM * ldb * 2; return true;
    }
};

template <class Epi, class Sched, bool ALIGN_EPI = true>
__device__ __forceinline__ void gemm_phase(LAS unsigned char* lds, const Gemm g, const Sched& S, const Epi& E) {
    const int tid = opaque_tid(), wid = __builtin_amdgcn_readfirstlane(tid >> 6), lane = tid & 63, wr = wid >> 2, wc = wid & 3, fr = lane & 15, fq = lane >> 4;
    int K = g.K; asm volatile("" : "+s"(K));
    const int nt = K / BK;
    unsigned voffA[2], voffB[2];
#pragma unroll
    for (int i = 0; i < 2; ++i) { int R, C; stage_rc(tid * 16 + i * 8192, R, C); const int Rb = Epi::PERM ? ((R & ~31) + perm32(R & 31)) : R;
        voffA[i] = (unsigned)(R * g.lda + C) * 2u; voffB[i] = (unsigned)(Rb * g.ldb + C) * 2u; }
    const size_t kstep = (size_t)(BK * 2);
    const size_t hstepA = (size_t)HALF * g.lda * 2, hstepB = (size_t)HALF * g.ldb * 2;
    const unsigned ldsw = (unsigned)wid * 1024u;
    const int aoff = lds_byte(wr * 64 + fr, fq * 8), boff = lds_byte(wc * 32 + fr, fq * 8);
#define PG8_SA(b, h) (((b) * 2 + (h)) * HTB)
#define PG8_SB(b, h) ((4 + (b) * 2 + (h)) * HTB)
#define PG8_STAGE(bufoff, gbase, voff) do { _Pragma("unroll") for (int _i = 0; _i < 2; ++_i) \
        __builtin_amdgcn_global_load_lds((const unsigned*)((const char*)(gbase) + (voff)[_i]), (LAS unsigned*)(lds + (bufoff) + ldsw + _i * 8192), 16, 0, 0); } while (0)
#define PG8_LDA(dst, b, h) do { _Pragma("unroll") for (int m = 0; m < 4; ++m) _Pragma("unroll") for (int k = 0; k < 2; ++k) dst[m][k] = *(const LAS bf16x8*)(lds + PG8_SA(b, h) + aoff + m * 2048 + k * 1024); } while (0)
#define PG8_LDB(dst, b, h) do { _Pragma("unroll") for (int n = 0; n < 2; ++n) _Pragma("unroll") for (int k = 0; k < 2; ++k) dst[n][k] = *(const LAS bf16x8*)(lds + PG8_SB(b, h) + boff + n * 2048 + k * 1024); } while (0)
#define PG8_MMA(ai, bj, At, Bt) do { __builtin_amdgcn_s_setprio(1); _Pragma("unroll") for (int m = 0; m < 4; ++m) _Pragma("unroll") for (int n = 0; n < 2; ++n) _Pragma("unroll") for (int k = 0; k < 2; ++k) \
        acc[ai][bj][m][n] = __builtin_amdgcn_mfma_f32_16x16x32_bf16(Bt[n][k], At[m][k], acc[ai][bj][m][n], 0, 0, 0); __builtin_amdgcn_s_setprio(0); } while (0)
#define PG8_WAIT_V(n) asm volatile("s_waitcnt vmcnt(" #n ")" ::: "memory")
#define PG8_WAIT_L(n) asm volatile("s_waitcnt lgkmcnt(" #n ")" ::: "memory")
#define PG8_BAR __builtin_amdgcn_s_barrier()
#define PG8_SCHED __builtin_amdgcn_sched_barrier(0)
    Unit cur, nxt; int ui = 0;
    if (!S.next(0, cur)) return;
    f32x4 acc[2][2][4][2];
#pragma unroll
    for (int a = 0; a < 2; ++a)
#pragma unroll
        for (int b = 0; b < 2; ++b)
#pragma unroll
            for (int m = 0; m < 4; ++m)
#pragma unroll
                for (int n = 0; n < 2; ++n) acc[a][b][m][n] = (f32x4){0.f, 0.f, 0.f, 0.f};
    bf16x8 At[4][2], B0[2][2], B1[2][2];
    const char* cA = cur.a; const char* cB = cur.b;
    PG8_STAGE(PG8_SB(0, 0), cB, voffB); PG8_STAGE(PG8_SB(0, 1), cB + hstepB, voffB); PG8_STAGE(PG8_SA(0, 0), cA, voffA); PG8_STAGE(PG8_SA(0, 1), cA + hstepA, voffA);
    if (wr == 1) PG8_BAR;
    PG8_WAIT_V(2); PG8_BAR;
    PG8_STAGE(PG8_SB(1, 0), cB + kstep, voffB); PG8_STAGE(PG8_SA(1, 0), cA + kstep, voffA); PG8_STAGE(PG8_SB(1, 1), cB + hstepB + kstep, voffB);
    PG8_WAIT_V(6); PG8_BAR;
    for (;;) {
        const bool has_next = S.next(ui + 1, nxt);
        const char* nA = has_next ? nxt.a : cA; const char* nB = has_next ? nxt.b : cB;
        for (int t = 0; t < nt; t += 2) {
            const bool last = (t == nt - 2);
            const char* a1 = cA + (size_t)(t + 1) * kstep;
            const char* a2 = last ? nA : cA + (size_t)(t + 2) * kstep; const char* b2 = last ? nB : cB + (size_t)(t + 2) * kstep;
            const char* a3 = a2 + kstep; const char* b3 = b2 + kstep;
            PG8_LDB(B0, 0, 0); PG8_LDB(B1, 0, 1); PG8_SCHED; PG8_LDA(At, 0, 0); PG8_STAGE(PG8_SA(1, 1), a1 + hstepA, voffA);
            PG8_WAIT_V(8); PG8_WAIT_L(0); PG8_BAR; PG8_MMA(0, 0, At, B0); PG8_MMA(0, 1, At, B1); PG8_BAR; PG8_SCHED;
            PG8_LDA(At, 0, 1); PG8_STAGE(PG8_SB(0, 0), b2, voffB); PG8_STAGE(PG8_SB(0, 1), b2 + hstepB, voffB); PG8_STAGE(PG8_SA(0, 0), a2, voffA);
            PG8_WAIT_V(8); PG8_WAIT_L(0); PG8_BAR; PG8_MMA(1, 0, At, B0); PG8_MMA(1, 1, At, B1); PG8_BAR; PG8_SCHED;
            PG8_LDB(B0, 1, 0); PG8_LDB(B1, 1, 1); PG8_SCHED; PG8_LDA(At, 1, 0); PG8_STAGE(PG8_SA(0, 1), a2 + hstepA, voffA);
            PG8_WAIT_V(8); PG8_WAIT_L(0); PG8_BAR; PG8_MMA(0, 0, At, B0); PG8_MMA(0, 1, At, B1); PG8_BAR; PG8_SCHED;
            PG8_LDA(At, 1, 1); PG8_STAGE(PG8_SB(1, 0), b3, voffB); PG8_STAGE(PG8_SB(1, 1), b3 + hstepB, voffB); PG8_STAGE(PG8_SA(1, 0), a3, voffA);
            PG8_WAIT_V(8); PG8_WAIT_L(0); PG8_BAR; PG8_MMA(1, 0, At, B0); PG8_MMA(1, 1, At, B1); PG8_BAR; PG8_SCHED;
        }
        if constexpr (ALIGN_EPI) { if (wr == 0) PG8_BAR; }
        { int fr_ = fr, fq_ = fq; asm volatile("" : "+v"(fr_), "+v"(fq_)); E(acc, cur, wr, wc, fr_, fq_); }
        if (!has_next) break;
#pragma unroll
        for (int a = 0; a < 2; ++a)
#pragma unroll
            for (int b = 0; b < 2; ++b)
#pragma unroll
                for (int m = 0; m < 4; ++m)
#pragma unroll
                    for (int n = 0; n < 2; ++n) acc[a][b][m][n] = (f32x4){0.f, 0.f, 0.f, 0.f};
        cur = nxt; cA = nA; cB = nB; ++ui;
        if constexpr (ALIGN_EPI) { if (wr == 1) PG8_BAR; }
    }
    PG8_WAIT_V(0);
    if constexpr (!ALIGN_EPI) { if (wr == 0) PG8_BAR; }
    PG8_BAR;
#undef PG8_SA
#undef PG8_SB
#undef PG8_STAGE
#undef PG8_LDA
#undef PG8_LDB
#undef PG8_MMA
#undef PG8_WAIT_V
#undef PG8_WAIT_L
#undef PG8_BAR
#undef PG8_SCHED
}

typedef f32x4 Acc[2][2][4][2];

struct EpiZ { static constexpr bool PERM = true;
    bf16_t* O; int ldc; const u64* ssq;
    __device__ __forceinline__ void operator()(const Acc& acc, const Unit& u, int wr, int wc, int fr, int fq) const {
        const int row0 = u.pm * BM + wr * 64 + fr, col0 = u.pn * BM + wc * 32 + 8 * fq;
#pragma unroll
        for (int ai = 0; ai < 2; ++ai)
#pragma unroll
            for (int m = 0; m < 4; ++m) { const int row = row0 + ai * HALF + m * 16; const float rs = rstd_of(ssq, row);
                bf16_t* rowp = O + (size_t)row * ldc + col0;
#pragma unroll
                for (int bj = 0; bj < 2; ++bj) { const f32x4 v0 = acc[ai][bj][m][0] * rs, v1 = acc[ai][bj][m][1] * rs;
                    u32x4 w; w.x = cvt_pk_bf16(v0[0], v0[1]); w.y = cvt_pk_bf16(v0[2], v0[3]); w.z = cvt_pk_bf16(v1[0], v1[1]); w.w = cvt_pk_bf16(v1[2], v1[3]);
                    *(u32x4*)(rowp + bj * HALF) = w; } }
    }
};
struct EpiQ { static constexpr bool PERM = false;
    bf16_t* O; const float* rq; const float* cosT; const float* sinT;
    __device__ __forceinline__ void operator()(const Acc& acc, const Unit& u, int wr, int wc, int fr, int fq) const {
        const int row0 = u.pm * BM + wr * 64 + fr;
#pragma unroll
        for (int ai = 0; ai < 2; ++ai)
#pragma unroll
            for (int m = 0; m < 4; ++m) { const int row = row0 + ai * HALF + m * 16; const float rs = rq[row] * QS_MLA; const int pos = row & (SEQ - 1);
                const f32x4 cs = *(const f32x4*)(cosT + pos * 16 + 4 * fq), sn = *(const f32x4*)(sinT + pos * 16 + 4 * fq);
#pragma unroll
                for (int bj = 0; bj < 2; ++bj) { const int cb = u.pn * BM + bj * HALF + wc * 32; const bool rope = ((cb >> 5) % 3) == 2;
                    f32x4 v0 = acc[ai][bj][m][0] * rs, v1 = acc[ai][bj][m][1] * rs;
                    if (rope) { const f32x4 o0 = v0 * cs - v1 * sn, o1 = v1 * cs + v0 * sn; v0 = o0; v1 = o1; }
                    u32x2 w0, w1; w0.x = cvt_pk_bf16(v0[0], v0[1]); w0.y = cvt_pk_bf16(v0[2], v0[3]); w1.x = cvt_pk_bf16(v1[0], v1[1]); w1.y = cvt_pk_bf16(v1[2], v1[3]);
                    bf16_t* p = O + (size_t)row * 768 + cb + 4 * fq;
                    *(u32x2*)(p) = w0; *(u32x2*)(p + 16) = w1; } }
    }
};
struct EpiKV { static constexpr bool PERM = true;
    bf16_t* Kb; bf16_t* Vb; const float* rkv;
    __device__ __forceinline__ void operator()(const Acc& acc, const Unit& u, int wr, int wc, int fr, int fq) const {
        const int row0 = u.pm * BM + wr * 64 + fr;
#pragma unroll
        for (int ai = 0; ai < 2; ++ai)
#pragma unroll
            for (int m = 0; m < 4; ++m) { const int row = row0 + ai * HALF + m * 16; const float rs = rkv[row];
#pragma unroll
                for (int bj = 0; bj < 2; ++bj) { const int h = 2 * u.pn + bj; const f32x4 v0 = acc[ai][bj][m][0] * rs, v1 = acc[ai][bj][m][1] * rs;
                    u32x4 w; w.x = cvt_pk_bf16(v0[0], v0[1]); w.y = cvt_pk_bf16(v0[2], v0[3]); w.z = cvt_pk_bf16(v1[0], v1[1]); w.w = cvt_pk_bf16(v1[2], v1[3]);
                    bf16_t* p = (wc < 2) ? (Kb + (size_t)row * 768 + 96 * h + 32 * wc + 8 * fq) : (Vb + (size_t)row * 512 + 64 * h + 32 * (wc - 2) + 8 * fq);
                    *(u32x4*)p = w; } }
    }
};
struct EpiRes { static constexpr bool PERM = false;
    const float* base; float* X; bf16_t* XB; u64* ssq_next;
    __device__ __forceinline__ void operator()(const Acc& acc, const Unit& u, int wr, int wc, int fr, int fq) const {
        const int row0 = u.pm * BM + wr * 64 + fr, col0 = u.pn * BM + wc * 32 + 4 * fq;
#pragma unroll
        for (int ai = 0; ai < 2; ++ai)
#pragma unroll
            for (int m = 0; m < 4; ++m) { const int row = row0 + ai * HALF + m * 16; const size_t off = (size_t)row * DM + col0; float s = 0.f;
#pragma unroll
                for (int bj = 0; bj < 2; ++bj)
#pragma unroll
                    for (int n = 0; n < 2; ++n) { const f32x4 o = *(const f32x4*)(base + off + bj * HALF + n * 16) + acc[ai][bj][m][n];
                        *(f32x4*)(X + off + bj * HALF + n * 16) = o; s += (o[0] * o[0] + o[1] * o[1]) + (o[2] * o[2] + o[3] * o[3]);
                        u32x2 w; w.x = cvt_pk_bf16(o[0], o[1]); w.y = cvt_pk_bf16(o[2], o[3]); *(u32x2*)(XB + off + bj * HALF + n * 16) = w; }
                s += __shfl_xor(s, 16); s += __shfl_xor(s, 32);
                if (fq == 0) __hip_atomic_fetch_add(ssq_next + row, ssq_fix(s), RLX_AGENT);
                asm volatile("" ::: "memory"); }
    }
};
template <int MODE> struct EpiSwiGLU { static constexpr bool PERM = true;
    bf16_t* O; int ldc; const void* rsrc;
    __device__ __forceinline__ void operator()(const Acc& acc, const Unit& u, int wr, int wc, int fr, int fq) const {
        const int row0 = u.pm * BM + wr * 64 + fr, col0 = u.pn * HALF + wc * 32 + 8 * fq;
#pragma unroll
        for (int ai = 0; ai < 2; ++ai)
#pragma unroll
            for (int m = 0; m < 4; ++m) { const int row = row0 + ai * HALF + m * 16; const float rs = MODE == 0 ? rstd_of((const u64*)rsrc, row) : ((const float*)rsrc)[row];
                float o[8];
#pragma unroll
                for (int n = 0; n < 2; ++n)
#pragma unroll
                    for (int i = 0; i < 4; ++i) { const float gg = acc[ai][0][m][n][i] * rs, uu = acc[ai][1][m][n][i] * rs; o[n * 4 + i] = gg * sigmoidf_(gg) * uu; }
                u32x4 w; w.x = cvt_pk_bf16(o[0], o[1]); w.y = cvt_pk_bf16(o[2], o[3]); w.z = cvt_pk_bf16(o[4], o[5]); w.w = cvt_pk_bf16(o[6], o[7]);
                *(u32x4*)(O + (size_t)row * ldc + col0) = w; }
    }
};
struct EpiOddIn { static constexpr bool PERM = true;
    bf16_t* QKV; bf16_t* UV; const u64* ssq;
    __device__ __forceinline__ void operator()(const Acc& acc, const Unit& u, int wr, int wc, int fr, int fq) const {
        const int row0 = u.pm * BM + wr * 64 + fr; const bool isuv = u.pn >= 6; const float qsc = u.pn < 2 ? QS_BAND : 1.0f;
#pragma unroll
        for (int ai = 0; ai < 2; ++ai)
#pragma unroll
            for (int m = 0; m < 4; ++m) { const int row = row0 + ai * HALF + m * 16; const float rs = rstd_of(ssq, row);
#pragma unroll
                for (int bj = 0; bj < 2; ++bj) { float o[8];
#pragma unroll
                    for (int n = 0; n < 2; ++n)
#pragma unroll
                        for (int i = 0; i < 4; ++i) { float v = acc[ai][bj][m][n][i] * rs;
                            if (isuv) { const float t = 0.7978845608028654f * (v + 0.044715f * v * v * v); v = v * sigmoidf_(2.0f * t); } else v *= qsc;
                            o[n * 4 + i] = v; }
                    u32x4 w; w.x = cvt_pk_bf16(o[0], o[1]); w.y = cvt_pk_bf16(o[2], o[3]); w.z = cvt_pk_bf16(o[4], o[5]); w.w = cvt_pk_bf16(o[6], o[7]);
                    bf16_t* p = isuv ? (UV + (size_t)row * 1024 + (u.pn - 6) * BM + bj * HALF + wc * 32 + 8 * fq) : (QKV + (size_t)row * 1536 + u.pn * BM + bj * HALF + wc * 32 + 8 * fq);
                    *(u32x4*)p = w; } }
    }
};
struct EpiY { static constexpr bool PERM = true;
    bf16_t* O; const float* gate;
    __device__ __forceinline__ void operator()(const Acc& acc, const Unit& u, int wr, int wc, int fr, int fq) const {
        const int row0 = u.pm * BM + wr * 64 + fr, col0 = u.pn * BM + wc * 32 + 8 * fq;
#pragma unroll
        for (int ai = 0; ai < 2; ++ai)
#pragma unroll
            for (int m = 0; m < 4; ++m) { const int row = row0 + ai * HALF + m * 16; const float rs = gate[row];
                bf16_t* rowp = O + (size_t)row * DM + col0;
#pragma unroll
                for (int bj = 0; bj < 2; ++bj) { const f32x4 v0 = acc[ai][bj][m][0] * rs, v1 = acc[ai][bj][m][1] * rs;
                    u32x4 w; w.x = cvt_pk_bf16(v0[0], v0[1]); w.y = cvt_pk_bf16(v0[2], v0[3]); w.z = cvt_pk_bf16(v1[0], v1[1]); w.w = cvt_pk_bf16(v1[2], v1[3]);
                    *(u32x4*)(rowp + bj * HALF) = w; } }
    }
};
}

#define XB_TMO      128
#define XB_XCNT(j)  (256  + 64 * (j))
#define XB_XSUB(j)  (1280 + 64 * (j))
#define XB_XGEN(j)  (2304 + 64 * (j))
#define XB_TOP      3328
#define XB_TOPGEN   3392
#define XCD_BAR_WORDS 3456
#define XB_SPIN_CAP (1u << 18)
__device__ __forceinline__ unsigned xb_ld(unsigned* p)              { return __hip_atomic_load(p, __ATOMIC_RELAXED, __HIP_MEMORY_SCOPE_AGENT); }
__device__ __forceinline__ unsigned xb_add(unsigned* p, unsigned v) { return __hip_atomic_fetch_add(p, v, __ATOMIC_RELAXED, __HIP_MEMORY_SCOPE_AGENT); }
__device__ __forceinline__ unsigned xb_xcc_id() { return (unsigned)__builtin_amdgcn_s_getreg((3 << 11) | 20) & 0xFu; }
#define XB_SPIN(cond, bar) do { unsigned _sp = 0; while (cond) { __builtin_amdgcn_s_sleep(1); \
    if ((++_sp & 255u) == 0u) { if (xb_ld(&(bar)[XB_TMO])) break; if (_sp > XB_SPIN_CAP) { atomicAdd(&(bar)[XB_TMO], 1u); break; } } } } while (0)
struct XcdBarrier { unsigned* bar; unsigned x; volatile LAS unsigned* st; };
__device__ __forceinline__ XcdBarrier xcd_barrier_post(unsigned* bar, volatile LAS unsigned* st) {
    XcdBarrier b; b.bar = bar; b.x = xb_xcc_id(); b.st = st;
    if (threadIdx.x == 0) (void)xb_add(&bar[XB_XCNT(b.x)], 1u);
    return b;
}
__device__ __forceinline__ void xcd_barrier_complete(unsigned* bar, unsigned x, unsigned& nloc, unsigned& nx) {
    const unsigned G = gridDim.x * gridDim.y * gridDim.z;
    unsigned sum, cnt, mine, sp = 0u;
    for (;;) {
        sum = 0u; cnt = 0u; mine = 0u;
#pragma unroll
        for (unsigned j = 0; j < 16; ++j) { const unsigned c = xb_ld(&bar[XB_XCNT(j)]); sum += c; cnt += (c > 0u) ? 1u : 0u; mine = (j == x) ? c : mine; }
        if (sum == G) break;
        __builtin_amdgcn_s_sleep(1);
        if ((++sp & 255u) == 0u) { if (xb_ld(&bar[XB_TMO])) break; if (sp > XB_SPIN_CAP) { atomicAdd(&bar[XB_TMO], 1u); break; } }
    }
    nloc = mine > 0u ? mine : 1u; nx = cnt > 0u ? cnt : 1u;
}
__device__ __forceinline__ void xcd_barrier(const XcdBarrier& b) {
    asm volatile("s_waitcnt vmcnt(0)" ::: "memory");
    __syncthreads();
    if (threadIdx.x == 0) {
        unsigned* bar = b.bar;
        __builtin_amdgcn_s_waitcnt(0);
        unsigned nloc = b.st[0], nx = b.st[1];
        if (nloc == 0u) { xcd_barrier_complete(bar, b.x, nloc, nx); b.st[0] = nloc; b.st[1] = nx; }
        const unsigned old = xb_add(&bar[XB_XSUB(b.x)], 1u);
        const unsigned gen = old / nloc;
        if (old + 1u == (gen + 1u) * nloc) {
            __builtin_amdgcn_fence(__ATOMIC_RELEASE, "agent");
            asm volatile("s_waitcnt vmcnt(0)" ::: "memory");
            const unsigned og = xb_add(&bar[XB_TOP], 1u);
            const unsigned tg = og / nx;
            if (og + 1u == (tg + 1u) * nx) xb_add(&bar[XB_TOPGEN], 1u);
            else XB_SPIN(xb_ld(&bar[XB_TOPGEN]) == tg, bar);
            __builtin_amdgcn_fence(__ATOMIC_ACQUIRE, "agent");
            xb_add(&bar[XB_XGEN(b.x)], 1u);
            asm volatile("s_waitcnt vmcnt(0)" ::: "memory");
        } else {
            XB_SPIN(xb_ld(&bar[XB_XGEN(b.x)]) == gen, bar);
            __builtin_amdgcn_fence(__ATOMIC_ACQUIRE, "agent");
            asm volatile("s_waitcnt vmcnt(0)" ::: "memory");
        }
    }
    __syncthreads();
}

struct Frame {
    LAS unsigned char* lds;
    unsigned* ctl;
    int tid, lane, wave, vcu, G;
    __device__ __forceinline__ void refresh() { tid = opaque_tid(); lane = tid & 63; wave = __builtin_amdgcn_readfirstlane(tid >> 6); }
};

struct XJob { const float* W; const float* gain; bf16_t* WT; int K, N, ldt, mode, nb; size_t sb, db; int istart; };
__device__ __forceinline__ void xpose_item(const XJob& J, int item, LAS float* scr, int lane) {
    const int nblk = J.N / 32, per = (J.K / 64) * nblk, e = item / per, r = item % per, kb = r / nblk, nbk = r % nblk, k0 = 64 * kb, n0 = 32 * nbk;
    const float* W = J.W + (size_t)e * J.sb; bf16_t* WT = J.WT + (size_t)e * J.db;
#pragma unroll 8
    for (int i = 0; i < 32; ++i) { const int kk = 2 * i + (lane >> 5); float v = W[(size_t)(k0 + kk) * J.N + n0 + (lane & 31)]; if (J.gain) v *= J.gain[k0 + kk]; scr[kk * 33 + (lane & 31)] = v; }
    LDS_WAIT(); asm volatile("" ::: "memory");
    const int c = lane & 7;
#pragma unroll
    for (int j = 0; j < 4; ++j) { const int n = (lane >> 3) + 8 * j; const LAS float* s = scr + (8 * c) * 33 + n;
        u32x4 o; o.x = cvt_pk_bf16(s[0 * 33], s[1 * 33]); o.y = cvt_pk_bf16(s[2 * 33], s[3 * 33]); o.z = cvt_pk_bf16(s[4 * 33], s[5 * 33]); o.w = cvt_pk_bf16(s[6 * 33], s[7 * 33]);
        const int ng = n0 + n; const int row = J.mode == 0 ? ng : ((ng >> 7) * 256 + (ng & 127) + (J.mode == 2 ? 128 : 0));
        *(u32x4*)(WT + (size_t)row * J.ldt + k0 + 8 * c) = o; }
    LDS_WAIT(); asm volatile("" ::: "memory");
}
constexpr int NJT = 12;
__device__ __forceinline__ void make_job(int i, int t, const float* const* in, unsigned char* ws, XJob& J) {
    J.gain = nullptr; J.mode = 0; J.nb = 1; J.sb = 0; J.db = 0; J.istart = 0;
    bf16_t* WE = (bf16_t*)(ws + WS_WE) + (size_t)i * E_SIZE; bf16_t* WO = (bf16_t*)(ws + WS_WO) + (size_t)i * O_SIZE;
    switch (t) {
    case 0: J.W = in[2] + (size_t)i * 1024 * 928; J.gain = in[1] + i * 1024; J.WT = WE + E_WIN; J.K = 1024; J.N = 928; J.ldt = 1024; break;
    case 1: J.W = in[6] + (size_t)i * 256 * 768; J.gain = in[5] + i * 256; J.WT = WE + E_WQ; J.K = 256; J.N = 768; J.ldt = 256; break;
    case 2: J.W = in[8] + (size_t)i * 128 * 1024; J.gain = in[7] + i * 128; J.WT = WE + E_WKV; J.K = 128; J.N = 1024; J.ldt = 256; break;
    case 3: J.W = in[9] + (size_t)i * 1024 * 1024 + (size_t)512 * 1024; J.WT = WE + E_WOUT + 512; J.K = 512; J.N = 1024; J.ldt = 1024; break;
    case 4: J.W = in[11] + (size_t)i * 1024 * FF; J.gain = in[10] + i * 1024; J.WT = WE + E_WGU; J.K = 1024; J.N = FF; J.ldt = 1024; J.mode = 1; break;
    case 5: J.W = in[12] + (size_t)i * 1024 * FF; J.gain = in[10] + i * 1024; J.WT = WE + E_WGU; J.K = 1024; J.N = FF; J.ldt = 1024; J.mode = 2; break;
    case 6: J.W = in[13] + (size_t)i * FF * 1024; J.WT = WE + E_WDN; J.K = FF; J.N = 1024; J.ldt = FF; break;
    case 7: J.W = in[15] + (size_t)i * 1024 * 2560; J.gain = in[14] + i * 1024; J.WT = WO + O_WIN; J.K = 1024; J.N = 2560; J.ldt = 1024; break;
    case 8: J.W = in[21] + (size_t)i * 1024 * 1024; J.WT = WO + O_WOUT; J.K = 1024; J.N = 1024; J.ldt = 1024; break;
    case 9: J.W = in[24] + (size_t)i * NEXP * 1024 * EFF; J.gain = in[22] + i * 1024; J.WT = WO + O_WGU; J.K = 1024; J.N = EFF; J.ldt = 1024; J.mode = 1; J.nb = NEXP; J.sb = (size_t)1024 * EFF; J.db = (size_t)2 * EFF * 1024; break;
    case 10: J.W = in[25] + (size_t)i * NEXP * 1024 * EFF; J.gain = in[22] + i * 1024; J.WT = WO + O_WGU; J.K = 1024; J.N = EFF; J.ldt = 1024; J.mode = 2; J.nb = NEXP; J.sb = (size_t)1024 * EFF; J.db = (size_t)2 * EFF * 1024; break;
    default: J.W = in[26] + (size_t)i * NEXP * EFF * 1024; J.WT = WO + O_WDN; J.K = EFF; J.N = 1024; J.ldt = EFF; J.nb = NEXP; J.sb = (size_t)EFF * 1024; J.db = (size_t)1024 * EFF; break;
    }
}
__host__ __device__ constexpr int job_items_t(int t) {
    return t == 0 ? 16 * 29 : t == 1 ? 4 * 24 : t == 2 ? 2 * 32 : t == 3 ? 8 * 32 : t == 4 ? 16 * 88 : t == 5 ? 16 * 88 : t == 6 ? 44 * 32 : t == 7 ? 16 * 80 : t == 8 ? 16 * 32 : t == 9 ? 8 * 16 * 112 : t == 10 ? 8 * 16 * 112 : 8 * 56 * 32;
}
__host__ __device__ constexpr int job_start_t(int t) { int a = 0; for (int k = 0; k < t; ++k) a += job_items_t(k); return a; }
constexpr int ITEMS_PER_PAIR = job_start_t(NJT);

__device__ __forceinline__ void p0_prologue(Frame& F, const float* const* in, unsigned char* ws) {
    F.refresh();
    LAS float* scr = (LAS float*)(F.lds + F.wave * 12288);
    const int gw = F.vcu * NWAVES + F.wave, NGW = F.G * NWAVES;
    for (int it = gw; it < 2 * ITEMS_PER_PAIR; it += NGW) {
        const int i = it / ITEMS_PER_PAIR, r = it % ITEMS_PER_PAIR;
        int t = 0;
#pragma unroll
        for (int k = 1; k < NJT; ++k) t += (r >= job_start_t(k)) ? 1 : 0;
        int st = 0;
#pragma unroll
        for (int k = 1; k < NJT; ++k) st = (t == k) ? job_start_t(k) : st;
        XJob J; make_job(i, t, in, ws, J);
        xpose_item(J, r - st, scr, F.lane);
    }
    const int gt = F.vcu * 512 + F.tid, NGT = F.G * 512;
    for (int i = 0; i < 2; ++i) {
        bf16_t* WE = (bf16_t*)(ws + WS_WE) + (size_t)i * E_SIZE;
        for (int x = gt; x < 96 * 1024 / 8; x += NGT) *(u32x4*)(WE + E_WIN + (size_t)928 * 1024 + (size_t)x * 8) = (u32x4){0u, 0u, 0u, 0u};
        for (int x = gt; x < 1024 * 16; x += NGT) { const int r = x >> 4, c = x & 15; *(u32x4*)(WE + E_WKV + (size_t)r * 256 + 128 + c * 8) = (u32x4){0u, 0u, 0u, 0u}; }
        const float* pw = in[3] + (size_t)i * 4 * 128 * 128; const float* ps = in[4] + (size_t)i * 512; const float* wo = in[9] + (size_t)i * 1024 * 1024;
        for (int x = gt; x < 512 * 1024; x += NGT) { const int n = x & 1023, k = x >> 10, g = k >> 7, c = k & 127; float a = 0.f;
            const float* pr = pw + ((size_t)g * 128 + c) * 128; const float* sr = ps + g * 128; const float* wr_ = wo + (size_t)(g * 128) * 1024 + n;
#pragma unroll 8
            for (int d = 0; d < 128; ++d) a += pr[d] * sr[d] * wr_[(size_t)d * 1024];
            WE[E_WOUT + (size_t)n * 1024 + k] = f2bf(a); }
    }
    { float* cosT = (float*)(ws + T_COS); float* sinT = (float*)(ws + T_SIN);
      for (int x = gt; x < SEQ * 16; x += NGT) { const int pos = x >> 4, j = x & 15;
          const float inv = 1.0f / powf(10000.0f, (float)(2 * j) / 32.0f); const float angf = (float)pos * inv;
          double a = (double)angf; const double twopi = 6.283185307179586476925; a -= twopi * rint(a / twopi);
          const double y = a * 0.125, y2 = y * y;
          double s = y * (1.0 + y2 * (-1.0 / 6 + y2 * (1.0 / 120 + y2 * (-1.0 / 5040 + y2 * (1.0 / 362880 + y2 * (-1.0 / 39916800 + y2 * (1.0 / 6227020800.0)))))));
          double c = 1.0 + y2 * (-0.5 + y2 * (1.0 / 24 + y2 * (-1.0 / 720 + y2 * (1.0 / 40320 + y2 * (-1.0 / 3628800 + y2 * (1.0 / 479001600.0 + y2 * (-1.0 / 87178291200.0)))))));
#pragma unroll
          for (int k = 0; k < 3; ++k) { const double s2 = 2.0 * s * c, c2 = c * c - s * s; s = s2; c = c2; }
          cosT[x] = (float)c; sinT[x] = (float)s; } }
    { const float* x = in[0]; bf16_t* XB = (bf16_t*)(ws + WS_XB); u64* ssq = (u64*)(ws + WS_SSQ);
      for (int m = gw; m < NTOK; m += NGW) { const f32x4* xr = (const f32x4*)(x + (size_t)m * DM) + F.lane; float s = 0.f;
#pragma unroll
          for (int j = 0; j < 4; ++j) { const f32x4 v = xr[64 * j]; s += (v[0] * v[0] + v[1] * v[1]) + (v[2] * v[2] + v[3] * v[3]);
              u32x2 w; w.x = cvt_pk_bf16(v[0], v[1]); w.y = cvt_pk_bf16(v[2], v[3]); *((u32x2*)(XB + (size_t)m * DM) + F.lane + 64 * j) = w; }
          s = wave_sum(s); if (F.lane == 0) ssq[m] = ssq_fix(s); } }
}

__device__ __forceinline__ void p_even_mid(Frame& F, unsigned char* ws) {
    F.refresh();
    const bf16_t* Z = (const bf16_t*)(ws + R_Z); bf16_t* MIX = (bf16_t*)(ws + R_MIX); bf16_t* Kb = (bf16_t*)(ws + R_K);
    float* RQ = (float*)(ws + T_RQ); float* RKV = (float*)(ws + T_RKV); const float* cosT = (const float*)(ws + T_COS); const float* sinT = (const float*)(ws + T_SIN);
    for (int blk = F.vcu; blk < NTOK / 64; blk += F.G) {
        const int rb = blk * 64;
        { const int c = F.tid, g = c >> 7, w = 2 << g;
          for (int r = 0; r < 64; ++r) { const int t = rb + r, p = t & (SEQ - 1); const int cnt = (p + 1 < w) ? (p + 1) : w; float s = 0.f;
              for (int j = 0; j < cnt; ++j) s += bf2f(Z[(size_t)(t - j) * 1024 + c]);
              const float self = bf2f(Z[(size_t)t * 1024 + c]);
              MIX[(size_t)t * 1024 + c] = f2bf(s / (float)cnt - self); } }
        for (int r = F.wave; r < 64; r += NWAVES) { const int t = rb + r, p = t & (SEQ - 1); const bf16_t* zr = Z + (size_t)t * 1024;
            const u32x2 q = *((const u32x2*)(zr + 512) + F.lane); const unsigned kv = *((const unsigned*)(zr + 768) + F.lane);
            float sq = bflo(q.x) * bflo(q.x) + bfhi(q.x) * bfhi(q.x) + bflo(q.y) * bflo(q.y) + bfhi(q.y) * bfhi(q.y);
            float sk = bflo(kv) * bflo(kv) + bfhi(kv) * bfhi(kv);
            sq = wave_sum(sq); sk = wave_sum(sk);
            if (F.lane == 0) { RQ[t] = rsqrtf(sq * (1.0f / 256.0f) + EPS); RKV[t] = rsqrtf(sk * (1.0f / 128.0f) + EPS); }
            if (F.lane < 16) { const int j = F.lane; const float x1 = bf2f(zr[896 + j]), x2 = bf2f(zr[912 + j]); const float c = cosT[p * 16 + j], s = sinT[p * 16 + j];
                const bf16_t o1 = f2bf(x1 * c - x2 * s), o2 = f2bf(x2 * c + x1 * s); bf16_t* kr = Kb + (size_t)t * 768;
#pragma unroll
                for (int h = 0; h < 8; ++h) { kr[96 * h + 64 + j] = o1; kr[96 * h + 80 + j] = o2; } } }
    }
}

__device__ __forceinline__ int crow(int r, int hi) { return (r & 3) + 8 * (r >> 2) + 4 * hi; }
__device__ __forceinline__ s16x4 vtr(const LAS unsigned char* p) { return __builtin_bit_cast(s16x4, __builtin_amdgcn_ds_read_tr16_b64_v4i16((LAS s16x4*)p)); }

template <int DQK, bool BAND>
__device__ __forceinline__ void attn_unit(const bf16_t* __restrict__ Qp, int ldq, const bf16_t* __restrict__ Kp, int ldk, const bf16_t* __restrict__ Vp, int ldv,
                                          bf16_t* Op, int ldo, int b, int qb, LAS unsigned char* lds, const float* bias_g) {
    constexpr int KSTR = (DQK + 8) * 2, KBUF = 64 * KSTR, VBUF = 8192, KCH = DQK / 8, NKS = DQK / 16;
    const int tid = opaque_tid(), lane = tid & 63, wave = __builtin_amdgcn_readfirstlane(tid >> 6), r32 = lane & 31, hi = lane >> 5;
    LAS unsigned char* Kl = lds; LAS unsigned char* Vl = lds + 2 * KBUF;
    LAS float* sc = (LAS float*)(lds + 2 * KBUF + 2 * VBUF) + wave * 32;
    LAS float* biasL = (LAS float*)(lds + 2 * KBUF + 2 * VBUF + 1024);
    const int chunkw = 4 * qb + (wave >> 1), t1 = 4 * qb + 3, t0 = BAND ? ((4 * qb - 8) > 0 ? (4 * qb - 8) : 0) : 0;
    const size_t rowb = (size_t)b * SEQ;
    if (BAND) { if (tid < 257) biasL[tid] = bias_g[tid] * LOG2E; }
    bf16x8 qf[NKS];
    { const bf16_t* qrow = Qp + (rowb + 256 * qb + 32 * wave + r32) * ldq + 8 * hi;
#pragma unroll
      for (int ks = 0; ks < NKS; ++ks) qf[ks] = *(const bf16x8*)(qrow + 16 * ks); }
    const int kkey0 = tid / KCH, kch0 = tid % KCH; const int idx1 = tid + 512; const bool has1 = idx1 < 64 * KCH; const int kkey1 = has1 ? idx1 / KCH : 0, kch1 = has1 ? idx1 % KCH : 0;
    const int vkey = tid >> 3, vch = tid & 7;
    const bf16_t* kg0 = Kp + (rowb + kkey0) * ldk + 8 * kch0; const bf16_t* kg1 = Kp + (rowb + kkey1) * ldk + 8 * kch1; const bf16_t* vg = Vp + (rowb + vkey) * ldv + 8 * vch;
    const int kl0 = kkey0 * KSTR + kch0 * 16, kl1 = kkey1 * KSTR + kch1 * 16, vl = (vch >> 2) * 4096 + vkey * 64 + (vch & 3) * 16;
    u32x4 kr0, kr1 = (u32x4){0u, 0u, 0u, 0u}, vr;
    { const size_t to = (size_t)t0 * 64; kr0 = *(const u32x4*)(kg0 + to * ldk); if (has1) kr1 = *(const u32x4*)(kg1 + to * ldk); vr = *(const u32x4*)(vg + to * ldv);
      *(LAS u32x4*)(Kl + kl0) = kr0; if (has1) *(LAS u32x4*)(Kl + kl1) = kr1; *(LAS u32x4*)(Vl + vl) = vr; }
    __syncthreads();
    float m_run = -INFINITY, l_run = 0.f; f32x16 o0 = {}, o1 = {};
    const int vtoff = (16 * ((lane >> 4) & 1) + 4 * (lane & 3)) * 2 + (4 * hi + ((lane & 15) >> 2)) * 64;
    for (int t = t0; t <= t1; ++t) {
        const int cur = (t - t0) & 1; const bool more = t < t1;
        if (more) { const size_t to = (size_t)(t + 1) * 64; kr0 = *(const u32x4*)(kg0 + to * ldk); if (has1) kr1 = *(const u32x4*)(kg1 + to * ldk); vr = *(const u32x4*)(vg + to * ldv); }
        const bool active = BAND ? (t <= chunkw && t >= chunkw - 8) : (t <= chunkw);
        if (active) {
            const LAS unsigned char* Ks = Kl + cur * KBUF; const LAS unsigned char* Vs = Vl + cur * VBUF;
            f32x16 s0 = {}, s1 = {};
#pragma unroll
            for (int ks = 0; ks < NKS; ++ks) {
                const bf16x8 k0 = *(const LAS bf16x8*)(Ks + r32 * KSTR + ks * 32 + hi * 16);
                const bf16x8 k1 = *(const LAS bf16x8*)(Ks + (32 + r32) * KSTR + ks * 32 + hi * 16);
                s0 = __builtin_amdgcn_mfma_f32_32x32x16_bf16(k0, qf[ks], s0, 0, 0, 0);
                s1 = __builtin_amdgcn_mfma_f32_32x32x16_bf16(k1, qf[ks], s1, 0, 0, 0);
            }
            if (BAND) {
                if (t <= chunkw - 3) { const float cb = biasL[256];
#pragma unroll
                    for (int r = 0; r < 16; ++r) { s0[r] += cb; s1[r] += cb; } }
                else { const int qpos = 256 * qb + 32 * wave + r32, kb0 = 64 * t;
#pragma unroll
                    for (int r = 0; r < 16; ++r) { const int rel = qpos - (kb0 + crow(r, hi)); int i0 = rel < -128 ? -128 : (rel > 128 ? 128 : rel); int rel1 = rel - 32; int i1 = rel1 < -128 ? -128 : (rel1 > 128 ? 128 : rel1);
                        s0[r] += biasL[i0 + 128]; s1[r] += biasL[i1 + 128]; } }
            }
            float mx = s0[0];
#pragma unroll
            for (int r = 1; r < 16; ++r) mx = fmaxf(mx, s0[r]);
#pragma unroll
            for (int r = 0; r < 16; ++r) mx = fmaxf(mx, s1[r]);
            mx = fmaxf(mx, __shfl_xor(mx, 32));
            const float m_new = fmaxf(m_run, mx), alpha = fast_exp2(m_run - m_new); m_run = m_new;
            float ps = 0.f;
#pragma unroll
            for (int r = 0; r < 16; ++r) { s0[r] = fast_exp2(s0[r] - m_new); s1[r] = fast_exp2(s1[r] - m_new); ps += s0[r] + s1[r]; }
            l_run = l_run * alpha + ps;
            if (hi == 0) sc[r32] = alpha;
            LDS_WAIT();
#pragma unroll
            for (int r = 0; r < 16; ++r) { const float a = sc[crow(r, hi)]; o0[r] *= a; o1[r] *= a; }
            LDS_WAIT();
#pragma unroll
            for (int hf = 0; hf < 2; ++hf)
#pragma unroll
                for (int s2 = 0; s2 < 2; ++s2) {
                    u32x4 pw;
                    if (hf == 0) { pw.x = cvt_pk_bf16(s0[8 * s2 + 0], s0[8 * s2 + 1]); pw.y = cvt_pk_bf16(s0[8 * s2 + 2], s0[8 * s2 + 3]); pw.z = cvt_pk_bf16(s0[8 * s2 + 4], s0[8 * s2 + 5]); pw.w = cvt_pk_bf16(s0[8 * s2 + 6], s0[8 * s2 + 7]); }
                    else         { pw.x = cvt_pk_bf16(s1[8 * s2 + 0], s1[8 * s2 + 1]); pw.y = cvt_pk_bf16(s1[8 * s2 + 2], s1[8 * s2 + 3]); pw.z = cvt_pk_bf16(s1[8 * s2 + 4], s1[8 * s2 + 5]); pw.w = cvt_pk_bf16(s1[8 * s2 + 6], s1[8 * s2 + 7]); }
                    const bf16x8 pa = __builtin_bit_cast(bf16x8, pw);
                    const LAS unsigned char* vb = Vs + (32 * hf + 16 * s2) * 64 + vtoff;
#pragma unroll
                    for (int dh = 0; dh < 2; ++dh) {
                        const s16x4 lo = vtr(vb + dh * 4096), hh = vtr(vb + dh * 4096 + 8 * 64);
                        const bf16x8 vf = (bf16x8){lo[0], lo[1], lo[2], lo[3], hh[0], hh[1], hh[2], hh[3]};
                        if (dh == 0) o0 = __builtin_amdgcn_mfma_f32_32x32x16_bf16(pa, vf, o0, 0, 0, 0);
                        else         o1 = __builtin_amdgcn_mfma_f32_32x32x16_bf16(pa, vf, o1, 0, 0, 0);
                    }
                }
        }
        if (more) { const int nx = cur ^ 1; *(LAS u32x4*)(Kl + nx * KBUF + kl0) = kr0; if (has1) *(LAS u32x4*)(Kl + nx * KBUF + kl1) = kr1; *(LAS u32x4*)(Vl + nx * VBUF + vl) = vr; }
        __syncthreads();
    }
    { const float lt = l_run + __shfl_xor(l_run, 32);
      if (hi == 0) sc[r32] = fast_rcp(lt);
      LDS_WAIT();
      bf16_t* orow = Op + (rowb + 256 * qb + 32 * wave) * ldo + r32;
#pragma unroll
      for (int r = 0; r < 16; ++r) { const int q = crow(r, hi); const float inv = sc[q];
          orow[(size_t)q * ldo] = f2bf(o0[r] * inv); orow[(size_t)q * ldo + 32] = f2bf(o1[r] * inv); }
      LDS_WAIT(); }
}

__device__ __forceinline__ void sgu_unit(const bf16_t* UV, const float* ng, const float* nb, const float* W, const float* bs, bf16_t* MIX, int b, int n, int g, LAS unsigned char* lds) {
    LAS float* vn = (LAS float*)lds;
    const int tid = opaque_tid(); const size_t t0 = (size_t)b * SEQ + (size_t)n * 128;
    { const int s = tid >> 2, qd = tid & 3; const bf16_t* src = UV + (t0 + s) * 1024 + 512 + g * 128 + 32 * qd;
      float x[32];
#pragma unroll
      for (int j = 0; j < 4; ++j) { const u32x4 v = *((const u32x4*)src + j); x[8 * j + 0] = bflo(v.x); x[8 * j + 1] = bfhi(v.x); x[8 * j + 2] = bflo(v.y); x[8 * j + 3] = bfhi(v.y); x[8 * j + 4] = bflo(v.z); x[8 * j + 5] = bfhi(v.z); x[8 * j + 6] = bflo(v.w); x[8 * j + 7] = bfhi(v.w); }
      float sm = 0.f;
#pragma unroll
      for (int j = 0; j < 32; ++j) sm += x[j];
      sm += __shfl_xor(sm, 1); sm += __shfl_xor(sm, 2);
      const float mu = sm * (1.0f / 128.0f); float vs = 0.f;
#pragma unroll
      for (int j = 0; j < 32; ++j) { x[j] -= mu; vs += x[j] * x[j]; }
      vs += __shfl_xor(vs, 1); vs += __shfl_xor(vs, 2);
      const float rstd = rsqrtf(vs * (1.0f / 128.0f) + EPS);
#pragma unroll
      for (int j = 0; j < 32; ++j) { const int c = 32 * qd + j; vn[s * 128 + c] = x[j] * rstd * ng[g * 128 + c] + nb[g * 128 + c]; } }
    __syncthreads();
    { const int c = tid & 127, tq = __builtin_amdgcn_readfirstlane(tid >> 7);
      for (int k = 0; k < 32; ++k) { const int t = tq + 4 * k; const float* wrow = W + ((size_t)g * 128 + t) * 128; float a = 0.f;
          for (int s = 0; s <= t; ++s) a += wrow[s] * vn[s * 128 + c];
          const float u = bf2f(UV[(t0 + t) * 1024 + g * 128 + c]);
          MIX[(t0 + t) * 1024 + 512 + g * 128 + c] = f2bf(u * (a + bs[g * 128 + t])); } }
    __syncthreads();
}

__device__ __forceinline__ void p_route(Frame& F, unsigned char* ws, const float* X, const u64* ssq, const float* gain, const float* router, unsigned* cnt) {
    F.refresh();
    LAS float* RW = (LAS float*)F.lds;
    LAS int* hist = (LAS int*)(F.lds + 32768);
    LAS int* gbase = (LAS int*)(F.lds + 32768 + 64);
    LAS int* pe = (LAS int*)(F.lds + 32768 + 128);
    LAS float* pwt = (LAS float*)(F.lds + 32768 + 128 + 1024);
    int* TE = (int*)(ws + T_TE); int* TP = (int*)(ws + T_TP); float* TW = (float*)(ws + T_TW);
    for (int idx = F.tid; idx < 8192; idx += 512) { const int k = idx >> 3, e = idx & 7; RW[e * 1024 + k] = router[idx] * gain[k]; }
    for (int blk = F.vcu; blk < NTOK / 64; blk += F.G) {
        if (F.tid < 8) hist[F.tid] = 0;
        __syncthreads();
        for (int r = F.wave; r < 64; r += NWAVES) { const int t = blk * 64 + r; const f32x4* xr = (const f32x4*)(X + (size_t)t * DM) + F.lane;
            float lg[8];
#pragma unroll
            for (int e = 0; e < 8; ++e) lg[e] = 0.f;
#pragma unroll
            for (int j = 0; j < 4; ++j) { const f32x4 v = xr[64 * j];
#pragma unroll
                for (int e = 0; e < 8; ++e) { const f32x4 w = *(const LAS f32x4*)(RW + e * 1024 + 256 * j + 4 * F.lane); lg[e] += (v[0] * w[0] + v[1] * w[1]) + (v[2] * w[2] + v[3] * w[3]); } }
#pragma unroll
            for (int e = 0; e < 8; ++e) lg[e] = wave_sum(lg[e]);
            if (F.lane == 0) { const float rs = rstd_of(ssq, t);
                int e1 = 0; float v1 = lg[0];
#pragma unroll
                for (int e = 1; e < 8; ++e) if (lg[e] > v1) { v1 = lg[e]; e1 = e; }
                int e2 = -1; float v2 = -INFINITY;
#pragma unroll
                for (int e = 0; e < 8; ++e) if (e != e1 && lg[e] > v2) { v2 = lg[e]; e2 = e; }
                const float w1 = 1.0f / (1.0f + __expf((v2 - v1) * rs)), w2 = 1.0f - w1;
                const int p1 = __hip_atomic_fetch_add(&hist[e1], 1, __ATOMIC_RELAXED, __HIP_MEMORY_SCOPE_WORKGROUP), p2 = __hip_atomic_fetch_add(&hist[e2], 1, __ATOMIC_RELAXED, __HIP_MEMORY_SCOPE_WORKGROUP);
                pe[r * 4 + 0] = e1; pe[r * 4 + 1] = e2; pe[r * 4 + 2] = p1; pe[r * 4 + 3] = p2; pwt[r * 2 + 0] = w1; pwt[r * 2 + 1] = w2; } }
        __syncthreads();
        if (F.tid < 8) gbase[F.tid] = (int)__hip_atomic_fetch_add(cnt + F.tid, (unsigned)hist[F.tid], RLX_AGENT);
        __syncthreads();
        if (F.tid < 64) { const int r = F.tid, t = blk * 64 + r; const int e1 = pe[r * 4 + 0], e2 = pe[r * 4 + 1];
            TE[t] = e1 | (e2 << 8); TP[2 * t] = gbase[e1] + pe[r * 4 + 2]; TP[2 * t + 1] = gbase[e2] + pe[r * 4 + 3]; TW[2 * t] = pwt[r * 2 + 0]; TW[2 * t + 1] = pwt[r * 2 + 1]; }
        __syncthreads();
    }
}
__device__ __forceinline__ void moe_offsets(const unsigned* cnt, int (&off)[9], int (&cn)[8]) {
    int a = 0;
#pragma unroll
    for (int e = 0; e < 8; ++e) { cn[e] = (int)__hip_atomic_load(cnt + e, RLX_AGENT); off[e] = a; a += (cn[e] + 255) & ~255; }
    off[8] = a;
}
__device__ __forceinline__ void p_gather(Frame& F, unsigned char* ws, const u64* ssq, const unsigned* cnt) {
    F.refresh();
    int off[9], cn[8]; moe_offsets(cnt, off, cn);
    const bf16_t* XB = (const bf16_t*)(ws + WS_XB); bf16_t* HS = (bf16_t*)(ws + R_HS);
    const int* TE = (const int*)(ws + T_TE); const int* TP = (const int*)(ws + T_TP); const float* TW = (const float*)(ws + T_TW);
    int* PAIR = (int*)(ws + T_PAIR); float* DGATE = (float*)(ws + T_DGATE); float* DRS = (float*)(ws + T_DRS);
    const int gw = F.vcu * NWAVES + F.wave, NGW = F.G * NWAVES;
    for (int t = gw; t < NTOK; t += NGW) { const int te = TE[t]; const float rs = rstd_of(ssq, t);
        const u32x4 a0 = *((const u32x4*)(XB + (size_t)t * DM) + F.lane), a1 = *((const u32x4*)(XB + (size_t)t * DM) + 64 + F.lane);
#pragma unroll
        for (int k = 0; k < 2; ++k) { const int e = (te >> (8 * k)) & 255; int o = 0;
#pragma unroll
            for (int q = 0; q < 8; ++q) o = (q == e) ? off[q] : o;
            const int dest = o + TP[2 * t + k];
            *((u32x4*)(HS + (size_t)dest * DM) + F.lane) = a0; *((u32x4*)(HS + (size_t)dest * DM) + 64 + F.lane) = a1;
            if (F.lane == 0) { PAIR[2 * t + k] = dest; DGATE[dest] = TW[2 * t + k]; DRS[dest] = rs; } } }
#pragma unroll
    for (int e = 0; e < 8; ++e) { const int lo = off[e] + cn[e], hi = off[e + 1];
        for (int r = lo + gw; r < hi; r += NGW) { *((u32x4*)(HS + (size_t)r * DM) + F.lane) = (u32x4){0u, 0u, 0u, 0u}; *((u32x4*)(HS + (size_t)r * DM) + 64 + F.lane) = (u32x4){0u, 0u, 0u, 0u};
            if (F.lane == 0) { DGATE[r] = 0.f; DRS[r] = 0.f; } } }
}
__device__ __forceinline__ void p_combine(Frame& F, unsigned char* ws, float* X, u64* ssq_next, const float* fnorm, bool final_) {
    F.refresh();
    const bf16_t* Y = (const bf16_t*)(ws + R_Y); bf16_t* XB = (bf16_t*)(ws + WS_XB); const int* PAIR = (const int*)(ws + T_PAIR);
    const int gw = F.vcu * NWAVES + F.wave, NGW = F.G * NWAVES;
    for (int t = gw; t < NTOK; t += NGW) { const int p1 = PAIR[2 * t], p2 = PAIR[2 * t + 1];
        f32x4* xr = (f32x4*)(X + (size_t)t * DM) + F.lane; const u32x2* y1 = (const u32x2*)(Y + (size_t)p1 * DM) + F.lane; const u32x2* y2 = (const u32x2*)(Y + (size_t)p2 * DM) + F.lane;
        f32x4 v[4]; float s = 0.f;
#pragma unroll
        for (int j = 0; j < 4; ++j) { const f32x4 x = xr[64 * j]; const u32x2 a = y1[64 * j], bb = y2[64 * j];
            f32x4 o; o[0] = x[0] + bflo(a.x) + bflo(bb.x); o[1] = x[1] + bfhi(a.x) + bfhi(bb.x); o[2] = x[2] + bflo(a.y) + bflo(bb.y); o[3] = x[3] + bfhi(a.y) + bfhi(bb.y);
            v[j] = o; s += (o[0] * o[0] + o[1] * o[1]) + (o[2] * o[2] + o[3] * o[3]); }
        s = wave_sum(s);
        if (!final_) {
#pragma unroll
            for (int j = 0; j < 4; ++j) { xr[64 * j] = v[j]; u32x2 w; w.x = cvt_pk_bf16(v[j][0], v[j][1]); w.y = cvt_pk_bf16(v[j][2], v[j][3]); *((u32x2*)(XB + (size_t)t * DM) + F.lane + 64 * j) = w; }
            if (F.lane == 0) ssq_next[t] = ssq_fix(s);
        } else { const float rs = rsqrtf(s * (1.0f / DM) + EPS);
#pragma unroll
            for (int j = 0; j < 4; ++j) { const f32x4 g = *((const f32x4*)fnorm + F.lane + 64 * j); xr[64 * j] = v[j] * rs * g; } }
    }
}

constexpr int NPH = 31;
struct Args { const float* in[28]; float* out; unsigned char* ws; int ph_lo, ph_hi; };
__global__ void __launch_bounds__(NWAVES * 64, 2) mk_fwd(Args args) {
    extern __shared__ __attribute__((aligned(16))) unsigned char lds_raw[];
    Frame F;
    F.lds = (LAS unsigned char*)lds_raw;
    F.refresh();
    F.G = gridDim.x; { const int bx = blockIdx.x; F.vcu = (F.G % 8 == 0) ? (bx % 8) * (F.G / 8) + bx / 8 : bx; }
    unsigned char* ws = args.ws;
    F.ctl = (unsigned*)(ws + WS_CTL);
    volatile LAS unsigned* MISC = (volatile LAS unsigned*)(F.lds + MISC_OFF);
    for (int u = F.tid; u < (LDS_BYTES - LDSCTL_OFF) / 4; u += NWAVES * 64) ((LAS unsigned*)(F.lds + LDSCTL_OFF))[u] = 0u;
    __syncthreads();
    const int lo = args.ph_lo, hi = args.ph_hi;
    XcdBarrier bar = xcd_barrier_post(F.ctl + CW_BAR + lo * XCD_BAR_WORDS, MISC + 8);
#ifndef PH_MASK
#define PH_MASK 0xFFFF
#endif
#define PT(t) (((PH_MASK) >> (t)) & 1)
#define IN(k) (lo <= (k) && (k) < hi)
#define SEAM(k) do { if ((k) + 1 < hi) xcd_barrier(bar); } while (0)
    const float* const* in = args.in;
    float* X = args.out;
    u64* SSQ = (u64*)(ws + WS_SSQ);
    bf16_t* XB = (bf16_t*)(ws + WS_XB);
    const int bx = (int)blockIdx.x;

    if (PT(0) && IN(0)) { asm volatile("; PHASE_MARK 0"); p0_prologue(F, in, ws); SEAM(0); }

    for (int lp = 0; lp < 2; ++lp) {
        const int pb = 1 + 15 * lp;
        bf16_t* WE = (bf16_t*)(ws + WS_WE) + (size_t)lp * E_SIZE; bf16_t* WO = (bf16_t*)(ws + WS_WO) + (size_t)lp * O_SIZE;
        u64* ssq0 = SSQ + (size_t)(4 * lp) * NTOK;
        if (PT(1) && IN(pb + 0)) { asm volatile("; PHASE_MARK 1");
            pg8::DenseOrder S; S.init(XB, DM, WE + E_WIN, DM, NTOK, 1024, F.G, bx);
            pg8::EpiZ E{(bf16_t*)(ws + R_Z), 1024, ssq0};
            pg8::gemm_phase(F.lds, pg8::Gemm{DM, DM, DM}, S, E);
            SEAM(pb + 0);
        }
        if (PT(2) && IN(pb + 1)) { asm volatile("; PHASE_MARK 2"); p_even_mid(F, ws); SEAM(pb + 1); }
        if (PT(3) && IN(pb + 2)) { asm volatile("; PHASE_MARK 3");
            { pg8::DenseOrder S; S.init((const bf16_t*)(ws + R_Z) + 512, 1024, WE + E_WQ, 256, NTOK, 768, F.G, bx);
              pg8::EpiQ E{(bf16_t*)(ws + R_Q), (const float*)(ws + T_RQ), (const float*)(ws + T_COS), (const float*)(ws + T_SIN)};
              pg8::gemm_phase(F.lds, pg8::Gemm{1024, 256, 256}, S, E); }
            { pg8::DenseOrder S; S.init((const bf16_t*)(ws + R_Z) + 768, 1024, WE + E_WKV, 256, NTOK, 1024, F.G, bx);
              pg8::EpiKV E{(bf16_t*)(ws + R_K), (bf16_t*)(ws + R_V), (const float*)(ws + T_RKV)};
              pg8::gemm_phase(F.lds, pg8::Gemm{1024, 256, 256}, S, E); }
            SEAM(pb + 2);
        }
        if (PT(4) && IN(pb + 3)) { asm volatile("; PHASE_MARK 4");
            const bf16_t* Q = (const bf16_t*)(ws + R_Q); const bf16_t* Kb = (const bf16_t*)(ws + R_K); const bf16_t* Vb = (const bf16_t*)(ws + R_V); bf16_t* MIX = (bf16_t*)(ws + R_MIX);
            for (int pi = F.vcu; pi < 256; pi += F.G) { const int bh = pi >> 3, s = pi & 7, b = bh >> 3, h = bh & 7;
#pragma unroll 1
                for (int k = 0; k < 2; ++k) { const int qb = k == 0 ? (15 - s) : s;
                    attn_unit<96, false>(Q + 96 * h, 768, Kb + 96 * h, 768, Vb + 64 * h, 512, MIX + 512 + 64 * h, 1024, b, qb, F.lds, nullptr); } }
            SEAM(pb + 3);
        }
        if (PT(5) && IN(pb + 4)) { asm volatile("; PHASE_MARK 5");
            pg8::DenseOrder S; S.init((const bf16_t*)(ws + R_MIX), 1024, WE + E_WOUT, 1024, NTOK, 1024, F.G, bx);
            pg8::EpiRes E{lp == 0 ? in[0] : X, X, XB, ssq0 + NTOK};
            pg8::gemm_phase(F.lds, pg8::Gemm{1024, 1024, 1024}, S, E);
            SEAM(pb + 4);
        }
        if (PT(6) && IN(pb + 5)) { asm volatile("; PHASE_MARK 6");
            pg8::DenseOrder S; S.init(XB, DM, WE + E_WGU, DM, NTOK, 2 * FF, F.G, bx);
            pg8::EpiSwiGLU<0> E{(bf16_t*)(ws + R_ACT), FF, ssq0 + NTOK};
            pg8::gemm_phase(F.lds, pg8::Gemm{DM, DM, DM}, S, E);
            SEAM(pb + 5);
        }
        if (PT(7) && IN(pb + 6)) { asm volatile("; PHASE_MARK 7");
            pg8::DenseOrder S; S.init((const bf16_t*)(ws + R_ACT), FF, WE + E_WDN, FF, NTOK, 1024, F.G, bx);
            pg8::EpiRes E{X, X, XB, ssq0 + 2 * NTOK};
            pg8::gemm_phase(F.lds, pg8::Gemm{FF, FF, FF}, S, E);
            SEAM(pb + 6);
        }
        if (PT(8) && IN(pb + 7)) { asm volatile("; PHASE_MARK 8");
            pg8::DenseOrder S; S.init(XB, DM, WO + O_WIN, DM, NTOK, 2560, F.G, bx);
            pg8::EpiOddIn E{(bf16_t*)(ws + R_QKV), (bf16_t*)(ws + R_UV), ssq0 + 2 * NTOK};
            pg8::gemm_phase(F.lds, pg8::Gemm{DM, DM, DM}, S, E);
            SEAM(pb + 7);
        }
        if (PT(9) && IN(pb + 8)) { asm volatile("; PHASE_MARK 9");
            const bf16_t* QKV = (const bf16_t*)(ws + R_QKV); const bf16_t* UV = (const bf16_t*)(ws + R_UV); bf16_t* MIX = (bf16_t*)(ws + R_MIX);
            const float* rb = in[16] + (size_t)lp * 8 * 257;
            for (int u = F.vcu; u < 512; u += F.G) { const int bh = u >> 4, qb = u & 15, b = bh >> 3, h = bh & 7;
                attn_unit<64, true>(QKV + 64 * h, 1536, QKV + 512 + 64 * h, 1536, QKV + 1024 + 64 * h, 1536, MIX + 64 * h, 1024, b, qb, F.lds, rb + h * 257); }
            for (int u = F.vcu; u < 512; u += F.G) { const int g = u & 3, n = (u >> 2) & 31, b = u >> 7;
                sgu_unit(UV, in[17] + (size_t)lp * 512, in[18] + (size_t)lp * 512, in[19] + (size_t)lp * 4 * 128 * 128, in[20] + (size_t)lp * 512, MIX, b, n, g, F.lds); }
            SEAM(pb + 8);
        }
        if (PT(10) && IN(pb + 9)) { asm volatile("; PHASE_MARK 10");
            pg8::DenseOrder S; S.init((const bf16_t*)(ws + R_MIX), 1024, WO + O_WOUT, 1024, NTOK, 1024, F.G, bx);
            pg8::EpiRes E{X, X, XB, ssq0 + 3 * NTOK};
            pg8::gemm_phase(F.lds, pg8::Gemm{1024, 1024, 1024}, S, E);
            SEAM(pb + 9);
        }
        unsigned* cnt = F.ctl + CW_CNT + 64 * lp;
        if (PT(11) && IN(pb + 10)) { asm volatile("; PHASE_MARK 11"); p_route(F, ws, X, ssq0 + 3 * NTOK, in[22] + (size_t)lp * 1024, in[23] + (size_t)lp * 8192, cnt); SEAM(pb + 10); }
        if (PT(12) && IN(pb + 11)) { asm volatile("; PHASE_MARK 12"); p_gather(F, ws, ssq0 + 3 * NTOK, cnt); SEAM(pb + 11); }
        if (PT(13) && IN(pb + 12)) { asm volatile("; PHASE_MARK 13");
            int off[9], cn[8]; moe_offsets(cnt, off, cn);
            pg8::MoeOrder S; S.A = (const char*)(ws + R_HS); S.Bt = (const char*)(WO + O_WGU); S.bstride = (size_t)2 * EFF * 1024 * 2; S.lda = 1024; S.ldb = 1024; S.nM = off[8] >> 8; S.nN = 2 * EFF / 256; S.G = F.G; S.c = bx;
#pragma unroll
            for (int e = 0; e < 8; ++e) S.tend[e] = off[e + 1] >> 8;
            pg8::EpiSwiGLU<1> E{(bf16_t*)(ws + R_ACT2), EFF, (const float*)(ws + T_DRS)};
            pg8::gemm_phase(F.lds, pg8::Gemm{1024, 1024, 1024}, S, E);
            SEAM(pb + 12);
        }
        if (PT(14) && IN(pb + 13)) { asm volatile("; PHASE_MARK 14");
            int off[9], cn[8]; moe_offsets(cnt, off, cn);
            pg8::MoeOrder S; S.A = (const char*)(ws + R_ACT2); S.Bt = (const char*)(WO + O_WDN); S.bstride = (size_t)1024 * EFF * 2; S.lda = EFF; S.ldb = EFF; S.nM = off[8] >> 8; S.nN = 4; S.G = F.G; S.c = bx;
#pragma unroll
            for (int e = 0; e < 8; ++e) S.tend[e] = off[e + 1] >> 8;
            pg8::EpiY E{(bf16_t*)(ws + R_Y), (const float*)(ws + T_DGATE)};
            pg8::gemm_phase(F.lds, pg8::Gemm{EFF, EFF, EFF}, S, E);
            SEAM(pb + 13);
        }
        if (PT(15) && IN(pb + 14)) { asm volatile("; PHASE_MARK 15"); p_combine(F, ws, X, ssq0 + 4 * NTOK, in[27], lp == 1); SEAM(pb + 14); }
    }
#undef IN
#undef SEAM
}

extern "C" void kernel_launch(void* const* d_in, const int* in_sizes, int n_in, void* d_out, int out_size, void* d_ws, size_t ws_size, hipStream_t stream) {
    static int grid = 0;
    if (grid == 0) {
        if (n_in != 28 || in_sizes[0] != NTOK * DM || out_size != NTOK * DM || ws_size < WS_END) { fprintf(stderr, "kernel_launch: unexpected shapes / workspace (%d inputs, ws %zu, need %zu); nothing launched\n", n_in, ws_size, (size_t)WS_END); grid = -1; return; }
        int dev = 0, cus = 0, per_cu = 0;
        if (hipGetDevice(&dev) != hipSuccess || hipDeviceGetAttribute(&cus, hipDeviceAttributeMultiprocessorCount, dev) != hipSuccess) { grid = -1; return; }
        if (hipFuncSetAttribute((const void*)mk_fwd, hipFuncAttributeMaxDynamicSharedMemorySize, LDS_BYTES) != hipSuccess) { fprintf(stderr, "kernel_launch: hipFuncSetAttribute failed\n"); grid = -1; return; }
        if (hipOccupancyMaxActiveBlocksPerMultiprocessor(&per_cu, (const void*)mk_fwd, NWAVES * 64, LDS_BYTES) != hipSuccess || per_cu < 1) fprintf(stderr, "kernel_launch: occupancy query reports %d\n", per_cu);
        (void)hipGetLastError();
        grid = cus;
        if (grid > 256) grid = 256;
        grid &= ~7;
    }
    if (grid <= 0) return;
    if (hipMemsetAsync((char*)d_ws + WS_CTL, 0, CTL_ZERO_BYTES, stream) != hipSuccess) return;
    Args a{};
    for (int i = 0; i < 28; ++i) a.in[i] = (const float*)d_in[i];
    a.out = (float*)d_out; a.ws = (unsigned char*)d_ws;
#if MK_N_LAUNCHES == 1
    a.ph_lo = 0; a.ph_hi = NPH;
    hipLaunchKernelGGL(mk_fwd, dim3(grid), dim3(NWAVES * 64), LDS_BYTES, stream, a);
#else
    for (int p = 0; p < NPH; ++p) { a.ph_lo = p; a.ph_hi = p + 1; hipLaunchKernelGGL(mk_fwd, dim3(grid), dim3(NWAVES * 64), LDS_BYTES, stream, a); }
#endif
}
```

```cpp
#include <hip/hip_runtime.h>
#include <cstdio>
#include <cstdint>

#ifndef MK_N_LAUNCHES
#define MK_N_LAUNCHES 1
#endif

#define LAS __attribute__((address_space(3)))
#define GAS __attribute__((address_space(1)))
typedef unsigned short bf16_t;
typedef short bf16x8 __attribute__((ext_vector_type(8)));
typedef short s16x4 __attribute__((ext_vector_type(4)));
typedef float f32x4 __attribute__((ext_vector_type(4)));
typedef float f32x2 __attribute__((ext_vector_type(2)));
typedef float f32x16 __attribute__((ext_vector_type(16)));
typedef unsigned u32x4 __attribute__((ext_vector_type(4)));
typedef unsigned u32x2 __attribute__((ext_vector_type(2)));

constexpr int NTOK = 16384, DM = 1024, SEQ = 4096;
constexpr float EPS = 1e-6f;
constexpr float LOG2E = 1.4426950408889634f;
constexpr float QS_MLA = 0.10206207261596575f * LOG2E;
constexpr float QS_BAND = 0.125f * LOG2E;
constexpr int FF = 2816, EFF = 3584, NEXP = 8;
constexpr int MOE_ROWS = 34816;

constexpr size_t MiB = 1u << 20, KiB = 1024;
constexpr size_t WS_CTL = 0, CTL_ZERO_BYTES = 3 * MiB;
constexpr int CW_TMO = 0, CW_CNT = 64, CW_BAR = 4096;
constexpr size_t WS_SSQ = 1 * MiB;
constexpr size_t WS_TAB = 3 * MiB;
constexpr size_t T_COS = WS_TAB, T_SIN = WS_TAB + 256 * KiB, T_RQ = WS_TAB + 512 * KiB, T_RKV = WS_TAB + 576 * KiB, T_TE = WS_TAB + 640 * KiB,
                 T_TP = WS_TAB + 704 * KiB, T_TW = WS_TAB + 832 * KiB, T_PAIR = WS_TAB + 960 * KiB, T_DGATE = WS_TAB + 1088 * KiB, T_DRS = WS_TAB + 1280 * KiB;
constexpr size_t WS_W = 5 * MiB;
constexpr size_t E_WIN = 0, E_WQ = 1048576, E_WKV = 1245184, E_WOUT = 1507328, E_WGU = 2555904, E_WDN = 8323072, E_SIZE = 11206656;
constexpr size_t O_WIN = 0, O_WOUT = 2621440, O_WGU = 3670016, O_WDN = 62390272, O_SIZE = 91750400;
constexpr size_t WS_WE = WS_W, WS_WO = WS_W + 2 * E_SIZE * 2;
static_assert(WS_WO + 2 * O_SIZE * 2 <= 400 * MiB, "weights");
constexpr size_t WS_XB = 400 * MiB;
constexpr size_t WS_R = 432 * MiB;
constexpr size_t R_Z = WS_R, R_Q = WS_R + 32 * MiB, R_K = WS_R + 56 * MiB, R_V = WS_R + 80 * MiB, R_MIX = WS_R + 96 * MiB, R_ACT = WS_R;
constexpr size_t R_QKV = WS_R, R_UV = WS_R + 48 * MiB, R_HS = WS_R, R_ACT2 = WS_R + 68 * MiB, R_Y = WS_R;
constexpr size_t WS_END = WS_R + 306 * MiB;
static_assert((size_t)MOE_ROWS * EFF * 2 <= 238 * MiB && (size_t)MOE_ROWS * 1024 * 2 <= 68 * MiB, "moe buffers");

constexpr int RING_BYTES = 131072, LDSCTL_OFF = 135168, MISC_OFF = LDSCTL_OFF + 320, LDS_BYTES = 151552;
constexpr int NWAVES = 8;

#define RLX_AGENT __ATOMIC_RELAXED, __HIP_MEMORY_SCOPE_AGENT
#define LDS_WAIT() asm volatile("s_waitcnt lgkmcnt(0)" ::: "memory")
#define VM_WAIT() asm volatile("s_waitcnt vmcnt(0)" ::: "memory")

__device__ __forceinline__ unsigned cvt_pk_bf16(float lo, float hi) { unsigned r; asm volatile("v_cvt_pk_bf16_f32 %0, %1, %2" : "=v"(r) : "v"(lo), "v"(hi)); return r; }
__device__ __forceinline__ float bf2f(unsigned short b) { return __uint_as_float(((unsigned)b) << 16); }
__device__ __forceinline__ float bflo(unsigned w) { return __uint_as_float(w << 16); }
__device__ __forceinline__ float bfhi(unsigned w) { return __uint_as_float(w & 0xffff0000u); }
__device__ __forceinline__ unsigned short f2bf(float f) { return (unsigned short)(cvt_pk_bf16(f, 0.f) & 0xffffu); }
__device__ __forceinline__ float wave_sum(float v) {
#pragma unroll
    for (int o = 1; o < 64; o <<= 1) v += __shfl_xor(v, o);
    return v;
}
typedef unsigned long long u64;
__device__ __forceinline__ u64 ssq_fix(float s) { return (u64)((double)s * 4294967296.0); }
__device__ __forceinline__ float ssq_get(const u64* p, int row) { return (float)((double)p[row] * (1.0 / 4294967296.0)); }
__device__ __forceinline__ float rstd_of(const u64* p, int row) { return rsqrtf(ssq_get(p, row) * (1.0f / DM) + EPS); }
__device__ __forceinline__ float fast_exp2(float x) { return __builtin_amdgcn_exp2f(x); }
__device__ __forceinline__ float fast_rcp(float x) { return __builtin_amdgcn_rcpf(x); }
__device__ __forceinline__ float sigmoidf_(float x) { return fast_rcp(1.0f + fast_exp2(-x * LOG2E)); }

__device__ __forceinline__ int opaque_tid() { int t = threadIdx.x; asm volatile("" : "+v"(t)); return t; }

namespace pg8 {
constexpr int BM = 256, BK = 64, HALF = 128, HTB = HALF * BK * 2, STAGE_BYTES = 8 * HTB, NXCD = 8, WGM = 8;
__host__ __device__ __forceinline__ int lds_byte(int r, int c) { const int st = (r >> 4) * 2 + (c >> 5), rr = r & 15, cc = c & 31, ob = rr * 64 + cc * 2; return st * 1024 + (ob ^ (((ob >> 9) & 1) << 5)); }
__host__ __device__ __forceinline__ void stage_rc(int b, int& R, int& C) { const int st = b / 1024, sb = b % 1024, swz = sb ^ (((sb >> 9) & 1) << 5); R = (st >> 1) * 16 + swz / 64; C = (st & 1) * 32 + (swz % 64) / 2; }
__host__ __device__ __forceinline__ int perm32(int rho) { const int n = rho >> 4, i = rho & 15; return 8 * (i >> 2) + 4 * n + (i & 3); }

struct Unit { int pm, pn; const char* a; const char* b; };
struct Gemm { int lda, ldb, K; };

__device__ __forceinline__ void tile_of(int L, int nM, int nN, int& pm, int& pn) {
    const int nwg = nM * nN;
    int wgid = L; { const int q = nwg / NXCD, r = nwg % NXCD, xcd = wgid % NXCD, off = wgid / NXCD; wgid = (xcd < r ? xcd * (q + 1) : r * (q + 1) + (xcd - r) * q) + off; }
    const int nig = WGM * nN, gid = wgid / nig, fm = gid * WGM, gsz = (nM - fm) < WGM ? (nM - fm) : WGM;
    pm = fm + ((wgid % nig) % gsz); pn = (wgid % nig) / gsz;
}
struct DenseOrder {
    const char* A; const char* Bt; int lda, ldb, nM, nN, G, c;
    __device__ __forceinline__ void init(const void* A_, int lda_, const void* Bt_, int ldb_, int M, int N, int G_, int c_) { A = (const char*)A_; Bt = (const char*)Bt_; lda = lda_; ldb = ldb_; nM = M / BM; nN = N / BM; G = G_; c = c_; }
    __device__ __forceinline__ bool next(int i, Unit& u) const {
        const long L = (long)i * G + c; if (L >= (long)nM * nN) return false;
        tile_of((int)L, nM, nN, u.pm, u.pn);
        u.a = A + (size_t)u.pm * BM * lda * 2; u.b = Bt + (size_t)u.pn * BM * ldb * 2; return true;
    }
};
struct MoeOrder {
    const char* A; const char* Bt; size_t bstride; int lda, ldb, nM, nN, G, c; int tend[8];
    __device__ __forceinline__ bool next(int i, Unit& u) const {
        const long L = (long)i * G + c; if (L >= (long)nM * nN) return false;
        tile_of((int)L, nM, nN, u.pm, u.pn);
        int e = 0;
#pragma unroll
        for (int k = 0; k < 7; ++k) e += (u.pm >= tend[k]) ? 1 : 0;
        u.a = A + (size_t)u.pm * BM * lda * 2; u.b = Bt + (size_t)e * bstride + (size_t)u.pn * BM * ldb * 2; return true;
    }
};

template <class Epi, class Sched, bool ALIGN_EPI = true>
__device__ __forceinline__ void gemm_phase(LAS unsigned char* lds, const Gemm g, const Sched& S, const Epi& E) {
    const int tid = opaque_tid(), wid = __builtin_amdgcn_readfirstlane(tid >> 6), lane = tid & 63, wr = wid >> 2, wc = wid & 3, fr = lane & 15, fq = lane >> 4;
    int K = g.K; asm volatile("" : "+s"(K));
    const int nt = K / BK;
    unsigned voffA[2], voffB[2];
#pragma unroll
    for (int i = 0; i < 2; ++i) { int R, C; stage_rc(tid * 16 + i * 8192, R, C); const int Rb = Epi::PERM ? ((R & ~31) + perm32(R & 31)) : R;
        voffA[i] = (unsigned)(R * g.lda + C) * 2u; voffB[i] = (unsigned)(Rb * g.ldb + C) * 2u; }
    const size_t kstep = (size_t)(BK * 2);
    const size_t hstepA = (size_t)HALF * g.lda * 2, hstepB = (size_t)HALF * g.ldb * 2;
    const unsigned ldsw = (unsigned)wid * 1024u;
    const int aoff = lds_byte(wr * 64 + fr, fq * 8), boff = lds_byte(wc * 32 + fr, fq * 8);
#define PG8_SA(b, h) (((b) * 2 + (h)) * HTB)
#define PG8_SB(b, h) ((4 + (b) * 2 + (h)) * HTB)
#define PG8_STAGE(bufoff, gbase, voff) do { _Pragma("unroll") for (int _i = 0; _i < 2; ++_i) \
        __builtin_amdgcn_global_load_lds((const unsigned*)((const char*)(gbase) + (voff)[_i]), (LAS unsigned*)(lds + (bufoff) + ldsw + _i * 8192), 16, 0, 0); } while (0)
#define PG8_LDA(dst, b, h) do { _Pragma("unroll") for (int m = 0; m < 4; ++m) _Pragma("unroll") for (int k = 0; k < 2; ++k) dst[m][k] = *(const LAS bf16x8*)(lds + PG8_SA(b, h) + aoff + m * 2048 + k * 1024); } while (0)
#define PG8_LDB(dst, b, h) do { _Pragma("unroll") for (int n = 0; n < 2; ++n) _Pragma("unroll") for (int k = 0; k < 2; ++k) dst[n][k] = *(const LAS bf16x8*)(lds + PG8_SB(b, h) + boff + n * 2048 + k * 1024); } while (0)
#define PG8_MMA(ai, bj, At, Bt) do { __builtin_amdgcn_s_setprio(1); _Pragma("unroll") for (int m = 0; m < 4; ++m) _Pragma("unroll") for (int n = 0; n < 2; ++n) _Pragma("unroll") for (int k = 0; k < 2; ++k) \
        acc[ai][bj][m][n] = __builtin_amdgcn_mfma_f32_16x16x32_bf16(Bt[n][k], At[m][k], acc[ai][bj][m][n], 0, 0, 0); __builtin_amdgcn_s_setprio(0); } while (0)
#define PG8_WAIT_V(n) asm volatile("s_waitcnt vmcnt(" #n ")" ::: "memory")
#define PG8_WAIT_L(n) asm volatile("s_waitcnt lgkmcnt(" #n ")" ::: "memory")
#define PG8_BAR __builtin_amdgcn_s_barrier()
#define PG8_SCHED __builtin_amdgcn_sched_barrier(0)
    Unit cur, nxt; int ui = 0;
    if (!S.next(0, cur)) return;
    f32x4 acc[2][2][4][2];
#pragma unroll
    for (int a = 0; a < 2; ++a)
#pragma unroll
        for (int b = 0; b < 2; ++b)
#pragma unroll
            for (int m = 0; m < 4; ++m)
#pragma unroll
                for (int n = 0; n < 2; ++n) acc[a][b][m][n] = (f32x4){0.f, 0.f, 0.f, 0.f};
    bf16x8 At[4][2], B0[2][2], B1[2][2];
    const char* cA = cur.a; const char* cB = cur.b;
    PG8_STAGE(PG8_SB(0, 0), cB, voffB); PG8_STAGE(PG8_SB(0, 1), cB + hstepB, voffB); PG8_STAGE(PG8_SA(0, 0), cA, voffA); PG8_STAGE(PG8_SA(0, 1), cA + hstepA, voffA);
    if (wr == 1) PG8_BAR;
    PG8_WAIT_V(2); PG8_BAR;
    PG8_STAGE(PG8_SB(1, 0), cB + kstep, voffB); PG8_STAGE(PG8_SA(1, 0), cA + kstep, voffA); PG8_STAGE(PG8_SB(1, 1), cB + hstepB + kstep, voffB);
    PG8_WAIT_V(6); PG8_BAR;
    for (;;) {
        const bool has_next = S.next(ui + 1, nxt);
        const char* nA = has_next ? nxt.a : cA; const char* nB = has_next ? nxt.b : cB;
        for (int t = 0; t < nt; t += 2) {
            const bool last = (t == nt - 2);
            const char* a1 = cA + (size_t)(t + 1) * kstep;
            const char* a2 = last ? nA : cA + (size_t)(t + 2) * kstep; const char* b2 = last ? nB : cB + (size_t)(t + 2) * kstep;
            const char* a3 = a2 + kstep; const char* b3 = b2 + kstep;
            PG8_LDB(B0, 0, 0); PG8_LDB(B1, 0, 1); PG8_SCHED; PG8_LDA(At, 0, 0); PG8_STAGE(PG8_SA(1, 1), a1 + hstepA, voffA);
            PG8_WAIT_V(8); PG8_WAIT_L(0); PG8_BAR; PG8_MMA(0, 0, At, B0); PG8_MMA(0, 1, At, B1); PG8_BAR; PG8_SCHED;
            PG8_LDA(At, 0, 1); PG8_STAGE(PG8_SB(0, 0), b2, voffB); PG8_STAGE(PG8_SB(0, 1), b2 + hstepB, voffB); PG8_STAGE(PG8_SA(0, 0), a2, voffA);
            PG8_WAIT_V(8); PG8_WAIT_L(0); PG8_BAR; PG8_MMA(1, 0, At, B0); PG8_MMA(1, 1, At, B1); PG8_BAR; PG8_SCHED;
            PG8_LDB(B0, 1, 0); PG8_LDB(B1, 1, 1); PG8_SCHED; PG8_LDA(At, 1, 0); PG8_STAGE(PG8_SA(0, 1), a2 + hstepA, voffA);
            PG8_WAIT_V(8); PG8_WAIT_L(0); PG8_BAR; PG8_MMA(0, 0, At, B0); PG8_MMA(0, 1, At, B1); PG8_BAR; PG8_SCHED;
            PG8_LDA(At, 1, 1); PG8_STAGE(PG8_SB(1, 0), b3, voffB); PG8_STAGE(PG8_SB(1, 1), b3 + hstepB, voffB); PG8_STAGE(PG8_SA(1, 0), a3, voffA);
            PG8_WAIT_V(8); PG8_WAIT_L(0); PG8_BAR; PG8_MMA(1, 0, At, B0); PG8_MMA(1, 1, At, B1); PG8_BAR; PG8_SCHED;
        }
        if constexpr (ALIGN_EPI) { if (wr == 0) PG8_BAR; }
        { int fr_ = fr, fq_ = fq; asm volatile("" : "+v"(fr_), "+v"(fq_)); E(acc, cur, wr, wc, fr_, fq_); }
        if (!has_next) break;
#pragma unroll
        for (int a = 0; a < 2; ++a)
#pragma unroll
            for (int b = 0; b < 2; ++b)
#pragma unroll
                for (int m = 0; m < 4; ++m)
#pragma unroll
                    for (int n = 0; n < 2; ++n) acc[a][b][m][n] = (f32x4){0.f, 0.f, 0.f, 0.f};
        cur = nxt; cA = nA; cB = nB; ++ui;
        if constexpr (ALIGN_EPI) { if (wr == 1) PG8_BAR; }
    }
    PG8_WAIT_V(0);
    if constexpr (!ALIGN_EPI) { if (wr == 0) PG8_BAR; }
    PG8_BAR;
#undef PG8_SA
#undef PG8_SB
#undef PG8_STAGE
#undef PG8_LDA
#undef PG8_LDB
#undef PG8_MMA
#undef PG8_WAIT_V
#undef PG8_WAIT_L
#undef PG8_BAR
#undef PG8_SCHED
}

typedef f32x4 Acc[2][2][4][2];

struct EpiZ { static constexpr bool PERM = true;
    bf16_t* O; int ldc; const u64* ssq;
    __device__ __forceinline__ void operator()(const Acc& acc, const Unit& u, int wr, int wc, int fr, int fq) const {
        const int row0 = u.pm * BM + wr * 64 + fr, col0 = u.pn * BM + wc * 32 + 8 * fq;
#pragma unroll
        for (int ai = 0; ai < 2; ++ai)
#pragma unroll
            for (int m = 0; m < 4; ++m) { const int row = row0 + ai * HALF + m * 16; const float rs = rstd_of(ssq, row);
                bf16_t* rowp = O + (size_t)row * ldc + col0;
#pragma unroll
                for (int bj = 0; bj < 2; ++bj) { const f32x4 v0 = acc[ai][bj][m][0] * rs, v1 = acc[ai][bj][m][1] * rs;
                    u32x4 w; w.x = cvt_pk_bf16(v0[0], v0[1]); w.y = cvt_pk_bf16(v0[2], v0[3]); w.z = cvt_pk_bf16(v1[0], v1[1]); w.w = cvt_pk_bf16(v1[2], v1[3]);
                    *(u32x4*)(rowp + bj * HALF) = w; } }
    }
};
struct EpiQ { static constexpr bool PERM = false;
    bf16_t* O; const float* rq; const float* cosT; const float* sinT;
    __device__ __forceinline__ void operator()(const Acc& acc, const Unit& u, int wr, int wc, int fr, int fq) const {
        const int row0 = u.pm * BM + wr * 64 + fr;
#pragma unroll
        for (int ai = 0; ai < 2; ++ai)
#pragma unroll
            for (int m = 0; m < 4; ++m) { const int row = row0 + ai * HALF + m * 16; const float rs = rq[row] * QS_MLA; const int pos = row & (SEQ - 1);
                const f32x4 cs = *(const f32x4*)(cosT + pos * 16 + 4 * fq), sn = *(const f32x4*)(sinT + pos * 16 + 4 * fq);
#pragma unroll
                for (int bj = 0; bj < 2; ++bj) { const int cb = u.pn * BM + bj * HALF + wc * 32; const bool rope = ((cb >> 5) % 3) == 2;
                    f32x4 v0 = acc[ai][bj][m][0] * rs, v1 = acc[ai][bj][m][1] * rs;
                    if (rope) { const f32x4 o0 = v0 * cs - v1 * sn, o1 = v1 * cs + v0 * sn; v0 = o0; v1 = o1; }
                    u32x2 w0, w1; w0.x = cvt_pk_bf16(v0[0], v0[1]); w0.y = cvt_pk_bf16(v0[2], v0[3]); w1.x = cvt_pk_bf16(v1[0], v1[1]); w1.y = cvt_pk_bf16(v1[2], v1[3]);
                    bf16_t* p = O + (size_t)row * 768 + cb + 4 * fq;
                    *(u32x2*)(p) = w0; *(u32x2*)(p + 16) = w1; } }
    }
};
struct EpiKV { static constexpr bool PERM = true;
    bf16_t* Kb; bf16_t* Vb; const float* rkv;
    __device__ __forceinline__ void operator()(const Acc& acc, const Unit& u, int wr, int wc, int fr, int fq) const {
        const int row0 = u.pm * BM + wr * 64 + fr;
#pragma unroll
        for (int ai = 0; ai < 2; ++ai)
#pragma unroll
            for (int m = 0; m < 4; ++m) { const int row = row0 + ai * HALF + m * 16; const float rs = rkv[row];
#pragma unroll
                for (int bj = 0; bj < 2; ++bj) { const int h = 2 * u.pn + bj; const f32x4 v0 = acc[ai][bj][m][0] * rs, v1 = acc[ai][bj][m][1] * rs;
                    u32x4 w; w.x = cvt_pk_bf16(v0[0], v0[1]); w.y = cvt_pk_bf16(v0[2], v0[3]); w.z = cvt_pk_bf16(v1[0], v1[1]); w.w = cvt_pk_bf16(v1[2], v1[3]);
                    bf16_t* p = (wc < 2) ? (Kb + (size_t)row * 768 + 96 * h + 32 * wc + 8 * fq) : (Vb + (size_t)row * 512 + 64 * h + 32 * (wc - 2) + 8 * fq);
                    *(u32x4*)p = w; } }
    }
};
struct EpiRes { static constexpr bool PERM = false;
    const float* base; float* X; bf16_t* XB; u64* ssq_next;
    __device__ __forceinline__ void operator()(const Acc& acc, const Unit& u, int wr, int wc, int fr, int fq) const {
        const int row0 = u.pm * BM + wr * 64 + fr, col0 = u.pn * BM + wc * 32 + 4 * fq;
#pragma unroll
        for (int ai = 0; ai < 2; ++ai)
#pragma unroll
            for (int m = 0; m < 4; ++m) { const int row = row0 + ai * HALF + m * 16; const size_t off = (size_t)row * DM + col0; float s = 0.f;
#pragma unroll
                for (int bj = 0; bj < 2; ++bj)
#pragma unroll
                    for (int n = 0; n < 2; ++n) { const f32x4 o = *(const f32x4*)(base + off + bj * HALF + n * 16) + acc[ai][bj][m][n];
                        *(f32x4*)(X + off + bj * HALF + n * 16) = o; s += (o[0] * o[0] + o[1] * o[1]) + (o[2] * o[2] + o[3] * o[3]);
                        u32x2 w; w.x = cvt_pk_bf16(o[0], o[1]); w.y = cvt_pk_bf16(o[2], o[3]); *(u32x2*)(XB + off + bj * HALF + n * 16) = w; }
                s += __shfl_xor(s, 16); s += __shfl_xor(s, 32);
                if (fq == 0) __hip_atomic_fetch_add(ssq_next + row, ssq_fix(s), RLX_AGENT);
                asm volatile("" ::: "memory"); }
    }
};
template <int MODE> struct EpiSwiGLU { static constexpr bool PERM = true;
    bf16_t* O; int ldc; const void* rsrc;
    __device__ __forceinline__ void operator()(const Acc& acc, const Unit& u, int wr, int wc, int fr, int fq) const {
        const int row0 = u.pm * BM + wr * 64 + fr, col0 = u.pn * HALF + wc * 32 + 8 * fq;
#pragma unroll
        for (int ai = 0; ai < 2; ++ai)
#pragma unroll
            for (int m = 0; m < 4; ++m) { const int row = row0 + ai * HALF + m * 16; const float rs = MODE == 0 ? rstd_of((const u64*)rsrc, row) : ((const float*)rsrc)[row];
                float o[8];
#pragma unroll
                for (int n = 0; n < 2; ++n)
#pragma unroll
                    for (int i = 0; i < 4; ++i) { const float gg = acc[ai][0][m][n][i] * rs, uu = acc[ai][1][m][n][i] * rs; o[n * 4 + i] = gg * sigmoidf_(gg) * uu; }
                u32x4 w; w.x = cvt_pk_bf16(o[0], o[1]); w.y = cvt_pk_bf16(o[2], o[3]); w.z = cvt_pk_bf16(o[4], o[5]); w.w = cvt_pk_bf16(o[6], o[7]);
                *(u32x4*)(O + (size_t)row * ldc + col0) = w; }
    }
};
struct EpiOddIn { static constexpr bool PERM = true;
    bf16_t* QKV; bf16_t* UV; const u64* ssq;
    __device__ __forceinline__ void operator()(const Acc& acc, const Unit& u, int wr, int wc, int fr, int fq) const {
        const int row0 = u.pm * BM + wr * 64 + fr; const bool isuv = u.pn >= 6; const float qsc = u.pn < 2 ? QS_BAND : 1.0f;
#pragma unroll
        for (int ai = 0; ai < 2; ++ai)
#pragma unroll
            for (int m = 0; m < 4; ++m) { const int row = row0 + ai * HALF + m * 16; const float rs = rstd_of(ssq, row);
#pragma unroll
                for (int bj = 0; bj < 2; ++bj) { float o[8];
#pragma unroll
                    for (int n = 0; n < 2; ++n)
#pragma unroll
                        for (int i = 0; i < 4; ++i) { float v = acc[ai][bj][m][n][i] * rs;
                            if (isuv) { const float t = 0.7978845608028654f * (v + 0.044715f * v * v * v); v = v * sigmoidf_(2.0f * t); } else v *= qsc;
                            o[n * 4 + i] = v; }
                    u32x4 w; w.x = cvt_pk_bf16(o[0], o[1]); w.y = cvt_pk_bf16(o[2], o[3]); w.z = cvt_pk_bf16(o[4], o[5]); w.w = cvt_pk_bf16(o[6], o[7]);
                    bf16_t* p = isuv ? (UV + (size_t)row * 1024 + (u.pn - 6) * BM + bj * HALF + wc * 32 + 8 * fq) : (QKV + (size_t)row * 1536 + u.pn * BM + bj * HALF + wc * 32 + 8 * fq);
                    *(u32x4*)p = w; } }
    }
};
struct EpiY { static constexpr bool PERM = true;
    bf16_t* O; const float* gate;
    __device__ __forceinline__ void operator()(const Acc& acc, const Unit& u, int wr, int wc, int fr, int fq) const {
        const int row0 = u.pm * BM + wr * 64 + fr, col0 = u.pn * BM + wc * 32 + 8 * fq;
#pragma unroll
        for (int ai = 0; ai < 2; ++ai)
#pragma unroll
            for (int m = 0; m < 4; ++m) { const int row = row0 + ai * HALF + m * 16; const float rs = gate[row];
                bf16_t* rowp = O + (size_t)row * DM + col0;
#pragma unroll
                for (int bj = 0; bj < 2; ++bj) { const f32x4 v0 = acc[ai][bj][m][0] * rs, v1 = acc[ai][bj][m][1] * rs;
                    u32x4 w; w.x = cvt_pk_bf16(v0[0], v0[1]); w.y = cvt_pk_bf16(v0[2], v0[3]); w.z = cvt_pk_bf16(v1[0], v1[1]); w.w = cvt_pk_bf16(v1[2], v1[3]);
                    *(u32x4*)(rowp + bj * HALF) = w; } }
    }
};
}

#define XB_TMO      128
#define XB_XCNT(j)  (256  + 64 * (j))
#define XB_XSUB(j)  (1280 + 64 * (j))
#define XB_XGEN(j)  (2304 + 64 * (j))
#define XB_TOP      3328
#define XB_TOPGEN   3392
#define XCD_BAR_WORDS 3456
#define XB_SPIN_CAP (1u << 18)
__device__ __forceinline__ unsigned xb_ld(unsigned* p)              { return __hip_atomic_load(p, __ATOMIC_RELAXED, __HIP_MEMORY_SCOPE_AGENT); }
__device__ __forceinline__ unsigned xb_add(unsigned* p, unsigned v) { return __hip_atomic_fetch_add(p, v, __ATOMIC_RELAXED, __HIP_MEMORY_SCOPE_AGENT); }
__device__ __forceinline__ unsigned xb_xcc_id() { return (unsigned)__builtin_amdgcn_s_getreg((3 << 11) | 20) & 0xFu; }
#define XB_SPIN(cond, bar) do { unsigned _sp = 0; while (cond) { __builtin_amdgcn_s_sleep(1); \
    if ((++_sp & 255u) == 0u) { if (xb_ld(&(bar)[XB_TMO])) break; if (_sp > XB_SPIN_CAP) { atomicAdd(&(bar)[XB_TMO], 1u); break; } } } } while (0)
struct XcdBarrier { unsigned* bar; unsigned x; volatile LAS unsigned* st; };
__device__ __forceinline__ XcdBarrier xcd_barrier_post(unsigned* bar, volatile LAS unsigned* st) {
    XcdBarrier b; b.bar = bar; b.x = xb_xcc_id(); b.st = st;
    if (threadIdx.x == 0) (void)xb_add(&bar[XB_XCNT(b.x)], 1u);
    return b;
}
__device__ __forceinline__ void xcd_barrier_complete(unsigned* bar, unsigned x, unsigned& nloc, unsigned& nx) {
    const unsigned G = gridDim.x * gridDim.y * gridDim.z;
    unsigned sum, cnt, mine, sp = 0u;
    for (;;) {
        sum = 0u; cnt = 0u; mine = 0u;
#pragma unroll
        for (unsigned j = 0; j < 16; ++j) { const unsigned c = xb_ld(&bar[XB_XCNT(j)]); sum += c; cnt += (c > 0u) ? 1u : 0u; mine = (j == x) ? c : mine; }
        if (sum == G) break;
        __builtin_amdgcn_s_sleep(1);
        if ((++sp & 255u) == 0u) { if (xb_ld(&bar[XB_TMO])) break; if (sp > XB_SPIN_CAP) { atomicAdd(&bar[XB_TMO], 1u); break; } }
    }
    nloc = mine > 0u ? mine : 1u; nx = cnt > 0u ? cnt : 1u;
}
__device__ __forceinline__ void xcd_barrier(const XcdBarrier& b) {
    asm volatile("s_waitcnt vmcnt(0)" ::: "memory");
    __syncthreads();
    if (threadIdx.x == 0) {
        unsigned* bar = b.bar;
        __builtin_amdgcn_s_waitcnt(0);
        unsigned nloc = b.st[0], nx = b.st[1];
        if (nloc == 0u) { xcd_barrier_complete(bar, b.x, nloc, nx); b.st[0] = nloc; b.st[1] = nx; }
        const unsigned old = xb_add(&bar[XB_XSUB(b.x)], 1u);
        const unsigned gen = old / nloc;
        if (old + 1u == (gen + 1u) * nloc) {
            __builtin_amdgcn_fence(__ATOMIC_RELEASE, "agent");
            asm volatile("s_waitcnt vmcnt(0)" ::: "memory");
            const unsigned og = xb_add(&bar[XB_TOP], 1u);
            const unsigned tg = og / nx;
            if (og + 1u == (tg + 1u) * nx) xb_add(&bar[XB_TOPGEN], 1u);
            else XB_SPIN(xb_ld(&bar[XB_TOPGEN]) == tg, bar);
            __builtin_amdgcn_fence(__ATOMIC_ACQUIRE, "agent");
            xb_add(&bar[XB_XGEN(b.x)], 1u);
            asm volatile("s_waitcnt vmcnt(0)" ::: "memory");
        } else {
            XB_SPIN(xb_ld(&bar[XB_XGEN(b.x)]) == gen, bar);
            __builtin_amdgcn_fence(__ATOMIC_ACQUIRE, "agent");
            asm volatile("s_waitcnt vmcnt(0)" ::: "memory");
        }
    }
    __syncthreads();
}

struct Frame {
    LAS unsigned char* lds;
    unsigned* ctl;
    int tid, lane, wave, vcu, G;
    __device__ __forceinline__ void refresh() { tid = opaque_tid(); lane = tid & 63; wave = __builtin_amdgcn_readfirstlane(tid >> 6); }
};

struct XJob { const float* W; const float* gain; bf16_t* WT; int K, N, ldt, mode, nb; size_t sb, db; int istart; };
__device__ __forceinline__ void xpose_item(const XJob& J, int item, LAS float* scr, int lane) {
    const int nblk = (J.N + 63) / 64, per = (J.K / 64) * nblk, e = item / per, r = item % per, kb = r / nblk, nbk = r % nblk, k0 = 64 * kb, n0 = 64 * nbk;
    const float* W = J.W + (size_t)e * J.sb; bf16_t* WT = J.WT + (size_t)e * J.db;
    const int lr = lane >> 4, lc = 4 * (lane & 15);
    const bool colok = (n0 + lc) < J.N;
    f32x4 v[16];
#pragma unroll
    for (int i = 0; i < 16; ++i) v[i] = colok ? *(const f32x4*)(W + (size_t)(k0 + 4 * i + lr) * J.N + n0 + lc) : (f32x4){0.f, 0.f, 0.f, 0.f};
#pragma unroll
    for (int i = 0; i < 16; ++i) { const int kk = 4 * i + lr; const float gs = J.gain ? J.gain[k0 + kk] : 1.0f; LAS float* d = scr + kk * 65 + lc;
        d[0] = v[i][0] * gs; d[1] = v[i][1] * gs; d[2] = v[i][2] * gs; d[3] = v[i][3] * gs; }
    LDS_WAIT(); asm volatile("" ::: "memory");
    const int c = lane & 7;
#pragma unroll
    for (int j = 0; j < 8; ++j) { const int n = (lane >> 3) + 8 * j; const LAS float* s = scr + (8 * c) * 65 + n;
        u32x4 o; o.x = cvt_pk_bf16(s[0 * 65], s[1 * 65]); o.y = cvt_pk_bf16(s[2 * 65], s[3 * 65]); o.z = cvt_pk_bf16(s[4 * 65], s[5 * 65]); o.w = cvt_pk_bf16(s[6 * 65], s[7 * 65]);
        const int ng = n0 + n; const int row = J.mode == 0 ? ng : ((ng >> 7) * 256 + (ng & 127) + (J.mode == 2 ? 128 : 0));
        if (ng < J.N) *(u32x4*)(WT + (size_t)row * J.ldt + k0 + 8 * c) = o; }
    LDS_WAIT(); asm volatile("" ::: "memory");
}
constexpr int NJT = 12;
__device__ __forceinline__ void make_job(int i, int t, const float* const* in, unsigned char* ws, XJob& J) {
    J.gain = nullptr; J.mode = 0; J.nb = 1; J.sb = 0; J.db = 0; J.istart = 0;
    bf16_t* WE = (bf16_t*)(ws + WS_WE) + (size_t)i * E_SIZE; bf16_t* WO = (bf16_t*)(ws + WS_WO) + (size_t)i * O_SIZE;
    switch (t) {
    case 0: J.W = in[2] + (size_t)i * 1024 * 928; J.gain = in[1] + i * 1024; J.WT = WE + E_WIN; J.K = 1024; J.N = 928; J.ldt = 1024; break;
    case 1: J.W = in[6] + (size_t)i * 256 * 768; J.gain = in[5] + i * 256; J.WT = WE + E_WQ; J.K = 256; J.N = 768; J.ldt = 256; break;
    case 2: J.W = in[8] + (size_t)i * 128 * 1024; J.gain = in[7] + i * 128; J.WT = WE + E_WKV; J.K = 128; J.N = 1024; J.ldt = 256; break;
    case 3: J.W = in[9] + (size_t)i * 1024 * 1024 + (size_t)512 * 1024; J.WT = WE + E_WOUT + 512; J.K = 512; J.N = 1024; J.ldt = 1024; break;
    case 4: J.W = in[11] + (size_t)i * 1024 * FF; J.gain = in[10] + i * 1024; J.WT = WE + E_WGU; J.K = 1024; J.N = FF; J.ldt = 1024; J.mode = 1; break;
    case 5: J.W = in[12] + (size_t)i * 1024 * FF; J.gain = in[10] + i * 1024; J.WT = WE + E_WGU; J.K = 1024; J.N = FF; J.ldt = 1024; J.mode = 2; break;
    case 6: J.W = in[13] + (size_t)i * FF * 1024; J.WT = WE + E_WDN; J.K = FF; J.N = 1024; J.ldt = FF; break;
    case 7: J.W = in[15] + (size_t)i * 1024 * 2560; J.gain = in[14] + i * 1024; J.WT = WO + O_WIN; J.K = 1024; J.N = 2560; J.ldt = 1024; break;
    case 8: J.W = in[21] + (size_t)i * 1024 * 1024; J.WT = WO + O_WOUT; J.K = 1024; J.N = 1024; J.ldt = 1024; break;
    case 9: J.W = in[24] + (size_t)i * NEXP * 1024 * EFF; J.gain = in[22] + i * 1024; J.WT = WO + O_WGU; J.K = 1024; J.N = EFF; J.ldt = 1024; J.mode = 1; J.nb = NEXP; J.sb = (size_t)1024 * EFF; J.db = (size_t)2 * EFF * 1024; break;
    case 10: J.W = in[25] + (size_t)i * NEXP * 1024 * EFF; J.gain = in[22] + i * 1024; J.WT = WO + O_WGU; J.K = 1024; J.N = EFF; J.ldt = 1024; J.mode = 2; J.nb = NEXP; J.sb = (size_t)1024 * EFF; J.db = (size_t)2 * EFF * 1024; break;
    default: J.W = in[26] + (size_t)i * NEXP * EFF * 1024; J.WT = WO + O_WDN; J.K = EFF; J.N = 1024; J.ldt = EFF; J.nb = NEXP; J.sb = (size_t)EFF * 1024; J.db = (size_t)1024 * EFF; break;
    }
}
__host__ __device__ constexpr int job_items_t(int t) {
    return t == 0 ? 16 * 15 : t == 1 ? 4 * 12 : t == 2 ? 2 * 16 : t == 3 ? 8 * 16 : t == 4 ? 16 * 44 : t == 5 ? 16 * 44 : t == 6 ? 44 * 16 : t == 7 ? 16 * 40 : t == 8 ? 16 * 16 : t == 9 ? 8 * 16 * 56 : t == 10 ? 8 * 16 * 56 : 8 * 56 * 16;
}
__host__ __device__ constexpr int job_start_t(int t) { int a = 0; for (int k = 0; k < t; ++k) a += job_items_t(k); return a; }
constexpr int ITEMS_PER_PAIR = job_start_t(NJT);

__device__ __forceinline__ void p0_prologue(Frame& F, const float* const* in, unsigned char* ws) {
    F.refresh();
    LAS float* scr = (LAS float*)(F.lds + F.wave * 16640);
    const int gw = F.vcu * NWAVES + F.wave, NGW = F.G * NWAVES;
    for (int it = gw; it < 2 * ITEMS_PER_PAIR; it += NGW) {
        const int i = it / ITEMS_PER_PAIR, r = it % ITEMS_PER_PAIR;
        int t = 0;
#pragma unroll
        for (int k = 1; k < NJT; ++k) t += (r >= job_start_t(k)) ? 1 : 0;
        int st = 0;
#pragma unroll
        for (int k = 1; k < NJT; ++k) st = (t == k) ? job_start_t(k) : st;
        XJob J; make_job(i, t, in, ws, J);
        xpose_item(J, r - st, scr, F.lane);
    }
    const int gt = F.vcu * 512 + F.tid, NGT = F.G * 512;
    for (int i = 0; i < 2; ++i) {
        bf16_t* WE = (bf16_t*)(ws + WS_WE) + (size_t)i * E_SIZE;
        for (int x = gt; x < 96 * 1024 / 8; x += NGT) *(u32x4*)(WE + E_WIN + (size_t)928 * 1024 + (size_t)x * 8) = (u32x4){0u, 0u, 0u, 0u};
        for (int x = gt; x < 1024 * 16; x += NGT) { const int r = x >> 4, c = x & 15; *(u32x4*)(WE + E_WKV + (size_t)r * 256 + 128 + c * 8) = (u32x4){0u, 0u, 0u, 0u}; }
        const float* pw = in[3] + (size_t)i * 4 * 128 * 128; const float* ps = in[4] + (size_t)i * 512; const float* wo = in[9] + (size_t)i * 1024 * 1024;
        for (int x = gt; x < 512 * 1024; x += NGT) { const int n = x & 1023, k = x >> 10, g = k >> 7, c = k & 127; float a = 0.f;
            const float* pr = pw + ((size_t)g * 128 + c) * 128; const float* sr = ps + g * 128; const float* wr_ = wo + (size_t)(g * 128) * 1024 + n;
#pragma unroll 8
            for (int d = 0; d < 128; ++d) a += pr[d] * sr[d] * wr_[(size_t)d * 1024];
            WE[E_WOUT + (size_t)n * 1024 + k] = f2bf(a); }
    }
    { float* cosT = (float*)(ws + T_COS); float* sinT = (float*)(ws + T_SIN);
      for (int x = gt; x < SEQ * 16; x += NGT) { const int pos = x >> 4, j = x & 15;
          const float inv = 1.0f / powf(10000.0f, (float)(2 * j) / 32.0f); const float angf = (float)pos * inv;
          double a = (double)angf; const double twopi = 6.283185307179586476925; a -= twopi * rint(a / twopi);
          const double y = a * 0.125, y2 = y * y;
          double s = y * (1.0 + y2 * (-1.0 / 6 + y2 * (1.0 / 120 + y2 * (-1.0 / 5040 + y2 * (1.0 / 362880 + y2 * (-1.0 / 39916800 + y2 * (1.0 / 6227020800.0)))))));
          double c = 1.0 + y2 * (-0.5 + y2 * (1.0 / 24 + y2 * (-1.0 / 720 + y2 * (1.0 / 40320 + y2 * (-1.0 / 3628800 + y2 * (1.0 / 479001600.0 + y2 * (-1.0 / 87178291200.0)))))));
#pragma unroll
          for (int k = 0; k < 3; ++k) { const double s2 = 2.0 * s * c, c2 = c * c - s * s; s = s2; c = c2; }
          cosT[x] = (float)c; sinT[x] = (float)s; } }
    { const float* x = in[0]; bf16_t* XB = (bf16_t*)(ws + WS_XB); u64* ssq = (u64*)(ws + WS_SSQ);
      for (int m = gw; m < NTOK; m += NGW) { const f32x4* xr = (const f32x4*)(x + (size_t)m * DM) + F.lane; float s = 0.f;
#pragma unroll
          for (int j = 0; j < 4; ++j) { const f32x4 v = xr[64 * j]; s += (v[0] * v[0] + v[1] * v[1]) + (v[2] * v[2] + v[3] * v[3]);
              u32x2 w; w.x = cvt_pk_bf16(v[0], v[1]); w.y = cvt_pk_bf16(v[2], v[3]); *((u32x2*)(XB + (size_t)m * DM) + F.lane + 64 * j) = w; }
          s = wave_sum(s); if (F.lane == 0) ssq[m] = ssq_fix(s); } }
}

__device__ __forceinline__ void p_even_mid(Frame& F, unsigned char* ws) {
    F.refresh();
    const bf16_t* Z = (const bf16_t*)(ws + R_Z); bf16_t* MIX = (bf16_t*)(ws + R_MIX); bf16_t* Kb = (bf16_t*)(ws + R_K);
    float* RQ = (float*)(ws + T_RQ); float* RKV = (float*)(ws + T_RKV); const float* cosT = (const float*)(ws + T_COS); const float* sinT = (const float*)(ws + T_SIN);
    for (int blk = F.vcu; blk < NTOK / 64; blk += F.G) {
        const int rb = blk * 64;
        { const int c = F.tid, g = c >> 7, w = 2 << g;
          for (int r = 0; r < 64; ++r) { const int t = rb + r, p = t & (SEQ - 1); const int cnt = (p + 1 < w) ? (p + 1) : w; float s = 0.f;
              for (int j = 0; j < cnt; ++j) s += bf2f(Z[(size_t)(t - j) * 1024 + c]);
              const float self = bf2f(Z[(size_t)t * 1024 + c]);
              MIX[(size_t)t * 1024 + c] = f2bf(s / (float)cnt - self); } }
        for (int r = F.wave; r < 64; r += NWAVES) { const int t = rb + r, p = t & (SEQ - 1); const bf16_t* zr = Z + (size_t)t * 1024;
            const u32x2 q = *((const u32x2*)(zr + 512) + F.lane); const unsigned kv = *((const unsigned*)(zr + 768) + F.lane);
            float sq = bflo(q.x) * bflo(q.x) + bfhi(q.x) * bfhi(q.x) + bflo(q.y) * bflo(q.y) + bfhi(q.y) * bfhi(q.y);
            float sk = bflo(kv) * bflo(kv) + bfhi(kv) * bfhi(kv);
            sq = wave_sum(sq); sk = wave_sum(sk);
            if (F.lane == 0) { RQ[t] = rsqrtf(sq * (1.0f / 256.0f) + EPS); RKV[t] = rsqrtf(sk * (1.0f / 128.0f) + EPS); }
            if (F.lane < 16) { const int j = F.lane; const float x1 = bf2f(zr[896 + j]), x2 = bf2f(zr[912 + j]); const float c = cosT[p * 16 + j], s = sinT[p * 16 + j];
                const bf16_t o1 = f2bf(x1 * c - x2 * s), o2 = f2bf(x2 * c + x1 * s); bf16_t* kr = Kb + (size_t)t * 768;
#pragma unroll
                for (int h = 0; h < 8; ++h) { kr[96 * h + 64 + j] = o1; kr[96 * h + 80 + j] = o2; } } }
    }
}

__device__ __forceinline__ int crow(int r, int hi) { return (r & 3) + 8 * (r >> 2) + 4 * hi; }
__device__ __forceinline__ s16x4 vtr(const LAS unsigned char* p) { return __builtin_bit_cast(s16x4, __builtin_amdgcn_ds_read_tr16_b64_v4i16((LAS s16x4*)p)); }

template <int DQK, bool BAND>
__device__ __forceinline__ void attn_unit(const bf16_t* __restrict__ Qp, int ldq, const bf16_t* __restrict__ Kp, int ldk, const bf16_t* __restrict__ Vp, int ldv,
                                          bf16_t* Op, int ldo, int b, int qb, LAS unsigned char* lds, const float* bias_g) {
    constexpr int KSTR = (DQK + 8) * 2, KBUF = 64 * KSTR, VBUF = 8192, KCH = DQK / 8, NKS = DQK / 16;
    const int tid = opaque_tid(), lane = tid & 63, wave = __builtin_amdgcn_readfirstlane(tid >> 6), r32 = lane & 31, hi = lane >> 5;
    LAS unsigned char* Kl = lds; LAS unsigned char* Vl = lds + 2 * KBUF;
    LAS float* sc = (LAS float*)(lds + 2 * KBUF + 2 * VBUF) + wave * 32;
    LAS float* biasL = (LAS float*)(lds + 2 * KBUF + 2 * VBUF + 1024);
    const int chunkw = 4 * qb + (wave >> 1), t1 = 4 * qb + 3, t0 = BAND ? ((4 * qb - 8) > 0 ? (4 * qb - 8) : 0) : 0;
    const size_t rowb = (size_t)b * SEQ;
    if (BAND) { if (tid < 257) biasL[tid] = bias_g[tid] * LOG2E; }
    bf16x8 qf[NKS];
    { const bf16_t* qrow = Qp + (rowb + 256 * qb + 32 * wave + r32) * ldq + 8 * hi;
#pragma unroll
      for (int ks = 0; ks < NKS; ++ks) qf[ks] = *(const bf16x8*)(qrow + 16 * ks); }
    const int kkey0 = tid / KCH, kch0 = tid % KCH; const int idx1 = tid + 512; const bool has1 = idx1 < 64 * KCH; const int kkey1 = has1 ? idx1 / KCH : 0, kch1 = has1 ? idx1 % KCH : 0;
    const int vkey = tid >> 3, vch = tid & 7;
    const bf16_t* kg0 = Kp + (rowb + kkey0) * ldk + 8 * kch0; const bf16_t* kg1 = Kp + (rowb + kkey1) * ldk + 8 * kch1; const bf16_t* vg = Vp + (rowb + vkey) * ldv + 8 * vch;
    const int kl0 = kkey0 * KSTR + kch0 * 16, kl1 = kkey1 * KSTR + kch1 * 16, vl = (vch >> 2) * 4096 + vkey * 64 + (vch & 3) * 16;
    u32x4 kr0, kr1 = (u32x4){0u, 0u, 0u, 0u}, vr;
    { const size_t to = (size_t)t0 * 64; kr0 = *(const u32x4*)(kg0 + to * ldk); if (has1) kr1 = *(const u32x4*)(kg1 + to * ldk); vr = *(const u32x4*)(vg + to * ldv);
      *(LAS u32x4*)(Kl + kl0) = kr0; if (has1) *(LAS u32x4*)(Kl + kl1) = kr1; *(LAS u32x4*)(Vl + vl) = vr; }
    __syncthreads();
    float m_run = -INFINITY, l_run = 0.f; f32x16 o0 = {}, o1 = {};
    const int vtoff = (16 * ((lane >> 4) & 1) + 4 * (lane & 3)) * 2 + (4 * hi + ((lane & 15) >> 2)) * 64;
    for (int t = t0; t <= t1; ++t) {
        const int cur = (t - t0) & 1; const bool more = t < t1;
        if (more) { const size_t to = (size_t)(t + 1) * 64; kr0 = *(const u32x4*)(kg0 + to * ldk); if (has1) kr1 = *(const u32x4*)(kg1 + to * ldk); vr = *(const u32x4*)(vg + to * ldv); }
        const bool active = BAND ? (t <= chunkw && t >= chunkw - 8) : (t <= chunkw);
        if (active) {
            const LAS unsigned char* Ks = Kl + cur * KBUF; const LAS unsigned char* Vs = Vl + cur * VBUF;
            f32x16 s0 = {}, s1 = {};
#pragma unroll
            for (int ks = 0; ks < NKS; ++ks) {
                const bf16x8 k0 = *(const LAS bf16x8*)(Ks + r32 * KSTR + ks * 32 + hi * 16);
                const bf16x8 k1 = *(const LAS bf16x8*)(Ks + (32 + r32) * KSTR + ks * 32 + hi * 16);
                s0 = __builtin_amdgcn_mfma_f32_32x32x16_bf16(k0, qf[ks], s0, 0, 0, 0);
                s1 = __builtin_amdgcn_mfma_f32_32x32x16_bf16(k1, qf[ks], s1, 0, 0, 0);
            }
            if (BAND) {
                if (t <= chunkw - 3) { const float cb = biasL[256];
#pragma unroll
                    for (int r = 0; r < 16; ++r) { s0[r] += cb; s1[r] += cb; } }
                else { const int qpos = 256 * qb + 32 * wave + r32, kb0 = 64 * t;
#pragma unroll
                    for (int r = 0; r < 16; ++r) { const int rel = qpos - (kb0 + crow(r, hi)); int i0 = rel < -128 ? -128 : (rel > 128 ? 128 : rel); int rel1 = rel - 32; int i1 = rel1 < -128 ? -128 : (rel1 > 128 ? 128 : rel1);
                        s0[r] += biasL[i0 + 128]; s1[r] += biasL[i1 + 128]; } }
            }
            float mx = s0[0];
#pragma unroll
            for (int r = 1; r < 16; ++r) mx = fmaxf(mx, s0[r]);
#pragma unroll
            for (int r = 0; r < 16; ++r) mx = fmaxf(mx, s1[r]);
            mx = fmaxf(mx, __shfl_xor(mx, 32));
            const float m_new = fmaxf(m_run, mx), alpha = fast_exp2(m_run - m_new); m_run = m_new;
            float ps = 0.f;
#pragma unroll
            for (int r = 0; r < 16; ++r) { s0[r] = fast_exp2(s0[r] - m_new); s1[r] = fast_exp2(s1[r] - m_new); ps += s0[r] + s1[r]; }
            l_run = l_run * alpha + ps;
            if (hi == 0) sc[r32] = alpha;
            LDS_WAIT();
#pragma unroll
            for (int r = 0; r < 16; ++r) { const float a = sc[crow(r, hi)]; o0[r] *= a; o1[r] *= a; }
            LDS_WAIT();
#pragma unroll
            for (int hf = 0; hf < 2; ++hf)
#pragma unroll
                for (int s2 = 0; s2 < 2; ++s2) {
                    u32x4 pw;
                    if (hf == 0) { pw.x = cvt_pk_bf16(s0[8 * s2 + 0], s0[8 * s2 + 1]); pw.y = cvt_pk_bf16(s0[8 * s2 + 2], s0[8 * s2 + 3]); pw.z = cvt_pk_bf16(s0[8 * s2 + 4], s0[8 * s2 + 5]); pw.w = cvt_pk_bf16(s0[8 * s2 + 6], s0[8 * s2 + 7]); }
                    else         { pw.x = cvt_pk_bf16(s1[8 * s2 + 0], s1[8 * s2 + 1]); pw.y = cvt_pk_bf16(s1[8 * s2 + 2], s1[8 * s2 + 3]); pw.z = cvt_pk_bf16(s1[8 * s2 + 4], s1[8 * s2 + 5]); pw.w = cvt_pk_bf16(s1[8 * s2 + 6], s1[8 * s2 + 7]); }
                    const bf16x8 pa = __builtin_bit_cast(bf16x8, pw);
                    const LAS unsigned char* vb = Vs + (32 * hf + 16 * s2) * 64 + vtoff;
#pragma unroll
                    for (int dh = 0; dh < 2; ++dh) {
                        const s16x4 lo = vtr(vb + dh * 4096), hh = vtr(vb + dh * 4096 + 8 * 64);
                        const bf16x8 vf = (bf16x8){lo[0], lo[1], lo[2], lo[3], hh[0], hh[1], hh[2], hh[3]};
                        if (dh == 0) o0 = __builtin_amdgcn_mfma_f32_32x32x16_bf16(pa, vf, o0, 0, 0, 0);
                        else         o1 = __builtin_amdgcn_mfma_f32_32x32x16_bf16(pa, vf, o1, 0, 0, 0);
                    }
                }
        }
        if (more) { const int nx = cur ^ 1; *(LAS u32x4*)(Kl + nx * KBUF + kl0) = kr0; if (has1) *(LAS u32x4*)(Kl + nx * KBUF + kl1) = kr1; *(LAS u32x4*)(Vl + nx * VBUF + vl) = vr; }
        __syncthreads();
    }
    { const float lt = l_run + __shfl_xor(l_run, 32);
      if (hi == 0) sc[r32] = fast_rcp(lt);
      LDS_WAIT();
      bf16_t* orow = Op + (rowb + 256 * qb + 32 * wave) * ldo + r32;
#pragma unroll
      for (int r = 0; r < 16; ++r) { const int q = crow(r, hi); const float inv = sc[q];
          orow[(size_t)q * ldo] = f2bf(o0[r] * inv); orow[(size_t)q * ldo + 32] = f2bf(o1[r] * inv); }
      LDS_WAIT(); }
}

__device__ __forceinline__ void sgu_unit(const bf16_t* UV, const float* ng, const float* nb, const float* W, const float* bs, bf16_t* MIX, int b, int n, int g, LAS unsigned char* lds) {
    const int tid = opaque_tid(), lane = tid & 63, wave = __builtin_amdgcn_readfirstlane(tid >> 6), r32 = lane & 31, hi = lane >> 5;
    const size_t t0 = (size_t)b * SEQ + (size_t)n * 128;
    { const int s = tid >> 2, qd = tid & 3; const bf16_t* src = UV + (t0 + s) * 1024 + 512 + g * 128 + 32 * qd;
      float x[32];
#pragma unroll
      for (int j = 0; j < 4; ++j) { const u32x4 v = *((const u32x4*)src + j); x[8 * j + 0] = bflo(v.x); x[8 * j + 1] = bfhi(v.x); x[8 * j + 2] = bflo(v.y); x[8 * j + 3] = bfhi(v.y); x[8 * j + 4] = bflo(v.z); x[8 * j + 5] = bfhi(v.z); x[8 * j + 6] = bflo(v.w); x[8 * j + 7] = bfhi(v.w); }
      float sm = 0.f;
#pragma unroll
      for (int j = 0; j < 32; ++j) sm += x[j];
      sm += __shfl_xor(sm, 1); sm += __shfl_xor(sm, 2);
      const float mu = sm * (1.0f / 128.0f); float vs = 0.f;
#pragma unroll
      for (int j = 0; j < 32; ++j) { x[j] -= mu; vs += x[j] * x[j]; }
      vs += __shfl_xor(vs, 1); vs += __shfl_xor(vs, 2);
      const float rstd = rsqrtf(vs * (1.0f / 128.0f) + EPS);
      const float* gp = ng + g * 128 + 32 * qd; const float* bp = nb + g * 128 + 32 * qd;
#pragma unroll
      for (int j = 0; j < 4; ++j) { float y[8];
#pragma unroll
          for (int i = 0; i < 8; ++i) y[i] = x[8 * j + i] * rstd * gp[8 * j + i] + bp[8 * j + i];
          u32x4 w; w.x = cvt_pk_bf16(y[0], y[1]); w.y = cvt_pk_bf16(y[2], y[3]); w.z = cvt_pk_bf16(y[4], y[5]); w.w = cvt_pk_bf16(y[6], y[7]);
          *(LAS u32x4*)(lds + qd * 8192 + s * 64 + j * 16) = w; } }
    __syncthreads();
    { const int tb = wave >> 1, cb0 = 2 * (wave & 1), trow = 32 * tb + r32;
      f32x16 acc0 = {}, acc1 = {};
      const float* wrow = W + ((size_t)g * 128 + trow) * 128 + 8 * hi;
      const int vto = (8 * hi + ((lane & 15) >> 2)) * 64 + (16 * ((lane >> 4) & 1) + 4 * (lane & 3)) * 2;
      for (int ks = 0; ks < 2 * (tb + 1); ++ks) {
          const f32x4 w0 = *(const f32x4*)(wrow + 16 * ks), w1 = *(const f32x4*)(wrow + 16 * ks + 4);
          const int s0 = 16 * ks + 8 * hi; float a[8];
#pragma unroll
          for (int j = 0; j < 4; ++j) { a[j] = (s0 + j <= trow) ? w0[j] : 0.f; a[4 + j] = (s0 + 4 + j <= trow) ? w1[j] : 0.f; }
          u32x4 aw; aw.x = cvt_pk_bf16(a[0], a[1]); aw.y = cvt_pk_bf16(a[2], a[3]); aw.z = cvt_pk_bf16(a[4], a[5]); aw.w = cvt_pk_bf16(a[6], a[7]);
          const bf16x8 af = __builtin_bit_cast(bf16x8, aw);
          const LAS unsigned char* vb = lds + (16 * ks) * 64 + vto;
          { const s16x4 lo = vtr(vb + cb0 * 8192), hh = vtr(vb + cb0 * 8192 + 4 * 64); const bf16x8 bfr = (bf16x8){lo[0], lo[1], lo[2], lo[3], hh[0], hh[1], hh[2], hh[3]};
            acc0 = __builtin_amdgcn_mfma_f32_32x32x16_bf16(af, bfr, acc0, 0, 0, 0); }
          { const s16x4 lo = vtr(vb + (cb0 + 1) * 8192), hh = vtr(vb + (cb0 + 1) * 8192 + 4 * 64); const bf16x8 bfr = (bf16x8){lo[0], lo[1], lo[2], lo[3], hh[0], hh[1], hh[2], hh[3]};
            acc1 = __builtin_amdgcn_mfma_f32_32x32x16_bf16(af, bfr, acc1, 0, 0, 0); }
      }
#pragma unroll
      for (int r = 0; r < 16; ++r) { const int t = 32 * tb + crow(r, hi); const float bias = bs[g * 128 + t];
          const size_t ro = (t0 + t) * 1024 + g * 128 + 32 * cb0 + r32;
          const float u0 = bf2f(UV[ro]), u1 = bf2f(UV[ro + 32]);
          MIX[ro + 512] = f2bf(u0 * (acc0[r] + bias)); MIX[ro + 512 + 32] = f2bf(u1 * (acc1[r] + bias)); } }
    __syncthreads();
}

__device__ __forceinline__ void p_route(Frame& F, unsigned char* ws, const float* X, const u64* ssq, const float* gain, const float* router, unsigned* cnt) {
    F.refresh();
    LAS float* RW = (LAS float*)F.lds;
    LAS int* hist = (LAS int*)(F.lds + 32768);
    LAS int* gbase = (LAS int*)(F.lds + 32768 + 64);
    LAS int* pe = (LAS int*)(F.lds + 32768 + 128);
    LAS float* pwt = (LAS float*)(F.lds + 32768 + 128 + 1024);
    int* TE = (int*)(ws + T_TE); int* TP = (int*)(ws + T_TP); float* TW = (float*)(ws + T_TW);
    for (int idx = F.tid; idx < 8192; idx += 512) { const int k = idx >> 3, e = idx & 7; RW[e * 1024 + k] = router[idx] * gain[k]; }
    for (int blk = F.vcu; blk < NTOK / 64; blk += F.G) {
        if (F.tid < 8) hist[F.tid] = 0;
        __syncthreads();
        for (int r = F.wave; r < 64; r += NWAVES) { const int t = blk * 64 + r; const f32x4* xr = (const f32x4*)(X + (size_t)t * DM) + F.lane;
            float lg[8];
#pragma unroll
            for (int e = 0; e < 8; ++e) lg[e] = 0.f;
#pragma unroll
            for (int j = 0; j < 4; ++j) { const f32x4 v = xr[64 * j];
#pragma unroll
                for (int e = 0; e < 8; ++e) { const f32x4 w = *(const LAS f32x4*)(RW + e * 1024 + 256 * j + 4 * F.lane); lg[e] += (v[0] * w[0] + v[1] * w[1]) + (v[2] * w[2] + v[3] * w[3]); } }
#pragma unroll
            for (int e = 0; e < 8; ++e) lg[e] = wave_sum(lg[e]);
            if (F.lane == 0) { const float rs = rstd_of(ssq, t);
                int e1 = 0; float v1 = lg[0];
#pragma unroll
                for (int e = 1; e < 8; ++e) if (lg[e] > v1) { v1 = lg[e]; e1 = e; }
                int e2 = -1; float v2 = -INFINITY;
#pragma unroll
                for (int e = 0; e < 8; ++e) if (e != e1 && lg[e] > v2) { v2 = lg[e]; e2 = e; }
                const float w1 = 1.0f / (1.0f + __expf((v2 - v1) * rs)), w2 = 1.0f - w1;
                const int p1 = __hip_atomic_fetch_add(&hist[e1], 1, __ATOMIC_RELAXED, __HIP_MEMORY_SCOPE_WORKGROUP), p2 = __hip_atomic_fetch_add(&hist[e2], 1, __ATOMIC_RELAXED, __HIP_MEMORY_SCOPE_WORKGROUP);
                pe[r * 4 + 0] = e1; pe[r * 4 + 1] = e2; pe[r * 4 + 2] = p1; pe[r * 4 + 3] = p2; pwt[r * 2 + 0] = w1; pwt[r * 2 + 1] = w2; } }
        __syncthreads();
        if (F.tid < 8) gbase[F.tid] = (int)__hip_atomic_fetch_add(cnt + F.tid, (unsigned)hist[F.tid], RLX_AGENT);
        __syncthreads();
        if (F.tid < 64) { const int r = F.tid, t = blk * 64 + r; const int e1 = pe[r * 4 + 0], e2 = pe[r * 4 + 1];
            TE[t] = e1 | (e2 << 8); TP[2 * t] = gbase[e1] + pe[r * 4 + 2]; TP[2 * t + 1] = gbase[e2] + pe[r * 4 + 3]; TW[2 * t] = pwt[r * 2 + 0]; TW[2 * t + 1] = pwt[r * 2 + 1]; }
        __syncthreads();
    }
}
__device__ __forceinline__ void moe_offsets(const unsigned* cnt, int (&off)[9], int (&cn)[8]) {
    int a = 0;
#pragma unroll
    for (int e = 0; e < 8; ++e) { cn[e] = (int)__hip_atomic_load(cnt + e, RLX_AGENT); off[e] = a; a += (cn[e] + 255) & ~255; }
    off[8] = a;
}
__device__ __forceinline__ void p_gather(Frame& F, unsigned char* ws, const u64* ssq, const unsigned* cnt) {
    F.refresh();
    int off[9], cn[8]; moe_offsets(cnt, off, cn);
    const bf16_t* XB = (const bf16_t*)(ws + WS_XB); bf16_t* HS = (bf16_t*)(ws + R_HS);
    const int* TE = (const int*)(ws + T_TE); const int* TP = (const int*)(ws + T_TP); const float* TW = (const float*)(ws + T_TW);
    int* PAIR = (int*)(ws + T_PAIR); float* DGATE = (float*)(ws + T_DGATE); float* DRS = (float*)(ws + T_DRS);
    const int gw = F.vcu * NWAVES + F.wave, NGW = F.G * NWAVES;
    for (int t = gw; t < NTOK; t += NGW) { const int te = TE[t]; const float rs = rstd_of(ssq, t);
        const u32x4 a0 = *((const u32x4*)(XB + (size_t)t * DM) + F.lane), a1 = *((const u32x4*)(XB + (size_t)t * DM) + 64 + F.lane);
#pragma unroll
        for (int k = 0; k < 2; ++k) { const int e = (te >> (8 * k)) & 255; int o = 0;
#pragma unroll
            for (int q = 0; q < 8; ++q) o = (q == e) ? off[q] : o;
            const int dest = o + TP[2 * t + k];
            *((u32x4*)(HS + (size_t)dest * DM) + F.lane) = a0; *((u32x4*)(HS + (size_t)dest * DM) + 64 + F.lane) = a1;
            if (F.lane == 0) { PAIR[2 * t + k] = dest; DGATE[dest] = TW[2 * t + k]; DRS[dest] = rs; } } }
#pragma unroll
    for (int e = 0; e < 8; ++e) { const int lo = off[e] + cn[e], hi = off[e + 1];
        for (int r = lo + gw; r < hi; r += NGW) { *((u32x4*)(HS + (size_t)r * DM) + F.lane) = (u32x4){0u, 0u, 0u, 0u}; *((u32x4*)(HS + (size_t)r * DM) + 64 + F.lane) = (u32x4){0u, 0u, 0u, 0u};
            if (F.lane == 0) { DGATE[r] = 0.f; DRS[r] = 0.f; } } }
}
__device__ __forceinline__ void p_combine(Frame& F, unsigned char* ws, float* X, u64* ssq_next, const float* fnorm, bool final_) {
    F.refresh();
    const bf16_t* Y = (const bf16_t*)(ws + R_Y); bf16_t* XB = (bf16_t*)(ws + WS_XB); const int* PAIR = (const int*)(ws + T_PAIR);
    const int gw = F.vcu * NWAVES + F.wave, NGW = F.G * NWAVES;
    for (int t = gw; t < NTOK; t += NGW) { const int p1 = PAIR[2 * t], p2 = PAIR[2 * t + 1];
        f32x4* xr = (f32x4*)(X + (size_t)t * DM) + F.lane; const u32x2* y1 = (const u32x2*)(Y + (size_t)p1 * DM) + F.lane; const u32x2* y2 = (const u32x2*)(Y + (size_t)p2 * DM) + F.lane;
        f32x4 v[4]; float s = 0.f;
#pragma unroll
        for (int j = 0; j < 4; ++j) { const f32x4 x = xr[64 * j]; const u32x2 a = y1[64 * j], bb = y2[64 * j];
            f32x4 o; o[0] = x[0] + bflo(a.x) + bflo(bb.x); o[1] = x[1] + bfhi(a.x) + bfhi(bb.x); o[2] = x[2] + bflo(a.y) + bflo(bb.y); o[3] = x[3] + bfhi(a.y) + bfhi(bb.y);
            v[j] = o; s += (o[0] * o[0] + o[1] * o[1]) + (o[2] * o[2] + o[3] * o[3]); }
        s = wave_sum(s);
        if (!final_) {
#pragma unroll
            for (int j = 0; j < 4; ++j) { xr[64 * j] = v[j]; u32x2 w; w.x = cvt_pk_bf16(v[j][0], v[j][1]); w.y = cvt_pk_bf16(v[j][2], v[j][3]); *((u32x2*)(XB + (size_t)t * DM) + F.lane + 64 * j) = w; }
            if (F.lane == 0) ssq_next[t] = ssq_fix(s);
        } else { const float rs = rsqrtf(s * (1.0f / DM) + EPS);
#pragma unroll
            for (int j = 0; j < 4; ++j) { const f32x4 g = *((const f32x4*)fnorm + F.lane + 64 * j); xr[64 * j] = v[j] * rs * g; } }
    }
}

constexpr int NPH = 31;
struct Args { const float* in[28]; float* out; unsigned char* ws; int ph_lo, ph_hi; };
__global__ void __launch_bounds__(NWAVES * 64, 2) mk_fwd(Args args) {
    extern __shared__ __attribute__((aligned(16))) unsigned char lds_raw[];
    Frame F;
    F.lds = (LAS unsigned char*)lds_raw;
    F.refresh();
    F.G = gridDim.x; { const int bx = blockIdx.x; F.vcu = (F.G % 8 == 0) ? (bx % 8) * (F.G / 8) + bx / 8 : bx; }
    unsigned char* ws = args.ws;
    F.ctl = (unsigned*)(ws + WS_CTL);
    volatile LAS unsigned* MISC = (volatile LAS unsigned*)(F.lds + MISC_OFF);
    for (int u = F.tid; u < (LDS_BYTES - LDSCTL_OFF) / 4; u += NWAVES * 64) ((LAS unsigned*)(F.lds + LDSCTL_OFF))[u] = 0u;
    __syncthreads();
    const int lo = args.ph_lo, hi = args.ph_hi;
    XcdBarrier bar = xcd_barrier_post(F.ctl + CW_BAR + lo * XCD_BAR_WORDS, MISC + 8);
#ifndef PH_MASK
#define PH_MASK 0xFFFF
#endif
#define PT(t) (((PH_MASK) >> (t)) & 1)
#ifndef REP_MASK
#define REP_MASK 0
#endif
#define NREP(t) ((((REP_MASK) >> (t)) & 1) ? 2 : 1)
#define REPEAT(t) for (int rep_ = 0; rep_ < NREP(t); ++rep_, (rep_ < NREP(t) ? xcd_barrier(bar) : (void)0))
#define IN(k) (lo <= (k) && (k) < hi)
#define SEAM(k) do { if ((k) + 1 < hi) xcd_barrier(bar); } while (0)
    const float* const* in = args.in;
    float* X = args.out;
    u64* SSQ = (u64*)(ws + WS_SSQ);
    bf16_t* XB = (bf16_t*)(ws + WS_XB);
    const int bx = (int)blockIdx.x;

    if (PT(0) && IN(0)) { asm volatile("; PHASE_MARK 0"); REPEAT(0) p0_prologue(F, in, ws); SEAM(0); }

    for (int lp = 0; lp < 2; ++lp) {
        const int pb = 1 + 15 * lp;
        bf16_t* WE = (bf16_t*)(ws + WS_WE) + (size_t)lp * E_SIZE; bf16_t* WO = (bf16_t*)(ws + WS_WO) + (size_t)lp * O_SIZE;
        u64* ssq0 = SSQ + (size_t)(4 * lp) * NTOK;
        if (PT(1) && IN(pb + 0)) { asm volatile("; PHASE_MARK 1");
            pg8::DenseOrder S; S.init(XB, DM, WE + E_WIN, DM, NTOK, 1024, F.G, bx);
            pg8::EpiZ E{(bf16_t*)(ws + R_Z), 1024, ssq0};
            pg8::gemm_phase(F.lds, pg8::Gemm{DM, DM, DM}, S, E);
            SEAM(pb + 0);
        }
        if (PT(2) && IN(pb + 1)) { asm volatile("; PHASE_MARK 2"); REPEAT(2) p_even_mid(F, ws); SEAM(pb + 1); }
        if (PT(3) && IN(pb + 2)) { asm volatile("; PHASE_MARK 3");
            { pg8::DenseOrder S; S.init((const bf16_t*)(ws + R_Z) + 512, 1024, WE + E_WQ, 256, NTOK, 768, F.G, bx);
              pg8::EpiQ E{(bf16_t*)(ws + R_Q), (const float*)(ws + T_RQ), (const float*)(ws + T_COS), (const float*)(ws + T_SIN)};
              pg8::gemm_phase(F.lds, pg8::Gemm{1024, 256, 256}, S, E); }
            { pg8::DenseOrder S; S.init((const bf16_t*)(ws + R_Z) + 768, 1024, WE + E_WKV, 256, NTOK, 1024, F.G, bx);
              pg8::EpiKV E{(bf16_t*)(ws + R_K), (bf16_t*)(ws + R_V), (const float*)(ws + T_RKV)};
              pg8::gemm_phase(F.lds, pg8::Gemm{1024, 256, 256}, S, E); }
            SEAM(pb + 2);
        }
        if (PT(4) && IN(pb + 3)) { asm volatile("; PHASE_MARK 4");
            const bf16_t* Q = (const bf16_t*)(ws + R_Q); const bf16_t* Kb = (const bf16_t*)(ws + R_K); const bf16_t* Vb = (const bf16_t*)(ws + R_V); bf16_t* MIX = (bf16_t*)(ws + R_MIX);
            REPEAT(4)
            for (int pi = F.vcu; pi < 256; pi += F.G) { const int bh = pi >> 3, s = pi & 7, b = bh >> 3, h = bh & 7;
#pragma unroll 1
                for (int k = 0; k < 2; ++k) { const int qb = k == 0 ? (15 - s) : s;
                    attn_unit<96, false>(Q + 96 * h, 768, Kb + 96 * h, 768, Vb + 64 * h, 512, MIX + 512 + 64 * h, 1024, b, qb, F.lds, nullptr); } }
            SEAM(pb + 3);
        }
        if (PT(5) && IN(pb + 4)) { asm volatile("; PHASE_MARK 5");
            pg8::DenseOrder S; S.init((const bf16_t*)(ws + R_MIX), 1024, WE + E_WOUT, 1024, NTOK, 1024, F.G, bx);
            pg8::EpiRes E{lp == 0 ? in[0] : X, X, XB, ssq0 + NTOK};
            pg8::gemm_phase(F.lds, pg8::Gemm{1024, 1024, 1024}, S, E);
            SEAM(pb + 4);
        }
        if (PT(6) && IN(pb + 5)) { asm volatile("; PHASE_MARK 6");
            pg8::DenseOrder S; S.init(XB, DM, WE + E_WGU, DM, NTOK, 2 * FF, F.G, bx);
            pg8::EpiSwiGLU<0> E{(bf16_t*)(ws + R_ACT), FF, ssq0 + NTOK};
            REPEAT(6) pg8::gemm_phase(F.lds, pg8::Gemm{DM, DM, DM}, S, E);
            SEAM(pb + 5);
        }
        if (PT(7) && IN(pb + 6)) { asm volatile("; PHASE_MARK 7");
            pg8::DenseOrder S; S.init((const bf16_t*)(ws + R_ACT), FF, WE + E_WDN, FF, NTOK, 1024, F.G, bx);
            pg8::EpiRes E{X, X, XB, ssq0 + 2 * NTOK};
            pg8::gemm_phase(F.lds, pg8::Gemm{FF, FF, FF}, S, E);
            SEAM(pb + 6);
        }
        if (PT(8) && IN(pb + 7)) { asm volatile("; PHASE_MARK 8");
            pg8::DenseOrder S; S.init(XB, DM, WO + O_WIN, DM, NTOK, 2560, F.G, bx);
            pg8::EpiOddIn E{(bf16_t*)(ws + R_QKV), (bf16_t*)(ws + R_UV), ssq0 + 2 * NTOK};
            pg8::gemm_phase(F.lds, pg8::Gemm{DM, DM, DM}, S, E);
            SEAM(pb + 7);
        }
        if (PT(9) && IN(pb + 8)) { asm volatile("; PHASE_MARK 9");
            const bf16_t* QKV = (const bf16_t*)(ws + R_QKV); const bf16_t* UV = (const bf16_t*)(ws + R_UV); bf16_t* MIX = (bf16_t*)(ws + R_MIX);
            const float* rb = in[16] + (size_t)lp * 8 * 257;
            REPEAT(9)
            for (int u = F.vcu; u < 512; u += F.G) { const int bh = u >> 4, qb = u & 15, b = bh >> 3, h = bh & 7;
                attn_unit<64, true>(QKV + 64 * h, 1536, QKV + 512 + 64 * h, 1536, QKV + 1024 + 64 * h, 1536, MIX + 64 * h, 1024, b, qb, F.lds, rb + h * 257); }
            REPEAT(10)
            for (int u = F.vcu; u < 512; u += F.G) { const int g = u & 3, n = (u >> 2) & 31, b = u >> 7;
                sgu_unit(UV, in[17] + (size_t)lp * 512, in[18] + (size_t)lp * 512, in[19] + (size_t)lp * 4 * 128 * 128, in[20] + (size_t)lp * 512, MIX, b, n, g, F.lds); }
            SEAM(pb + 8);
        }
        if (PT(10) && IN(pb + 9)) { asm volatile("; PHASE_MARK 10");
            pg8::DenseOrder S; S.init((const bf16_t*)(ws + R_MIX), 1024, WO + O_WOUT, 1024, NTOK, 1024, F.G, bx);
            pg8::EpiRes E{X, X, XB, ssq0 + 3 * NTOK};
            pg8::gemm_phase(F.lds, pg8::Gemm{1024, 1024, 1024}, S, E);
            SEAM(pb + 9);
        }
        unsigned* cnt = F.ctl + CW_CNT + 64 * lp;
        if (PT(11) && IN(pb + 10)) { asm volatile("; PHASE_MARK 11"); p_route(F, ws, X, ssq0 + 3 * NTOK, in[22] + (size_t)lp * 1024, in[23] + (size_t)lp * 8192, cnt); SEAM(pb + 10); }
        if (PT(12) && IN(pb + 11)) { asm volatile("; PHASE_MARK 12"); REPEAT(12) p_gather(F, ws, ssq0 + 3 * NTOK, cnt); SEAM(pb + 11); }
        if (PT(13) && IN(pb + 12)) { asm volatile("; PHASE_MARK 13");
            int off[9], cn[8]; moe_offsets(cnt, off, cn);
            pg8::MoeOrder S; S.A = (const char*)(ws + R_HS); S.Bt = (const char*)(WO + O_WGU); S.bstride = (size_t)2 * EFF * 1024 * 2; S.lda = 1024; S.ldb = 1024; S.nM = off[8] >> 8; S.nN = 2 * EFF / 256; S.G = F.G; S.c = bx;
#pragma unroll
            for (int e = 0; e < 8; ++e) S.tend[e] = off[e + 1] >> 8;
            pg8::EpiSwiGLU<1> E{(bf16_t*)(ws + R_ACT2), EFF, (const float*)(ws + T_DRS)};
            REPEAT(13) pg8::gemm_phase(F.lds, pg8::Gemm{1024, 1024, 1024}, S, E);
            SEAM(pb + 12);
        }
        if (PT(14) && IN(pb + 13)) { asm volatile("; PHASE_MARK 14");
            int off[9], cn[8]; moe_offsets(cnt, off, cn);
            pg8::MoeOrder S; S.A = (const char*)(ws + R_ACT2); S.Bt = (const char*)(WO + O_WDN); S.bstride = (size_t)1024 * EFF * 2; S.lda = EFF; S.ldb = EFF; S.nM = off[8] >> 8; S.nN = 4; S.G = F.G; S.c = bx;
#pragma unroll
            for (int e = 0; e < 8; ++e) S.tend[e] = off[e + 1] >> 8;
            pg8::EpiY E{(bf16_t*)(ws + R_Y), (const float*)(ws + T_DGATE)};
            REPEAT(14) pg8::gemm_phase(F.lds, pg8::Gemm{EFF, EFF, EFF}, S, E);
            SEAM(pb + 13);
        }
        if (PT(15) && IN(pb + 14)) { asm volatile("; PHASE_MARK 15"); p_combine(F, ws, X, ssq0 + 4 * NTOK, in[27], lp == 1); SEAM(pb + 14); }
    }
#undef IN
#undef SEAM
}

extern "C" void kernel_launch(void* const* d_in, const int* in_sizes, int n_in, void* d_out, int out_size, void* d_ws, size_t ws_size, hipStream_t stream) {
    static int grid = 0;
    if (grid == 0) {
        if (n_in != 28 || in_sizes[0] != NTOK * DM || out_size != NTOK * DM || ws_size < WS_END) { fprintf(stderr, "kernel_launch: unexpected shapes / workspace (%d inputs, ws %zu, need %zu); nothing launched\n", n_in, ws_size, (size_t)WS_END); grid = -1; return; }
        int dev = 0, cus = 0, per_cu = 0;
        if (hipGetDevice(&dev) != hipSuccess || hipDeviceGetAttribute(&cus, hipDeviceAttributeMultiprocessorCount, dev) != hipSuccess) { grid = -1; return; }
        if (hipFuncSetAttribute((const void*)mk_fwd, hipFuncAttributeMaxDynamicSharedMemorySize, LDS_BYTES) != hipSuccess) { fprintf(stderr, "kernel_launch: hipFuncSetAttribute failed\n"); grid = -1; return; }
        if (hipOccupancyMaxActiveBlocksPerMultiprocessor(&per_cu, (const void*)mk_fwd, NWAVES * 64, LDS_BYTES) != hipSuccess || per_cu < 1) fprintf(stderr, "kernel_launch: occupancy query reports %d\n", per_cu);
        (void)hipGetLastError();
        grid = cus;
        if (grid > 256) grid = 256;
        grid &= ~7;
    }
    if (grid <= 0) return;
    if (hipMemsetAsync((char*)d_ws + WS_CTL, 0, CTL_ZERO_BYTES, stream) != hipSuccess) return;
    Args a{};
    for (int i = 0; i < 28; ++i) a.in[i] = (const float*)d_in[i];
    a.out = (float*)d_out; a.ws = (unsigned char*)d_ws;
#if MK_N_LAUNCHES == 1
    a.ph_lo = 0; a.ph_hi = NPH;
    hipLaunchKernelGGL(mk_fwd, dim3(grid), dim3(NWAVES * 64), LDS_BYTES, stream, a);
#else
    for (int p = 0; p < NPH; ++p) { a.ph_lo = p; a.ph_hi = p + 1; hipLaunchKernelGGL(mk_fwd, dim3(grid), dim3(NWAVES * 64), LDS_BYTES, stream, a); }
#endif
}
```

```cpp
#include <hip/hip_runtime.h>
#include <cstdio>
#include <cstdint>

#ifndef MK_N_LAUNCHES
#define MK_N_LAUNCHES 1
#endif

#define LAS __attribute__((address_space(3)))
#define GAS __attribute__((address_space(1)))
typedef unsigned short bf16_t;
typedef short bf16x8 __attribute__((ext_vector_type(8)));
typedef short s16x4 __attribute__((ext_vector_type(4)));
typedef float f32x4 __attribute__((ext_vector_type(4)));
typedef float f32x2 __attribute__((ext_vector_type(2)));
typedef float f32x16 __attribute__((ext_vector_type(16)));
typedef unsigned u32x4 __attribute__((ext_vector_type(4)));
typedef unsigned u32x2 __attribute__((ext_vector_type(2)));

constexpr int NTOK = 16384, DM = 1024, SEQ = 4096;
constexpr float EPS = 1e-6f;
constexpr float LOG2E = 1.4426950408889634f;
constexpr float QS_MLA = 0.10206207261596575f * LOG2E;
constexpr float QS_BAND = 0.125f * LOG2E;
constexpr int FF = 2816, EFF = 3584, NEXP = 8;
constexpr int MOE_ROWS = 34816;

constexpr size_t MiB = 1u << 20, KiB = 1024;
constexpr size_t WS_CTL = 0, CTL_ZERO_BYTES = 3 * MiB;
constexpr int CW_TMO = 0, CW_CNT = 64, CW_BAR = 4096;
constexpr size_t WS_SSQ = 1 * MiB;
constexpr size_t WS_TAB = 3 * MiB;
constexpr size_t T_COS = WS_TAB, T_SIN = WS_TAB + 256 * KiB, T_RQ = WS_TAB + 512 * KiB, T_RKV = WS_TAB + 576 * KiB, T_TE = WS_TAB + 640 * KiB,
                 T_TP = WS_TAB + 704 * KiB, T_TW = WS_TAB + 832 * KiB, T_PAIR = WS_TAB + 960 * KiB, T_DGATE = WS_TAB + 1088 * KiB, T_DRS = WS_TAB + 1280 * KiB;
constexpr size_t WS_W = 5 * MiB;
constexpr size_t E_WIN = 0, E_WQ = 1048576, E_WKV = 1245184, E_WOUT = 1507328, E_WGU = 2555904, E_WDN = 8323072, E_SIZE = 11206656;
constexpr size_t O_WIN = 0, O_WOUT = 2621440, O_WGU = 3670016, O_WDN = 62390272, O_SIZE = 91750400;
constexpr size_t WS_WE = WS_W, WS_WO = WS_W + 2 * E_SIZE * 2;
static_assert(WS_WO + 2 * O_SIZE * 2 <= 400 * MiB, "weights");
constexpr size_t WS_XB = 400 * MiB;
constexpr size_t WS_R = 432 * MiB;
constexpr size_t R_Z = WS_R, R_Q = WS_R + 32 * MiB, R_K = WS_R + 56 * MiB, R_V = WS_R + 80 * MiB, R_MIX = WS_R + 96 * MiB, R_ACT = WS_R;
constexpr size_t R_QKV = WS_R, R_UV = WS_R + 48 * MiB, R_HS = WS_R, R_ACT2 = WS_R + 68 * MiB, R_Y = WS_R, R_Y1 = WS_R + 306 * MiB;
constexpr size_t WS_END = WS_R + 374 * MiB;
static_assert((size_t)MOE_ROWS * EFF * 2 <= 238 * MiB && (size_t)MOE_ROWS * 1024 * 2 <= 68 * MiB, "moe buffers");

constexpr int RING_BYTES = 131072, LDSCTL_OFF = 135168, MISC_OFF = LDSCTL_OFF + 320, LDS_BYTES = 151552;
constexpr int NWAVES = 8;

#define RLX_AGENT __ATOMIC_RELAXED, __HIP_MEMORY_SCOPE_AGENT
#define LDS_WAIT() asm volatile("s_waitcnt lgkmcnt(0)" ::: "memory")
#define VM_WAIT() asm volatile("s_waitcnt vmcnt(0)" ::: "memory")

__device__ __forceinline__ unsigned cvt_pk_bf16(float lo, float hi) { unsigned r; asm volatile("v_cvt_pk_bf16_f32 %0, %1, %2" : "=v"(r) : "v"(lo), "v"(hi)); return r; }
__device__ __forceinline__ float bf2f(unsigned short b) { return __uint_as_float(((unsigned)b) << 16); }
__device__ __forceinline__ float bflo(unsigned w) { return __uint_as_float(w << 16); }
__device__ __forceinline__ float bfhi(unsigned w) { return __uint_as_float(w & 0xffff0000u); }
__device__ __forceinline__ unsigned short f2bf(float f) { return (unsigned short)(cvt_pk_bf16(f, 0.f) & 0xffffu); }
__device__ __forceinline__ float wave_sum(float v) {
#pragma unroll
    for (int o = 1; o < 64; o <<= 1) v += __shfl_xor(v, o);
    return v;
}
typedef unsigned long long u64;
__device__ __forceinline__ u64 ssq_fix(float s) { return (u64)((double)s * 4294967296.0); }
__device__ __forceinline__ float ssq_get(const u64* p, int row) { return (float)((double)p[row] * (1.0 / 4294967296.0)); }
__device__ __forceinline__ float rstd_raw(u64 v) { return rsqrtf((float)((double)v * (1.0 / 4294967296.0)) * (1.0f / DM) + EPS); }
__device__ __forceinline__ float rstd_of(const u64* p, int row) { return rsqrtf(ssq_get(p, row) * (1.0f / DM) + EPS); }
__device__ __forceinline__ float fast_exp2(float x) { return __builtin_amdgcn_exp2f(x); }
__device__ __forceinline__ float fast_rcp(float x) { return __builtin_amdgcn_rcpf(x); }
__device__ __forceinline__ float sigmoidf_(float x) { return fast_rcp(1.0f + fast_exp2(-x * LOG2E)); }

__device__ __forceinline__ int opaque_tid() { int t = threadIdx.x; asm volatile("" : "+v"(t)); return t; }

namespace pg8 {
constexpr int BM = 256, BK = 64, HALF = 128, HTB = HALF * BK * 2, STAGE_BYTES = 8 * HTB, NXCD = 8, WGM = 8;
__host__ __device__ __forceinline__ int lds_byte(int r, int c) { const int st = (r >> 4) * 2 + (c >> 5), rr = r & 15, cc = c & 31, ob = rr * 64 + cc * 2; return st * 1024 + (ob ^ (((ob >> 9) & 1) << 5)); }
__host__ __device__ __forceinline__ void stage_rc(int b, int& R, int& C) { const int st = b / 1024, sb = b % 1024, swz = sb ^ (((sb >> 9) & 1) << 5); R = (st >> 1) * 16 + swz / 64; C = (st & 1) * 32 + (swz % 64) / 2; }
__host__ __device__ __forceinline__ int perm32(int rho) { const int n = rho >> 4, i = rho & 15; return 8 * (i >> 2) + 4 * n + (i & 3); }

struct Unit { int pm, pn, kh; const char* a; const char* b; };
struct Gemm { int lda, ldb, K; };

__device__ __forceinline__ void tile_of(int L, int nM, int nN, int& pm, int& pn) {
    const int nwg = nM * nN;
    int wgid = L; { const int q = nwg / NXCD, r = nwg % NXCD, xcd = wgid % NXCD, off = wgid / NXCD; wgid = (xcd < r ? xcd * (q + 1) : r * (q + 1) + (xcd - r) * q) + off; }
    const int nig = WGM * nN, gid = wgid / nig, fm = gid * WGM, gsz = (nM - fm) < WGM ? (nM - fm) : WGM;
    pm = fm + ((wgid % nig) % gsz); pn = (wgid % nig) / gsz;
}
struct DenseOrder {
    const char* A; const char* Bt; int lda, ldb, nM, nN, G, c;
    __device__ __forceinline__ void init(const void* A_, int lda_, const void* Bt_, int ldb_, int M, int N, int G_, int c_) { A = (const char*)A_; Bt = (const char*)Bt_; lda = lda_; ldb = ldb_; nM = M / BM; nN = N / BM; G = G_; c = c_; }
    __device__ __forceinline__ bool next(int i, Unit& u) const {
        const long L = (long)i * G + c; if (L >= (long)nM * nN) return false;
        tile_of((int)L, nM, nN, u.pm, u.pn); u.kh = 0;
        u.a = A + (size_t)u.pm * BM * lda * 2; u.b = Bt + (size_t)u.pn * BM * ldb * 2; return true;
    }
};
struct MoeOrder {
    const char* A; const char* Bt; size_t bstride; int lda, ldb, nM, nN, G, c, ksplit, khalf; int tend[8];
    __device__ __forceinline__ bool next(int i, Unit& u) const {
        const long L = (long)i * G + c; const int nwg = nM * nN; if (L >= (long)nwg * ksplit) return false;
        const int kh = (int)(L / nwg); tile_of((int)(L - (long)kh * nwg), nM, nN, u.pm, u.pn); u.kh = kh;
        int e = 0;
#pragma unroll
        for (int k = 0; k < 7; ++k) e += (u.pm >= tend[k]) ? 1 : 0;
        u.a = A + (size_t)u.pm * BM * lda * 2 + (size_t)kh * khalf; u.b = Bt + (size_t)e * bstride + (size_t)u.pn * BM * ldb * 2 + (size_t)kh * khalf; return true;
    }
};

template <class Epi, class Sched, bool ALIGN_EPI = true>
__device__ __forceinline__ void gemm_phase(LAS unsigned char* lds, const Gemm g, const Sched& S, const Epi& E) {
    const int tid = opaque_tid(), wid = __builtin_amdgcn_readfirstlane(tid >> 6), lane = tid & 63, wr = wid >> 2, wc = wid & 3, fr = lane & 15, fq = lane >> 4;
    int K = g.K; asm volatile("" : "+s"(K));
    const int nt = K / BK;
    unsigned voffA[2], voffB[2];
#pragma unroll
    for (int i = 0; i < 2; ++i) { int R, C; stage_rc(tid * 16 + i * 8192, R, C); const int Rb = Epi::PERM ? ((R & ~31) + perm32(R & 31)) : R;
        voffA[i] = (unsigned)(R * g.lda + C) * 2u; voffB[i] = (unsigned)(Rb * g.ldb + C) * 2u; }
    const size_t kstep = (size_t)(BK * 2);
    const size_t hstepA = (size_t)HALF * g.lda * 2, hstepB = (size_t)HALF * g.ldb * 2;
    const unsigned ldsw = (unsigned)wid * 1024u;
    const int aoff = lds_byte(wr * 64 + fr, fq * 8), boff = lds_byte(wc * 32 + fr, fq * 8);
#define PG8_SA(b, h) (((b) * 2 + (h)) * HTB)
#define PG8_SB(b, h) ((4 + (b) * 2 + (h)) * HTB)
#define PG8_STAGE(bufoff, gbase, voff) do { _Pragma("unroll") for (int _i = 0; _i < 2; ++_i) \
        __builtin_amdgcn_global_load_lds((const unsigned*)((const char*)(gbase) + (voff)[_i]), (LAS unsigned*)(lds + (bufoff) + ldsw + _i * 8192), 16, 0, 0); } while (0)
#define PG8_LDA(dst, b, h) do { _Pragma("unroll") for (int m = 0; m < 4; ++m) _Pragma("unroll") for (int k = 0; k < 2; ++k) dst[m][k] = *(const LAS bf16x8*)(lds + PG8_SA(b, h) + aoff + m * 2048 + k * 1024); } while (0)
#define PG8_LDB(dst, b, h) do { _Pragma("unroll") for (int n = 0; n < 2; ++n) _Pragma("unroll") for (int k = 0; k < 2; ++k) dst[n][k] = *(const LAS bf16x8*)(lds + PG8_SB(b, h) + boff + n * 2048 + k * 1024); } while (0)
#define PG8_MMA(ai, bj, At, Bt) do { __builtin_amdgcn_s_setprio(1); _Pragma("unroll") for (int m = 0; m < 4; ++m) _Pragma("unroll") for (int n = 0; n < 2; ++n) _Pragma("unroll") for (int k = 0; k < 2; ++k) \
        acc[ai][bj][m][n] = __builtin_amdgcn_mfma_f32_16x16x32_bf16(Bt[n][k], At[m][k], acc[ai][bj][m][n], 0, 0, 0); __builtin_amdgcn_s_setprio(0); } while (0)
#define PG8_WAIT_V(n) asm volatile("s_waitcnt vmcnt(" #n ")" ::: "memory")
#define PG8_WAIT_L(n) asm volatile("s_waitcnt lgkmcnt(" #n ")" ::: "memory")
#define PG8_BAR __builtin_amdgcn_s_barrier()
#define PG8_SCHED __builtin_amdgcn_sched_barrier(0)
    Unit cur, nxt; int ui = 0;
    if (!S.next(0, cur)) return;
    f32x4 acc[2][2][4][2];
#pragma unroll
    for (int a = 0; a < 2; ++a)
#pragma unroll
        for (int b = 0; b < 2; ++b)
#pragma unroll
            for (int m = 0; m < 4; ++m)
#pragma unroll
                for (int n = 0; n < 2; ++n) acc[a][b][m][n] = (f32x4){0.f, 0.f, 0.f, 0.f};
    bf16x8 At[4][2], B0[2][2], B1[2][2];
    const char* cA = cur.a; const char* cB = cur.b;
    PG8_STAGE(PG8_SB(0, 0), cB, voffB); PG8_STAGE(PG8_SB(0, 1), cB + hstepB, voffB); PG8_STAGE(PG8_SA(0, 0), cA, voffA); PG8_STAGE(PG8_SA(0, 1), cA + hstepA, voffA);
    if (wr == 1) PG8_BAR;
    PG8_WAIT_V(2); PG8_BAR;
    PG8_STAGE(PG8_SB(1, 0), cB + kstep, voffB); PG8_STAGE(PG8_SA(1, 0), cA + kstep, voffA); PG8_STAGE(PG8_SB(1, 1), cB + hstepB + kstep, voffB);
    PG8_WAIT_V(6); PG8_BAR;
    for (;;) {
        const bool has_next = S.next(ui + 1, nxt);
        const char* nA = has_next ? nxt.a : cA; const char* nB = has_next ? nxt.b : cB;
        for (int t = 0; t < nt; t += 2) {
            const bool last = (t == nt - 2);
            const char* a1 = cA + (size_t)(t + 1) * kstep;
            const char* a2 = last ? nA : cA + (size_t)(t + 2) * kstep; const char* b2 = last ? nB : cB + (size_t)(t + 2) * kstep;
            const char* a3 = a2 + kstep; const char* b3 = b2 + kstep;
            PG8_LDB(B0, 0, 0); PG8_LDB(B1, 0, 1); PG8_SCHED; PG8_LDA(At, 0, 0); PG8_STAGE(PG8_SA(1, 1), a1 + hstepA, voffA);
            PG8_WAIT_V(8); PG8_WAIT_L(0); PG8_BAR; PG8_MMA(0, 0, At, B0); PG8_MMA(0, 1, At, B1); PG8_BAR; PG8_SCHED;
            PG8_LDA(At, 0, 1); PG8_STAGE(PG8_SB(0, 0), b2, voffB); PG8_STAGE(PG8_SB(0, 1), b2 + hstepB, voffB); PG8_STAGE(PG8_SA(0, 0), a2, voffA);
            PG8_WAIT_V(8); PG8_WAIT_L(0); PG8_BAR; PG8_MMA(1, 0, At, B0); PG8_MMA(1, 1, At, B1); PG8_BAR; PG8_SCHED;
            PG8_LDB(B0, 1, 0); PG8_LDB(B1, 1, 1); PG8_SCHED; PG8_LDA(At, 1, 0); PG8_STAGE(PG8_SA(0, 1), a2 + hstepA, voffA);
            PG8_WAIT_V(8); PG8_WAIT_L(0); PG8_BAR; PG8_MMA(0, 0, At, B0); PG8_MMA(0, 1, At, B1); PG8_BAR; PG8_SCHED;
            PG8_LDA(At, 1, 1); PG8_STAGE(PG8_SB(1, 0), b3, voffB); PG8_STAGE(PG8_SB(1, 1), b3 + hstepB, voffB); PG8_STAGE(PG8_SA(1, 0), a3, voffA);
            PG8_WAIT_V(8); PG8_WAIT_L(0); PG8_BAR; PG8_MMA(1, 0, At, B0); PG8_MMA(1, 1, At, B1); PG8_BAR; PG8_SCHED;
        }
        if constexpr (ALIGN_EPI) { if (wr == 0) PG8_BAR; }
        { int fr_ = fr, fq_ = fq; asm volatile("" : "+v"(fr_), "+v"(fq_)); E(acc, cur, wr, wc, fr_, fq_);
#ifdef EPI_REP
          if constexpr (Epi::PROBE2) { asm volatile("" : "+v"(fr_), "+v"(fq_)); E(acc, cur, wr, wc, fr_, fq_); }
#endif
        }
        if (!has_next) break;
#pragma unroll
        for (int a = 0; a < 2; ++a)
#pragma unroll
            for (int b = 0; b < 2; ++b)
#pragma unroll
                for (int m = 0; m < 4; ++m)
#pragma unroll
                    for (int n = 0; n < 2; ++n) acc[a][b][m][n] = (f32x4){0.f, 0.f, 0.f, 0.f};
        cur = nxt; cA = nA; cB = nB; ++ui;
        if constexpr (ALIGN_EPI) { if (wr == 1) PG8_BAR; }
    }
    PG8_WAIT_V(0);
    if constexpr (!ALIGN_EPI) { if (wr == 0) PG8_BAR; }
    PG8_BAR;
#undef PG8_SA
#undef PG8_SB
#undef PG8_STAGE
#undef PG8_LDA
#undef PG8_LDB
#undef PG8_MMA
#undef PG8_WAIT_V
#undef PG8_WAIT_L
#undef PG8_BAR
#undef PG8_SCHED
}

typedef f32x4 Acc[2][2][4][2];

struct EpiZ { static constexpr bool PERM = true, PROBE2 = false;
    bf16_t* O; int ldc; const u64* ssq;
    __device__ __forceinline__ void operator()(const Acc& acc, const Unit& u, int wr, int wc, int fr, int fq) const {
        const int row0 = u.pm * BM + wr * 64 + fr, col0 = u.pn * BM + wc * 32 + 8 * fq;
        u64 raw[8];
#pragma unroll
        for (int q = 0; q < 8; ++q) raw[q] = ssq[row0 + (q >> 2) * HALF + (q & 3) * 16];
#pragma unroll
        for (int ai = 0; ai < 2; ++ai)
#pragma unroll
            for (int m = 0; m < 4; ++m) { const int row = row0 + ai * HALF + m * 16; const float rs = rstd_raw(raw[ai * 4 + m]);
                bf16_t* rowp = O + (size_t)row * ldc + col0;
#pragma unroll
                for (int bj = 0; bj < 2; ++bj) { const f32x4 v0 = acc[ai][bj][m][0] * rs, v1 = acc[ai][bj][m][1] * rs;
                    u32x4 w; w.x = cvt_pk_bf16(v0[0], v0[1]); w.y = cvt_pk_bf16(v0[2], v0[3]); w.z = cvt_pk_bf16(v1[0], v1[1]); w.w = cvt_pk_bf16(v1[2], v1[3]);
                    *(u32x4*)(rowp + bj * HALF) = w; } }
    }
};
struct EpiQ { static constexpr bool PERM = false, PROBE2 = false;
    bf16_t* O; const float* rq; const float* cosT; const float* sinT;
    __device__ __forceinline__ void operator()(const Acc& acc, const Unit& u, int wr, int wc, int fr, int fq) const {
        const int row0 = u.pm * BM + wr * 64 + fr;
        float rsv[8];
#pragma unroll
        for (int q = 0; q < 8; ++q) rsv[q] = rq[row0 + (q >> 2) * HALF + (q & 3) * 16];
#pragma unroll
        for (int ai = 0; ai < 2; ++ai)
#pragma unroll
            for (int m = 0; m < 4; ++m) { const int row = row0 + ai * HALF + m * 16; const float rs = rsv[ai * 4 + m] * QS_MLA; const int pos = row & (SEQ - 1);
                const f32x4 cs = *(const f32x4*)(cosT + pos * 16 + 4 * fq), sn = *(const f32x4*)(sinT + pos * 16 + 4 * fq);
#pragma unroll
                for (int bj = 0; bj < 2; ++bj) { const int cb = u.pn * BM + bj * HALF + wc * 32; const bool rope = ((cb >> 5) % 3) == 2;
                    f32x4 v0 = acc[ai][bj][m][0] * rs, v1 = acc[ai][bj][m][1] * rs;
                    if (rope) { const f32x4 o0 = v0 * cs - v1 * sn, o1 = v1 * cs + v0 * sn; v0 = o0; v1 = o1; }
                    u32x2 w0, w1; w0.x = cvt_pk_bf16(v0[0], v0[1]); w0.y = cvt_pk_bf16(v0[2], v0[3]); w1.x = cvt_pk_bf16(v1[0], v1[1]); w1.y = cvt_pk_bf16(v1[2], v1[3]);
                    bf16_t* p = O + (size_t)row * 768 + cb + 4 * fq;
                    *(u32x2*)(p) = w0; *(u32x2*)(p + 16) = w1; } }
    }
};
struct EpiKV { static constexpr bool PERM = true, PROBE2 = false;
    bf16_t* Kb; bf16_t* Vb; const float* rkv;
    __device__ __forceinline__ void operator()(const Acc& acc, const Unit& u, int wr, int wc, int fr, int fq) const {
        const int row0 = u.pm * BM + wr * 64 + fr;
        float rsv[8];
#pragma unroll
        for (int q = 0; q < 8; ++q) rsv[q] = rkv[row0 + (q >> 2) * HALF + (q & 3) * 16];
#pragma unroll
        for (int ai = 0; ai < 2; ++ai)
#pragma unroll
            for (int m = 0; m < 4; ++m) { const int row = row0 + ai * HALF + m * 16; const float rs = rsv[ai * 4 + m];
#pragma unroll
                for (int bj = 0; bj < 2; ++bj) { const int h = 2 * u.pn + bj; const f32x4 v0 = acc[ai][bj][m][0] * rs, v1 = acc[ai][bj][m][1] * rs;
                    u32x4 w; w.x = cvt_pk_bf16(v0[0], v0[1]); w.y = cvt_pk_bf16(v0[2], v0[3]); w.z = cvt_pk_bf16(v1[0], v1[1]); w.w = cvt_pk_bf16(v1[2], v1[3]);
                    bf16_t* p = (wc < 2) ? (Kb + (size_t)row * 768 + 96 * h + 32 * wc + 8 * fq) : (Vb + (size_t)row * 512 + 64 * h + 32 * (wc - 2) + 8 * fq);
                    *(u32x4*)p = w; } }
    }
};
struct EpiRes { static constexpr bool PERM = false, PROBE2 = false;
    const float* base; float* X; bf16_t* XB; u64* ssq_next;
    __device__ __forceinline__ void operator()(const Acc& acc, const Unit& u, int wr, int wc, int fr, int fq) const {
        const int row0 = u.pm * BM + wr * 64 + fr, col0 = u.pn * BM + wc * 32 + 4 * fq;
#pragma unroll
        for (int ai = 0; ai < 2; ++ai)
#pragma unroll
            for (int mp = 0; mp < 2; ++mp) {
                f32x4 bs[2][2][2];
#pragma unroll
                for (int mm = 0; mm < 2; ++mm) { const size_t off = (size_t)(row0 + ai * HALF + (2 * mp + mm) * 16) * DM + col0;
#pragma unroll
                    for (int bj = 0; bj < 2; ++bj)
#pragma unroll
                        for (int n = 0; n < 2; ++n) bs[mm][bj][n] = *(const f32x4*)(base + off + bj * HALF + n * 16); }
#pragma unroll
                for (int mm = 0; mm < 2; ++mm) { const int m = 2 * mp + mm; const int row = row0 + ai * HALF + m * 16; const size_t off = (size_t)row * DM + col0; float s = 0.f;
#pragma unroll
                    for (int bj = 0; bj < 2; ++bj)
#pragma unroll
                        for (int n = 0; n < 2; ++n) { const f32x4 o = bs[mm][bj][n] + acc[ai][bj][m][n];
                            *(f32x4*)(X + off + bj * HALF + n * 16) = o; s += (o[0] * o[0] + o[1] * o[1]) + (o[2] * o[2] + o[3] * o[3]);
                            u32x2 w; w.x = cvt_pk_bf16(o[0], o[1]); w.y = cvt_pk_bf16(o[2], o[3]); *(u32x2*)(XB + off + bj * HALF + n * 16) = w; }
                    s += __shfl_xor(s, 16); s += __shfl_xor(s, 32);
                    if (fq == 0) __hip_atomic_fetch_add(ssq_next + row, ssq_fix(s), RLX_AGENT); }
                asm volatile("" ::: "memory"); }
    }
};
template <int MODE> struct EpiSwiGLU { static constexpr bool PERM = true, PROBE2 = true;
    bf16_t* O; int ldc; const void* rsrc;
    __device__ __forceinline__ void operator()(const Acc& acc, const Unit& u, int wr, int wc, int fr, int fq) const {
        const int row0 = u.pm * BM + wr * 64 + fr, col0 = u.pn * HALF + wc * 32 + 8 * fq;
        float rsv[8];
        if (MODE == 0) { u64 raw[8];
#pragma unroll
            for (int q = 0; q < 8; ++q) raw[q] = ((const u64*)rsrc)[row0 + (q >> 2) * HALF + (q & 3) * 16];
#pragma unroll
            for (int q = 0; q < 8; ++q) rsv[q] = rstd_raw(raw[q]);
        } else {
#pragma unroll
            for (int q = 0; q < 8; ++q) rsv[q] = ((const float*)rsrc)[row0 + (q >> 2) * HALF + (q & 3) * 16]; }
#pragma unroll
        for (int ai = 0; ai < 2; ++ai)
#pragma unroll
            for (int m = 0; m < 4; ++m) { const int row = row0 + ai * HALF + m * 16; const float rs = rsv[ai * 4 + m];
                float o[8];
#pragma unroll
                for (int n = 0; n < 2; ++n)
#pragma unroll
                    for (int i = 0; i < 4; ++i) { const float gg = acc[ai][0][m][n][i] * rs, uu = acc[ai][1][m][n][i] * rs; o[n * 4 + i] = gg * sigmoidf_(gg) * uu; }
                u32x4 w; w.x = cvt_pk_bf16(o[0], o[1]); w.y = cvt_pk_bf16(o[2], o[3]); w.z = cvt_pk_bf16(o[4], o[5]); w.w = cvt_pk_bf16(o[6], o[7]);
                *(u32x4*)(O + (size_t)row * ldc + col0) = w; }
    }
};
struct EpiOddIn { static constexpr bool PERM = true, PROBE2 = false;
    bf16_t* QKV; bf16_t* UV; const u64* ssq;
    __device__ __forceinline__ void operator()(const Acc& acc, const Unit& u, int wr, int wc, int fr, int fq) const {
        const int row0 = u.pm * BM + wr * 64 + fr; const bool isuv = u.pn >= 6; const float qsc = u.pn < 2 ? QS_BAND : 1.0f;
        u64 raw[8];
#pragma unroll
        for (int q = 0; q < 8; ++q) raw[q] = ssq[row0 + (q >> 2) * HALF + (q & 3) * 16];
#pragma unroll
        for (int ai = 0; ai < 2; ++ai)
#pragma unroll
            for (int m = 0; m < 4; ++m) { const int row = row0 + ai * HALF + m * 16; const float rs = rstd_raw(raw[ai * 4 + m]);
#pragma unroll
                for (int bj = 0; bj < 2; ++bj) { float o[8];
#pragma unroll
                    for (int n = 0; n < 2; ++n)
#pragma unroll
                        for (int i = 0; i < 4; ++i) { float v = acc[ai][bj][m][n][i] * rs;
                            if (isuv) { const float t = 0.7978845608028654f * (v + 0.044715f * v * v * v); v = v * sigmoidf_(2.0f * t); } else v *= qsc;
                            o[n * 4 + i] = v; }
                    u32x4 w; w.x = cvt_pk_bf16(o[0], o[1]); w.y = cvt_pk_bf16(o[2], o[3]); w.z = cvt_pk_bf16(o[4], o[5]); w.w = cvt_pk_bf16(o[6], o[7]);
                    bf16_t* p = isuv ? (UV + (size_t)row * 1024 + (u.pn - 6) * BM + bj * HALF + wc * 32 + 8 * fq) : (QKV + (size_t)row * 1536 + u.pn * BM + bj * HALF + wc * 32 + 8 * fq);
                    *(u32x4*)p = w; } }
    }
};
struct EpiY { static constexpr bool PERM = true, PROBE2 = false;
    bf16_t* O; const float* gate; size_t ys;
    __device__ __forceinline__ void operator()(const Acc& acc, const Unit& u, int wr, int wc, int fr, int fq) const {
        const int row0 = u.pm * BM + wr * 64 + fr, col0 = u.pn * BM + wc * 32 + 8 * fq;
        float rsv[8];
#pragma unroll
        for (int q = 0; q < 8; ++q) rsv[q] = gate[row0 + (q >> 2) * HALF + (q & 3) * 16];
#pragma unroll
        for (int ai = 0; ai < 2; ++ai)
#pragma unroll
            for (int m = 0; m < 4; ++m) { const int row = row0 + ai * HALF + m * 16; const float rs = rsv[ai * 4 + m];
                bf16_t* rowp = O + (size_t)u.kh * ys + (size_t)row * DM + col0;
#pragma unroll
                for (int bj = 0; bj < 2; ++bj) { const f32x4 v0 = acc[ai][bj][m][0] * rs, v1 = acc[ai][bj][m][1] * rs;
                    u32x4 w; w.x = cvt_pk_bf16(v0[0], v0[1]); w.y = cvt_pk_bf16(v0[2], v0[3]); w.z = cvt_pk_bf16(v1[0], v1[1]); w.w = cvt_pk_bf16(v1[2], v1[3]);
                    *(u32x4*)(rowp + bj * HALF) = w; } }
    }
};
}

#define XB_TMO      128
#define XB_XCNT(j)  (256  + 64 * (j))
#define XB_XSUB(j)  (1280 + 64 * (j))
#define XB_XGEN(j)  (2304 + 64 * (j))
#define XB_TOP      3328
#define XB_TOPGEN   3392
#define XCD_BAR_WORDS 3456
#define XB_SPIN_CAP (1u << 18)
__device__ __forceinline__ unsigned xb_ld(unsigned* p)              { return __hip_atomic_load(p, __ATOMIC_RELAXED, __HIP_MEMORY_SCOPE_AGENT); }
__device__ __forceinline__ unsigned xb_add(unsigned* p, unsigned v) { return __hip_atomic_fetch_add(p, v, __ATOMIC_RELAXED, __HIP_MEMORY_SCOPE_AGENT); }
__device__ __forceinline__ unsigned xb_xcc_id() { return (unsigned)__builtin_amdgcn_s_getreg((3 << 11) | 20) & 0xFu; }
#define XB_SPIN(cond, bar) do { unsigned _sp = 0; while (cond) { __builtin_amdgcn_s_sleep(1); \
    if ((++_sp & 255u) == 0u) { if (xb_ld(&(bar)[XB_TMO])) break; if (_sp > XB_SPIN_CAP) { atomicAdd(&(bar)[XB_TMO], 1u); break; } } } } while (0)
struct XcdBarrier { unsigned* bar; unsigned x; volatile LAS unsigned* st; };
__device__ __forceinline__ XcdBarrier xcd_barrier_post(unsigned* bar, volatile LAS unsigned* st) {
    XcdBarrier b; b.bar = bar; b.x = xb_xcc_id(); b.st = st;
    if (threadIdx.x == 0) (void)xb_add(&bar[XB_XCNT(b.x)], 1u);
    return b;
}
__device__ __forceinline__ void xcd_barrier_complete(unsigned* bar, unsigned x, unsigned& nloc, unsigned& nx) {
    const unsigned G = gridDim.x * gridDim.y * gridDim.z;
    unsigned sum, cnt, mine, sp = 0u;
    for (;;) {
        sum = 0u; cnt = 0u; mine = 0u;
#pragma unroll
        for (unsigned j = 0; j < 16; ++j) { const unsigned c = xb_ld(&bar[XB_XCNT(j)]); sum += c; cnt += (c > 0u) ? 1u : 0u; mine = (j == x) ? c : mine; }
        if (sum == G) break;
        __builtin_amdgcn_s_sleep(1);
        if ((++sp & 255u) == 0u) { if (xb_ld(&bar[XB_TMO])) break; if (sp > XB_SPIN_CAP) { atomicAdd(&bar[XB_TMO], 1u); break; } }
    }
    nloc = mine > 0u ? mine : 1u; nx = cnt > 0u ? cnt : 1u;
}
__device__ __forceinline__ void xcd_barrier(const XcdBarrier& b) {
    asm volatile("s_waitcnt vmcnt(0)" ::: "memory");
    __syncthreads();
    if (threadIdx.x == 0) {
        unsigned* bar = b.bar;
        __builtin_amdgcn_s_waitcnt(0);
        unsigned nloc = b.st[0], nx = b.st[1];
        if (nloc == 0u) { xcd_barrier_complete(bar, b.x, nloc, nx); b.st[0] = nloc; b.st[1] = nx; }
        const unsigned old = xb_add(&bar[XB_XSUB(b.x)], 1u);
        const unsigned gen = old / nloc;
        if (old + 1u == (gen + 1u) * nloc) {
            __builtin_amdgcn_fence(__ATOMIC_RELEASE, "agent");
            asm volatile("s_waitcnt vmcnt(0)" ::: "memory");
            const unsigned og = xb_add(&bar[XB_TOP], 1u);
            const unsigned tg = og / nx;
            if (og + 1u == (tg + 1u) * nx) xb_add(&bar[XB_TOPGEN], 1u);
            else XB_SPIN(xb_ld(&bar[XB_TOPGEN]) == tg, bar);
            __builtin_amdgcn_fence(__ATOMIC_ACQUIRE, "agent");
            xb_add(&bar[XB_XGEN(b.x)], 1u);
            asm volatile("s_waitcnt vmcnt(0)" ::: "memory");
        } else {
            XB_SPIN(xb_ld(&bar[XB_XGEN(b.x)]) == gen, bar);
            __builtin_amdgcn_fence(__ATOMIC_ACQUIRE, "agent");
            asm volatile("s_waitcnt vmcnt(0)" ::: "memory");
        }
    }
    __syncthreads();
}

struct Frame {
    LAS unsigned char* lds;
    unsigned* ctl;
    int tid, lane, wave, vcu, G;
    __device__ __forceinline__ void refresh() { tid = opaque_tid(); lane = tid & 63; wave = __builtin_amdgcn_readfirstlane(tid >> 6); }
};

struct XJob { const float* W; const float* gain; bf16_t* WT; int K, N, ldt, mode, nb; size_t sb, db; int istart; };
__device__ __forceinline__ void xpose_load(const XJob& J, int item, f32x4 (&v)[16], int lane) {
    const int nblk = (J.N + 63) / 64, per = (J.K / 64) * nblk, e = item / per, r = item % per, kb = r / nblk, nbk = r % nblk, k0 = 64 * kb, n0 = 64 * nbk;
    const float* W = J.W + (size_t)e * J.sb;
    const int lr = lane >> 4, lc = 4 * (lane & 15);
    const bool colok = (n0 + lc) < J.N;
#pragma unroll
    for (int i = 0; i < 16; ++i) v[i] = colok ? *(const f32x4*)(W + (size_t)(k0 + 4 * i + lr) * J.N + n0 + lc) : (f32x4){0.f, 0.f, 0.f, 0.f};
}
__device__ __forceinline__ void xpose_store(const XJob& J, int item, const f32x4 (&v)[16], LAS float* scr, int lane) {
    const int nblk = (J.N + 63) / 64, per = (J.K / 64) * nblk, e = item / per, r = item % per, kb = r / nblk, nbk = r % nblk, k0 = 64 * kb, n0 = 64 * nbk;
    bf16_t* WT = J.WT + (size_t)e * J.db;
    const int lr = lane >> 4, lc = 4 * (lane & 15);
#pragma unroll
    for (int i = 0; i < 16; ++i) { const int kk = 4 * i + lr; const float gs = J.gain ? J.gain[k0 + kk] : 1.0f; LAS float* d = scr + kk * 65 + lc;
        d[0] = v[i][0] * gs; d[1] = v[i][1] * gs; d[2] = v[i][2] * gs; d[3] = v[i][3] * gs; }
    LDS_WAIT(); asm volatile("" ::: "memory");
    const int c = lane & 7;
#pragma unroll
    for (int j = 0; j < 8; ++j) { const int n = (lane >> 3) + 8 * j; const LAS float* s = scr + (8 * c) * 65 + n;
        u32x4 o; o.x = cvt_pk_bf16(s[0 * 65], s[1 * 65]); o.y = cvt_pk_bf16(s[2 * 65], s[3 * 65]); o.z = cvt_pk_bf16(s[4 * 65], s[5 * 65]); o.w = cvt_pk_bf16(s[6 * 65], s[7 * 65]);
        const int ng = n0 + n; const int row = J.mode == 0 ? ng : ((ng >> 7) * 256 + (ng & 127) + (J.mode == 2 ? 128 : 0));
        if (ng < J.N) *(u32x4*)(WT + (size_t)row * J.ldt + k0 + 8 * c) = o; }
    LDS_WAIT(); asm volatile("" ::: "memory");
}
constexpr int NJT = 12;
__device__ __forceinline__ void make_job(int i, int t, const float* const* in, unsigned char* ws, XJob& J) {
    J.gain = nullptr; J.mode = 0; J.nb = 1; J.sb = 0; J.db = 0; J.istart = 0;
    bf16_t* WE = (bf16_t*)(ws + WS_WE) + (size_t)i * E_SIZE; bf16_t* WO = (bf16_t*)(ws + WS_WO) + (size_t)i * O_SIZE;
    switch (t) {
    case 0: J.W = in[2] + (size_t)i * 1024 * 928; J.gain = in[1] + i * 1024; J.WT = WE + E_WIN; J.K = 1024; J.N = 928; J.ldt = 1024; break;
    case 1: J.W = in[6] + (size_t)i * 256 * 768; J.gain = in[5] + i * 256; J.WT = WE + E_WQ; J.K = 256; J.N = 768; J.ldt = 256; break;
    case 2: J.W = in[8] + (size_t)i * 128 * 1024; J.gain = in[7] + i * 128; J.WT = WE + E_WKV; J.K = 128; J.N = 1024; J.ldt = 256; break;
    case 3: J.W = in[9] + (size_t)i * 1024 * 1024 + (size_t)512 * 1024; J.WT = WE + E_WOUT + 512; J.K = 512; J.N = 1024; J.ldt = 1024; break;
    case 4: J.W = in[11] + (size_t)i * 1024 * FF; J.gain = in[10] + i * 1024; J.WT = WE + E_WGU; J.K = 1024; J.N = FF; J.ldt = 1024; J.mode = 1; break;
    case 5: J.W = in[12] + (size_t)i * 1024 * FF; J.gain = in[10] + i * 1024; J.WT = WE + E_WGU; J.K = 1024; J.N = FF; J.ldt = 1024; J.mode = 2; break;
    case 6: J.W = in[13] + (size_t)i * FF * 1024; J.WT = WE + E_WDN; J.K = FF; J.N = 1024; J.ldt = FF; break;
    case 7: J.W = in[15] + (size_t)i * 1024 * 2560; J.gain = in[14] + i * 1024; J.WT = WO + O_WIN; J.K = 1024; J.N = 2560; J.ldt = 1024; break;
    case 8: J.W = in[21] + (size_t)i * 1024 * 1024; J.WT = WO + O_WOUT; J.K = 1024; J.N = 1024; J.ldt = 1024; break;
    case 9: J.W = in[24] + (size_t)i * NEXP * 1024 * EFF; J.gain = in[22] + i * 1024; J.WT = WO + O_WGU; J.K = 1024; J.N = EFF; J.ldt = 1024; J.mode = 1; J.nb = NEXP; J.sb = (size_t)1024 * EFF; J.db = (size_t)2 * EFF * 1024; break;
    case 10: J.W = in[25] + (size_t)i * NEXP * 1024 * EFF; J.gain = in[22] + i * 1024; J.WT = WO + O_WGU; J.K = 1024; J.N = EFF; J.ldt = 1024; J.mode = 2; J.nb = NEXP; J.sb = (size_t)1024 * EFF; J.db = (size_t)2 * EFF * 1024; break;
    default: J.W = in[26] + (size_t)i * NEXP * EFF * 1024; J.WT = WO + O_WDN; J.K = EFF; J.N = 1024; J.ldt = EFF; J.nb = NEXP; J.sb = (size_t)EFF * 1024; J.db = (size_t)1024 * EFF; break;
    }
}
__host__ __device__ constexpr int job_items_t(int t) {
    return t == 0 ? 16 * 15 : t == 1 ? 4 * 12 : t == 2 ? 2 * 16 : t == 3 ? 8 * 16 : t == 4 ? 16 * 44 : t == 5 ? 16 * 44 : t == 6 ? 44 * 16 : t == 7 ? 16 * 40 : t == 8 ? 16 * 16 : t == 9 ? 8 * 16 * 56 : t == 10 ? 8 * 16 * 56 : 8 * 56 * 16;
}
__host__ __device__ constexpr int job_start_t(int t) { int a = 0; for (int k = 0; k < t; ++k) a += job_items_t(k); return a; }
constexpr int ITEMS_PER_PAIR = job_start_t(NJT);

__device__ __forceinline__ void p0_prologue(Frame& F, const float* const* in, unsigned char* ws) {
    F.refresh();
    LAS float* scr = (LAS float*)(F.lds + F.wave * 16640);
    const int gw = F.vcu * NWAVES + F.wave, NGW = F.G * NWAVES;
#define XP_DECODE(it_, J_, r_) do { const int i_ = (it_) / ITEMS_PER_PAIR, rr_ = (it_) % ITEMS_PER_PAIR; int t_ = 0; \
        _Pragma("unroll") for (int k = 1; k < NJT; ++k) t_ += (rr_ >= job_start_t(k)) ? 1 : 0; int st_ = 0; \
        _Pragma("unroll") for (int k = 1; k < NJT; ++k) st_ = (t_ == k) ? job_start_t(k) : st_; make_job(i_, t_, in, ws, J_); r_ = rr_ - st_; } while (0)
    { constexpr int NIT = 2 * ITEMS_PER_PAIR; int it = gw; XJob Jc; int rc = 0; f32x4 vc[16];
      if (it < NIT) { XP_DECODE(it, Jc, rc); xpose_load(Jc, rc, vc, F.lane); }
      while (it < NIT) {
          const int itn = it + NGW; XJob Jn = Jc; int rn = 0; f32x4 vn[16];
          if (itn < NIT) { XP_DECODE(itn, Jn, rn); xpose_load(Jn, rn, vn, F.lane); }
          xpose_store(Jc, rc, vc, scr, F.lane);
          it = itn; Jc = Jn; rc = rn;
#pragma unroll
          for (int i = 0; i < 16; ++i) vc[i] = vn[i];
      } }
#undef XP_DECODE
    const int gt = F.vcu * 512 + F.tid, NGT = F.G * 512;
    for (int i = 0; i < 2; ++i) {
        bf16_t* WE = (bf16_t*)(ws + WS_WE) + (size_t)i * E_SIZE;
        for (int x = gt; x < 96 * 1024 / 8; x += NGT) *(u32x4*)(WE + E_WIN + (size_t)928 * 1024 + (size_t)x * 8) = (u32x4){0u, 0u, 0u, 0u};
        for (int x = gt; x < 1024 * 16; x += NGT) { const int r = x >> 4, c = x & 15; *(u32x4*)(WE + E_WKV + (size_t)r * 256 + 128 + c * 8) = (u32x4){0u, 0u, 0u, 0u}; }
        const float* pw = in[3] + (size_t)i * 4 * 128 * 128; const float* ps = in[4] + (size_t)i * 512; const float* wo = in[9] + (size_t)i * 1024 * 1024;
        for (int x = gt; x < 512 * 1024; x += NGT) { const int n = x & 1023, k = x >> 10, g = k >> 7, c = k & 127; float a = 0.f;
            const float* pr = pw + ((size_t)g * 128 + c) * 128; const float* sr = ps + g * 128; const float* wr_ = wo + (size_t)(g * 128) * 1024 + n;
#pragma unroll 8
            for (int d = 0; d < 128; ++d) a += pr[d] * sr[d] * wr_[(size_t)d * 1024];
            WE[E_WOUT + (size_t)n * 1024 + k] = f2bf(a); }
    }
    { float* cosT = (float*)(ws + T_COS); float* sinT = (float*)(ws + T_SIN);
      for (int x = gt; x < SEQ * 16; x += NGT) { const int pos = x >> 4, j = x & 15;
          const float inv = 1.0f / powf(10000.0f, (float)(2 * j) / 32.0f); const float angf = (float)pos * inv;
          double a = (double)angf; const double twopi = 6.283185307179586476925; a -= twopi * rint(a / twopi);
          const double y = a * 0.125, y2 = y * y;
          double s = y * (1.0 + y2 * (-1.0 / 6 + y2 * (1.0 / 120 + y2 * (-1.0 / 5040 + y2 * (1.0 / 362880 + y2 * (-1.0 / 39916800 + y2 * (1.0 / 6227020800.0)))))));
          double c = 1.0 + y2 * (-0.5 + y2 * (1.0 / 24 + y2 * (-1.0 / 720 + y2 * (1.0 / 40320 + y2 * (-1.0 / 3628800 + y2 * (1.0 / 479001600.0 + y2 * (-1.0 / 87178291200.0)))))));
#pragma unroll
          for (int k = 0; k < 3; ++k) { const double s2 = 2.0 * s * c, c2 = c * c - s * s; s = s2; c = c2; }
          cosT[x] = (float)c; sinT[x] = (float)s; } }
    { const float* x = in[0]; bf16_t* XB = (bf16_t*)(ws + WS_XB); u64* ssq = (u64*)(ws + WS_SSQ);
      for (int m = gw; m < NTOK; m += NGW) { const f32x4* xr = (const f32x4*)(x + (size_t)m * DM) + F.lane; float s = 0.f;
#pragma unroll
          for (int j = 0; j < 4; ++j) { const f32x4 v = xr[64 * j]; s += (v[0] * v[0] + v[1] * v[1]) + (v[2] * v[2] + v[3] * v[3]);
              u32x2 w; w.x = cvt_pk_bf16(v[0], v[1]); w.y = cvt_pk_bf16(v[2], v[3]); *((u32x2*)(XB + (size_t)m * DM) + F.lane + 64 * j) = w; }
          s = wave_sum(s); if (F.lane == 0) ssq[m] = ssq_fix(s); } }
}

__device__ __forceinline__ void p_even_mid(Frame& F, unsigned char* ws) {
    F.refresh();
    const bf16_t* Z = (const bf16_t*)(ws + R_Z); bf16_t* MIX = (bf16_t*)(ws + R_MIX); bf16_t* Kb = (bf16_t*)(ws + R_K);
    float* RQ = (float*)(ws + T_RQ); float* RKV = (float*)(ws + T_RKV); const float* cosT = (const float*)(ws + T_COS); const float* sinT = (const float*)(ws + T_SIN);
    const int gw = F.vcu * NWAVES + F.wave, NGW = F.G * NWAVES;
    const int w = 2 << (F.lane >> 4);
    for (int t = gw; t < NTOK; t += NGW) { const int p = t & (SEQ - 1); const int cnt = (p + 1 < w) ? (p + 1) : w; const bf16_t* zr = Z + (size_t)t * 1024;
        u32x4 v[16];
#pragma unroll
        for (int j = 0; j < 16; ++j) v[j] = (j < cnt) ? *((const u32x4*)(zr - (size_t)j * 1024) + F.lane) : (u32x4){0u, 0u, 0u, 0u};
        const u32x2 q = *((const u32x2*)(zr + 512) + F.lane); const unsigned kv = *((const unsigned*)(zr + 768) + F.lane);
        float s[8];
#pragma unroll
        for (int i = 0; i < 8; ++i) s[i] = 0.f;
#pragma unroll
        for (int j = 0; j < 16; ++j) { s[0] += bflo(v[j].x); s[1] += bfhi(v[j].x); s[2] += bflo(v[j].y); s[3] += bfhi(v[j].y); s[4] += bflo(v[j].z); s[5] += bfhi(v[j].z); s[6] += bflo(v[j].w); s[7] += bfhi(v[j].w); }
        const float ic = 1.0f / (float)cnt;
        u32x4 o; o.x = cvt_pk_bf16(s[0] * ic - bflo(v[0].x), s[1] * ic - bfhi(v[0].x)); o.y = cvt_pk_bf16(s[2] * ic - bflo(v[0].y), s[3] * ic - bfhi(v[0].y));
        o.z = cvt_pk_bf16(s[4] * ic - bflo(v[0].z), s[5] * ic - bfhi(v[0].z)); o.w = cvt_pk_bf16(s[6] * ic - bflo(v[0].w), s[7] * ic - bfhi(v[0].w));
        *((u32x4*)(MIX + (size_t)t * 1024) + F.lane) = o;
        float sq = bflo(q.x) * bflo(q.x) + bfhi(q.x) * bfhi(q.x) + bflo(q.y) * bflo(q.y) + bfhi(q.y) * bfhi(q.y);
        float sk = bflo(kv) * bflo(kv) + bfhi(kv) * bfhi(kv);
        sq = wave_sum(sq); sk = wave_sum(sk);
        if (F.lane == 0) { RQ[t] = rsqrtf(sq * (1.0f / 256.0f) + EPS); RKV[t] = rsqrtf(sk * (1.0f / 128.0f) + EPS); }
        if (F.lane < 16) { const int j = F.lane; const float x1 = bf2f(zr[896 + j]), x2 = bf2f(zr[912 + j]); const float c = cosT[p * 16 + j], sn = sinT[p * 16 + j];
            const bf16_t o1 = f2bf(x1 * c - x2 * sn), o2 = f2bf(x2 * c + x1 * sn); bf16_t* kr = Kb + (size_t)t * 768;
#pragma unroll
            for (int h = 0; h < 8; ++h) { kr[96 * h + 64 + j] = o1; kr[96 * h + 80 + j] = o2; } } }
}

__device__ __forceinline__ int crow(int r, int hi) { return (r & 3) + 8 * (r >> 2) + 4 * hi; }
__device__ __forceinline__ s16x4 vtr(const LAS unsigned char* p) { return __builtin_bit_cast(s16x4, __builtin_amdgcn_ds_read_tr16_b64_v4i16((LAS s16x4*)p)); }

template <int DQK, bool BAND>
__device__ __forceinline__ void attn_unit(const bf16_t* __restrict__ Qp, int ldq, const bf16_t* __restrict__ Kp, int ldk, const bf16_t* __restrict__ Vp, int ldv,
                                          bf16_t* Op, int ldo, int b, int qb, LAS unsigned char* lds, const float* bias_g) {
    constexpr int KSTR = (DQK + 8) * 2, KBUF = 64 * KSTR, VBUF = 8192, KCH = DQK / 8, NKS = DQK / 16;
    const int tid = opaque_tid(), lane = tid & 63, wave = __builtin_amdgcn_readfirstlane(tid >> 6), r32 = lane & 31, hi = lane >> 5;
    LAS unsigned char* Kl = lds; LAS unsigned char* Vl = lds + 2 * KBUF;
    LAS float* sc = (LAS float*)(lds + 2 * KBUF + 2 * VBUF) + wave * 32;
    LAS float* biasL = (LAS float*)(lds + 2 * KBUF + 2 * VBUF + 1024);
    const int chunkw = 4 * qb + (wave >> 1), t1 = 4 * qb + 3, t0 = BAND ? ((4 * qb - 8) > 0 ? (4 * qb - 8) : 0) : 0;
    const size_t rowb = (size_t)b * SEQ;
    if (BAND) { if (tid < 257) biasL[tid] = bias_g[tid] * LOG2E; }
    bf16x8 qf[NKS];
    { const bf16_t* qrow = Qp + (rowb + 256 * qb + 32 * wave + r32) * ldq + 8 * hi;
#pragma unroll
      for (int ks = 0; ks < NKS; ++ks) qf[ks] = *(const bf16x8*)(qrow + 16 * ks); }
    const int kkey0 = tid / KCH, kch0 = tid % KCH; const int idx1 = tid + 512; const bool has1 = idx1 < 64 * KCH; const int kkey1 = has1 ? idx1 / KCH : 0, kch1 = has1 ? idx1 % KCH : 0;
    const int vkey = tid >> 3, vch = tid & 7;
    const bf16_t* kg0 = Kp + (rowb + kkey0) * ldk + 8 * kch0; const bf16_t* kg1 = Kp + (rowb + kkey1) * ldk + 8 * kch1; const bf16_t* vg = Vp + (rowb + vkey) * ldv + 8 * vch;
    const int kl0 = kkey0 * KSTR + kch0 * 16, kl1 = kkey1 * KSTR + kch1 * 16, vl = (vch >> 2) * 4096 + vkey * 64 + (vch & 3) * 16;
    u32x4 kr0, kr1 = (u32x4){0u, 0u, 0u, 0u}, vr;
    { const size_t to = (size_t)t0 * 64; kr0 = *(const u32x4*)(kg0 + to * ldk); if (has1) kr1 = *(const u32x4*)(kg1 + to * ldk); vr = *(const u32x4*)(vg + to * ldv);
      *(LAS u32x4*)(Kl + kl0) = kr0; if (has1) *(LAS u32x4*)(Kl + kl1) = kr1; *(LAS u32x4*)(Vl + vl) = vr; }
    __syncthreads();
    float m_run = -INFINITY, l_run = 0.f; f32x16 o0 = {}, o1 = {};
    const int vtoff = (16 * ((lane >> 4) & 1) + 4 * (lane & 3)) * 2 + (4 * hi + ((lane & 15) >> 2)) * 64;
    for (int t = t0; t <= t1; ++t) {
        const int cur = (t - t0) & 1; const bool more = t < t1;
        if (more) { const size_t to = (size_t)(t + 1) * 64; kr0 = *(const u32x4*)(kg0 + to * ldk); if (has1) kr1 = *(const u32x4*)(kg1 + to * ldk); vr = *(const u32x4*)(vg + to * ldv); }
        const bool active = BAND ? (t <= chunkw && t >= chunkw - 8) : (t <= chunkw);
        if (active) {
            const LAS unsigned char* Ks = Kl + cur * KBUF; const LAS unsigned char* Vs = Vl + cur * VBUF;
            f32x16 s0 = {}, s1 = {};
#pragma unroll
            for (int ks = 0; ks < NKS; ++ks) {
                const bf16x8 k0 = *(const LAS bf16x8*)(Ks + r32 * KSTR + ks * 32 + hi * 16);
                const bf16x8 k1 = *(const LAS bf16x8*)(Ks + (32 + r32) * KSTR + ks * 32 + hi * 16);
                s0 = __builtin_amdgcn_mfma_f32_32x32x16_bf16(k0, qf[ks], s0, 0, 0, 0);
                s1 = __builtin_amdgcn_mfma_f32_32x32x16_bf16(k1, qf[ks], s1, 0, 0, 0);
            }
            if (BAND) {
                if (t <= chunkw - 3) { const float cb = biasL[256];
#pragma unroll
                    for (int r = 0; r < 16; ++r) { s0[r] += cb; s1[r] += cb; } }
                else { const int qpos = 256 * qb + 32 * wave + r32, kb0 = 64 * t;
#pragma unroll
                    for (int r = 0; r < 16; ++r) { const int rel = qpos - (kb0 + crow(r, hi)); int i0 = rel < -128 ? -128 : (rel > 128 ? 128 : rel); int rel1 = rel - 32; int i1 = rel1 < -128 ? -128 : (rel1 > 128 ? 128 : rel1);
                        s0[r] += biasL[i0 + 128]; s1[r] += biasL[i1 + 128]; } }
            }
            float mx = s0[0];
#pragma unroll
            for (int r = 1; r < 16; ++r) mx = fmaxf(mx, s0[r]);
#pragma unroll
            for (int r = 0; r < 16; ++r) mx = fmaxf(mx, s1[r]);
            mx = fmaxf(mx, __shfl_xor(mx, 32));
            const float m_new = fmaxf(m_run, mx), alpha = fast_exp2(m_run - m_new); m_run = m_new;
            float ps = 0.f;
#pragma unroll
            for (int r = 0; r < 16; ++r) { s0[r] = fast_exp2(s0[r] - m_new); s1[r] = fast_exp2(s1[r] - m_new); ps += s0[r] + s1[r]; }
            l_run = l_run * alpha + ps;
            if (hi == 0) sc[r32] = alpha;
            LDS_WAIT();
#pragma unroll
            for (int r = 0; r < 16; ++r) { const float a = sc[crow(r, hi)]; o0[r] *= a; o1[r] *= a; }
            LDS_WAIT();
#pragma unroll
            for (int hf = 0; hf < 2; ++hf)
#pragma unroll
                for (int s2 = 0; s2 < 2; ++s2) {
                    u32x4 pw;
                    if (hf == 0) { pw.x = cvt_pk_bf16(s0[8 * s2 + 0], s0[8 * s2 + 1]); pw.y = cvt_pk_bf16(s0[8 * s2 + 2], s0[8 * s2 + 3]); pw.z = cvt_pk_bf16(s0[8 * s2 + 4], s0[8 * s2 + 5]); pw.w = cvt_pk_bf16(s0[8 * s2 + 6], s0[8 * s2 + 7]); }
                    else         { pw.x = cvt_pk_bf16(s1[8 * s2 + 0], s1[8 * s2 + 1]); pw.y = cvt_pk_bf16(s1[8 * s2 + 2], s1[8 * s2 + 3]); pw.z = cvt_pk_bf16(s1[8 * s2 + 4], s1[8 * s2 + 5]); pw.w = cvt_pk_bf16(s1[8 * s2 + 6], s1[8 * s2 + 7]); }
                    const bf16x8 pa = __builtin_bit_cast(bf16x8, pw);
                    const LAS unsigned char* vb = Vs + (32 * hf + 16 * s2) * 64 + vtoff;
#pragma unroll
                    for (int dh = 0; dh < 2; ++dh) {
                        const s16x4 lo = vtr(vb + dh * 4096), hh = vtr(vb + dh * 4096 + 8 * 64);
                        const bf16x8 vf = (bf16x8){lo[0], lo[1], lo[2], lo[3], hh[0], hh[1], hh[2], hh[3]};
                        if (dh == 0) o0 = __builtin_amdgcn_mfma_f32_32x32x16_bf16(pa, vf, o0, 0, 0, 0);
                        else         o1 = __builtin_amdgcn_mfma_f32_32x32x16_bf16(pa, vf, o1, 0, 0, 0);
                    }
                }
        }
        if (more) { const int nx = cur ^ 1; *(LAS u32x4*)(Kl + nx * KBUF + kl0) = kr0; if (has1) *(LAS u32x4*)(Kl + nx * KBUF + kl1) = kr1; *(LAS u32x4*)(Vl + nx * VBUF + vl) = vr; }
        __syncthreads();
    }
    { const float lt = l_run + __shfl_xor(l_run, 32);
      if (hi == 0) sc[r32] = fast_rcp(lt);
      LDS_WAIT();
      bf16_t* orow = Op + (rowb + 256 * qb + 32 * wave) * ldo + r32;
#pragma unroll
      for (int r = 0; r < 16; ++r) { const int q = crow(r, hi); const float inv = sc[q];
          orow[(size_t)q * ldo] = f2bf(o0[r] * inv); orow[(size_t)q * ldo + 32] = f2bf(o1[r] * inv); }
      LDS_WAIT(); }
}

__device__ __forceinline__ void sgu_unit(const bf16_t* UV, const float* ng, const float* nb, const float* W, const float* bs, bf16_t* MIX, int b, int n, int g, LAS unsigned char* lds) {
    const int tid = opaque_tid(), lane = tid & 63, wave = __builtin_amdgcn_readfirstlane(tid >> 6), r32 = lane & 31, hi = lane >> 5;
    const size_t t0 = (size_t)b * SEQ + (size_t)n * 128;
    { const int s = tid >> 2, qd = tid & 3; const bf16_t* src = UV + (t0 + s) * 1024 + 512 + g * 128 + 32 * qd;
      float x[32];
#pragma unroll
      for (int j = 0; j < 4; ++j) { const u32x4 v = *((const u32x4*)src + j); x[8 * j + 0] = bflo(v.x); x[8 * j + 1] = bfhi(v.x); x[8 * j + 2] = bflo(v.y); x[8 * j + 3] = bfhi(v.y); x[8 * j + 4] = bflo(v.z); x[8 * j + 5] = bfhi(v.z); x[8 * j + 6] = bflo(v.w); x[8 * j + 7] = bfhi(v.w); }
      float sm = 0.f;
#pragma unroll
      for (int j = 0; j < 32; ++j) sm += x[j];
      sm += __shfl_xor(sm, 1); sm += __shfl_xor(sm, 2);
      const float mu = sm * (1.0f / 128.0f); float vs = 0.f;
#pragma unroll
      for (int j = 0; j < 32; ++j) { x[j] -= mu; vs += x[j] * x[j]; }
      vs += __shfl_xor(vs, 1); vs += __shfl_xor(vs, 2);
      const float rstd = rsqrtf(vs * (1.0f / 128.0f) + EPS);
      const float* gp = ng + g * 128 + 32 * qd; const float* bp = nb + g * 128 + 32 * qd;
#pragma unroll
      for (int j = 0; j < 4; ++j) { float y[8];
#pragma unroll
          for (int i = 0; i < 8; ++i) y[i] = x[8 * j + i] * rstd * gp[8 * j + i] + bp[8 * j + i];
          u32x4 w; w.x = cvt_pk_bf16(y[0], y[1]); w.y = cvt_pk_bf16(y[2], y[3]); w.z = cvt_pk_bf16(y[4], y[5]); w.w = cvt_pk_bf16(y[6], y[7]);
          *(LAS u32x4*)(lds + qd * 8192 + s * 64 + j * 16) = w; } }
    __syncthreads();
    { const int tb = wave >> 1, cb0 = 2 * (wave & 1), trow = 32 * tb + r32;
      f32x16 acc0 = {}, acc1 = {};
      const float* wrow = W + ((size_t)g * 128 + trow) * 128 + 8 * hi;
      const int vto = (8 * hi + ((lane & 15) >> 2)) * 64 + (16 * ((lane >> 4) & 1) + 4 * (lane & 3)) * 2;
      for (int ks = 0; ks < 2 * (tb + 1); ++ks) {
          const f32x4 w0 = *(const f32x4*)(wrow + 16 * ks), w1 = *(const f32x4*)(wrow + 16 * ks + 4);
          const int s0 = 16 * ks + 8 * hi; float a[8];
#pragma unroll
          for (int j = 0; j < 4; ++j) { a[j] = (s0 + j <= trow) ? w0[j] : 0.f; a[4 + j] = (s0 + 4 + j <= trow) ? w1[j] : 0.f; }
          u32x4 aw; aw.x = cvt_pk_bf16(a[0], a[1]); aw.y = cvt_pk_bf16(a[2], a[3]); aw.z = cvt_pk_bf16(a[4], a[5]); aw.w = cvt_pk_bf16(a[6], a[7]);
          const bf16x8 af = __builtin_bit_cast(bf16x8, aw);
          const LAS unsigned char* vb = lds + (16 * ks) * 64 + vto;
          { const s16x4 lo = vtr(vb + cb0 * 8192), hh = vtr(vb + cb0 * 8192 + 4 * 64); const bf16x8 bfr = (bf16x8){lo[0], lo[1], lo[2], lo[3], hh[0], hh[1], hh[2], hh[3]};
            acc0 = __builtin_amdgcn_mfma_f32_32x32x16_bf16(af, bfr, acc0, 0, 0, 0); }
          { const s16x4 lo = vtr(vb + (cb0 + 1) * 8192), hh = vtr(vb + (cb0 + 1) * 8192 + 4 * 64); const bf16x8 bfr = (bf16x8){lo[0], lo[1], lo[2], lo[3], hh[0], hh[1], hh[2], hh[3]};
            acc1 = __builtin_amdgcn_mfma_f32_32x32x16_bf16(af, bfr, acc1, 0, 0, 0); }
      }
#pragma unroll
      for (int r = 0; r < 16; ++r) { const int t = 32 * tb + crow(r, hi); const float bias = bs[g * 128 + t];
          const size_t ro = (t0 + t) * 1024 + g * 128 + 32 * cb0 + r32;
          const float u0 = bf2f(UV[ro]), u1 = bf2f(UV[ro + 32]);
          MIX[ro + 512] = f2bf(u0 * (acc0[r] + bias)); MIX[ro + 512 + 32] = f2bf(u1 * (acc1[r] + bias)); } }
    __syncthreads();
}

__device__ __forceinline__ void p_route(Frame& F, unsigned char* ws, const float* X, const u64* ssq, const float* gain, const float* router, unsigned* cnt) {
    F.refresh();
    LAS float* RW = (LAS float*)F.lds;
    LAS int* hist = (LAS int*)(F.lds + 32768);
    LAS int* gbase = (LAS int*)(F.lds + 32768 + 64);
    LAS int* pe = (LAS int*)(F.lds + 32768 + 128);
    LAS float* pwt = (LAS float*)(F.lds + 32768 + 128 + 1024);
    int* TE = (int*)(ws + T_TE); int* TP = (int*)(ws + T_TP); float* TW = (float*)(ws + T_TW);
    for (int idx = F.tid; idx < 8192; idx += 512) { const int k = idx >> 3, e = idx & 7; RW[e * 1024 + k] = router[idx] * gain[k]; }
    for (int blk = F.vcu; blk < NTOK / 64; blk += F.G) {
        if (F.tid < 8) hist[F.tid] = 0;
        __syncthreads();
        for (int r = F.wave; r < 64; r += NWAVES) { const int t = blk * 64 + r; const f32x4* xr = (const f32x4*)(X + (size_t)t * DM) + F.lane;
            float lg[8];
#pragma unroll
            for (int e = 0; e < 8; ++e) lg[e] = 0.f;
#pragma unroll
            for (int j = 0; j < 4; ++j) { const f32x4 v = xr[64 * j];
#pragma unroll
                for (int e = 0; e < 8; ++e) { const f32x4 w = *(const LAS f32x4*)(RW + e * 1024 + 256 * j + 4 * F.lane); lg[e] += (v[0] * w[0] + v[1] * w[1]) + (v[2] * w[2] + v[3] * w[3]); } }
#pragma unroll
            for (int e = 0; e < 8; ++e) lg[e] = wave_sum(lg[e]);
            if (F.lane == 0) { const float rs = rstd_of(ssq, t);
                int e1 = 0; float v1 = lg[0];
#pragma unroll
                for (int e = 1; e < 8; ++e) if (lg[e] > v1) { v1 = lg[e]; e1 = e; }
                int e2 = -1; float v2 = -INFINITY;
#pragma unroll
                for (int e = 0; e < 8; ++e) if (e != e1 && lg[e] > v2) { v2 = lg[e]; e2 = e; }
                const float w1 = 1.0f / (1.0f + __expf((v2 - v1) * rs)), w2 = 1.0f - w1;
                const int p1 = __hip_atomic_fetch_add(&hist[e1], 1, __ATOMIC_RELAXED, __HIP_MEMORY_SCOPE_WORKGROUP), p2 = __hip_atomic_fetch_add(&hist[e2], 1, __ATOMIC_RELAXED, __HIP_MEMORY_SCOPE_WORKGROUP);
                pe[r * 4 + 0] = e1; pe[r * 4 + 1] = e2; pe[r * 4 + 2] = p1; pe[r * 4 + 3] = p2; pwt[r * 2 + 0] = w1; pwt[r * 2 + 1] = w2; } }
        __syncthreads();
        if (F.tid < 8) gbase[F.tid] = (int)__hip_atomic_fetch_add(cnt + F.tid, (unsigned)hist[F.tid], RLX_AGENT);
        __syncthreads();
        if (F.tid < 64) { const int r = F.tid, t = blk * 64 + r; const int e1 = pe[r * 4 + 0], e2 = pe[r * 4 + 1];
            TE[t] = e1 | (e2 << 8); TP[2 * t] = gbase[e1] + pe[r * 4 + 2]; TP[2 * t + 1] = gbase[e2] + pe[r * 4 + 3]; TW[2 * t] = pwt[r * 2 + 0]; TW[2 * t + 1] = pwt[r * 2 + 1]; }
        __syncthreads();
    }
}
__device__ __forceinline__ void moe_offsets(const unsigned* cnt, int (&off)[9], int (&cn)[8]) {
    int a = 0;
#pragma unroll
    for (int e = 0; e < 8; ++e) { cn[e] = (int)__hip_atomic_load(cnt + e, RLX_AGENT); off[e] = a; a += (cn[e] + 255) & ~255; }
    off[8] = a;
}
__device__ __forceinline__ void p_gather(Frame& F, unsigned char* ws, const u64* ssq, const unsigned* cnt) {
    F.refresh();
    int off[9], cn[8]; moe_offsets(cnt, off, cn);
    const bf16_t* XB = (const bf16_t*)(ws + WS_XB); bf16_t* HS = (bf16_t*)(ws + R_HS);
    const int* TE = (const int*)(ws + T_TE); const int* TP = (const int*)(ws + T_TP); const float* TW = (const float*)(ws + T_TW);
    int* PAIR = (int*)(ws + T_PAIR); float* DGATE = (float*)(ws + T_DGATE); float* DRS = (float*)(ws + T_DRS);
    const int gw = F.vcu * NWAVES + F.wave, NGW = F.G * NWAVES;
    for (int t = gw; t < NTOK; t += NGW) { const int te = TE[t]; const float rs = rstd_of(ssq, t);
        const u32x4 a0 = *((const u32x4*)(XB + (size_t)t * DM) + F.lane), a1 = *((const u32x4*)(XB + (size_t)t * DM) + 64 + F.lane);
#pragma unroll
        for (int k = 0; k < 2; ++k) { const int e = (te >> (8 * k)) & 255; int o = 0;
#pragma unroll
            for (int q = 0; q < 8; ++q) o = (q == e) ? off[q] : o;
            const int dest = o + TP[2 * t + k];
            *((u32x4*)(HS + (size_t)dest * DM) + F.lane) = a0; *((u32x4*)(HS + (size_t)dest * DM) + 64 + F.lane) = a1;
            if (F.lane == 0) { PAIR[2 * t + k] = dest; DGATE[dest] = TW[2 * t + k]; DRS[dest] = rs; } } }
#pragma unroll
    for (int e = 0; e < 8; ++e) { const int lo = off[e] + cn[e], hi = off[e + 1];
        for (int r = lo + gw; r < hi; r += NGW) { *((u32x4*)(HS + (size_t)r * DM) + F.lane) = (u32x4){0u, 0u, 0u, 0u}; *((u32x4*)(HS + (size_t)r * DM) + 64 + F.lane) = (u32x4){0u, 0u, 0u, 0u};
            if (F.lane == 0) { DGATE[r] = 0.f; DRS[r] = 0.f; } } }
}
__device__ __forceinline__ void p_combine(Frame& F, unsigned char* ws, float* X, u64* ssq_next, const float* fnorm, bool final_) {
    F.refresh();
    const bf16_t* Y = (const bf16_t*)(ws + R_Y); const bf16_t* Yb = (const bf16_t*)(ws + R_Y1); bf16_t* XB = (bf16_t*)(ws + WS_XB); const int* PAIR = (const int*)(ws + T_PAIR);
    const int gw = F.vcu * NWAVES + F.wave, NGW = F.G * NWAVES;
    for (int t = gw; t < NTOK; t += NGW) { const int p1 = PAIR[2 * t], p2 = PAIR[2 * t + 1];
        f32x4* xr = (f32x4*)(X + (size_t)t * DM) + F.lane; const u32x2* y1 = (const u32x2*)(Y + (size_t)p1 * DM) + F.lane; const u32x2* y2 = (const u32x2*)(Y + (size_t)p2 * DM) + F.lane;
        const u32x2* y3 = (const u32x2*)(Yb + (size_t)p1 * DM) + F.lane; const u32x2* y4 = (const u32x2*)(Yb + (size_t)p2 * DM) + F.lane;
        f32x4 v[4]; float s = 0.f;
#pragma unroll
        for (int j = 0; j < 4; ++j) { const f32x4 x = xr[64 * j]; const u32x2 a = y1[64 * j], bb = y2[64 * j], cc = y3[64 * j], dd = y4[64 * j];
            f32x4 o; o[0] = x[0] + ((bflo(a.x) + bflo(cc.x)) + (bflo(bb.x) + bflo(dd.x))); o[1] = x[1] + ((bfhi(a.x) + bfhi(cc.x)) + (bfhi(bb.x) + bfhi(dd.x)));
            o[2] = x[2] + ((bflo(a.y) + bflo(cc.y)) + (bflo(bb.y) + bflo(dd.y))); o[3] = x[3] + ((bfhi(a.y) + bfhi(cc.y)) + (bfhi(bb.y) + bfhi(dd.y)));
            v[j] = o; s += (o[0] * o[0] + o[1] * o[1]) + (o[2] * o[2] + o[3] * o[3]); }
        s = wave_sum(s);
        if (!final_) {
#pragma unroll
            for (int j = 0; j < 4; ++j) { xr[64 * j] = v[j]; u32x2 w; w.x = cvt_pk_bf16(v[j][0], v[j][1]); w.y = cvt_pk_bf16(v[j][2], v[j][3]); *((u32x2*)(XB + (size_t)t * DM) + F.lane + 64 * j) = w; }
            if (F.lane == 0) ssq_next[t] = ssq_fix(s);
        } else { const float rs = rsqrtf(s * (1.0f / DM) + EPS);
#pragma unroll
            for (int j = 0; j < 4; ++j) { const f32x4 g = *((const f32x4*)fnorm + F.lane + 64 * j); xr[64 * j] = v[j] * rs * g; } }
    }
}

constexpr int NPH = 31;
struct Args { const float* in[28]; float* out; unsigned char* ws; int ph_lo, ph_hi; };
__global__ void __launch_bounds__(NWAVES * 64, 2) mk_fwd(Args args) {
    extern __shared__ __attribute__((aligned(16))) unsigned char lds_raw[];
    Frame F;
    F.lds = (LAS unsigned char*)lds_raw;
    F.refresh();
    F.G = gridDim.x; { const int bx = blockIdx.x; F.vcu = (F.G % 8 == 0) ? (bx % 8) * (F.G / 8) + bx / 8 : bx; }
    unsigned char* ws = args.ws;
    F.ctl = (unsigned*)(ws + WS_CTL);
    volatile LAS unsigned* MISC = (volatile LAS unsigned*)(F.lds + MISC_OFF);
    for (int u = F.tid; u < (LDS_BYTES - LDSCTL_OFF) / 4; u += NWAVES * 64) ((LAS unsigned*)(F.lds + LDSCTL_OFF))[u] = 0u;
    __syncthreads();
    const int lo = args.ph_lo, hi = args.ph_hi;
    XcdBarrier bar = xcd_barrier_post(F.ctl + CW_BAR + lo * XCD_BAR_WORDS, MISC + 8);
#ifndef PH_MASK
#define PH_MASK 0xFFFF
#endif
#define PT(t) (((PH_MASK) >> (t)) & 1)
#ifndef REP_MASK
#define REP_MASK 0
#endif
#define NREP(t) ((((REP_MASK) >> (t)) & 1) ? 2 : 1)
#define REPEAT(t) for (int rep_ = 0; rep_ < NREP(t); ++rep_, (rep_ < NREP(t) ? xcd_barrier(bar) : (void)0))
#define IN(k) (lo <= (k) && (k) < hi)
#define SEAM(k) do { if ((k) + 1 < hi) xcd_barrier(bar); } while (0)
    const float* const* in = args.in;
    float* X = args.out;
    u64* SSQ = (u64*)(ws + WS_SSQ);
    bf16_t* XB = (bf16_t*)(ws + WS_XB);
    const int bx = (int)blockIdx.x;

    if (PT(0) && IN(0)) { asm volatile("; PHASE_MARK 0"); REPEAT(0) p0_prologue(F, in, ws); SEAM(0); }

    for (int lp = 0; lp < 2; ++lp) {
        const int pb = 1 + 15 * lp;
        bf16_t* WE = (bf16_t*)(ws + WS_WE) + (size_t)lp * E_SIZE; bf16_t* WO = (bf16_t*)(ws + WS_WO) + (size_t)lp * O_SIZE;
        u64* ssq0 = SSQ + (size_t)(4 * lp) * NTOK;
        if (PT(1) && IN(pb + 0)) { asm volatile("; PHASE_MARK 1");
            pg8::DenseOrder S; S.init(XB, DM, WE + E_WIN, DM, NTOK, 1024, F.G, bx);
            pg8::EpiZ E{(bf16_t*)(ws + R_Z), 1024, ssq0};
            REPEAT(1) pg8::gemm_phase(F.lds, pg8::Gemm{DM, DM, DM}, S, E);
            SEAM(pb + 0);
        }
        if (PT(2) && IN(pb + 1)) { asm volatile("; PHASE_MARK 2"); REPEAT(2) p_even_mid(F, ws); SEAM(pb + 1); }
        if (PT(3) && IN(pb + 2)) { asm volatile("; PHASE_MARK 3");
            REPEAT(3) {
            { pg8::DenseOrder S; S.init((const bf16_t*)(ws + R_Z) + 512, 1024, WE + E_WQ, 256, NTOK, 768, F.G, bx);
              pg8::EpiQ E{(bf16_t*)(ws + R_Q), (const float*)(ws + T_RQ), (const float*)(ws + T_COS), (const float*)(ws + T_SIN)};
              pg8::gemm_phase(F.lds, pg8::Gemm{1024, 256, 256}, S, E); }
            { pg8::DenseOrder S; S.init((const bf16_t*)(ws + R_Z) + 768, 1024, WE + E_WKV, 256, NTOK, 1024, F.G, bx);
              pg8::EpiKV E{(bf16_t*)(ws + R_K), (bf16_t*)(ws + R_V), (const float*)(ws + T_RKV)};
              pg8::gemm_phase(F.lds, pg8::Gemm{1024, 256, 256}, S, E); }
            }
            SEAM(pb + 2);
        }
        if (PT(4) && IN(pb + 3)) { asm volatile("; PHASE_MARK 4");
            const bf16_t* Q = (const bf16_t*)(ws + R_Q); const bf16_t* Kb = (const bf16_t*)(ws + R_K); const bf16_t* Vb = (const bf16_t*)(ws + R_V); bf16_t* MIX = (bf16_t*)(ws + R_MIX);
            REPEAT(4)
            for (int pi = F.vcu; pi < 256; pi += F.G) { const int bh = pi >> 3, s = pi & 7, b = bh >> 3, h = bh & 7;
#pragma unroll 1
                for (int k = 0; k < 2; ++k) { const int qb = k == 0 ? (15 - s) : s;
                    attn_unit<96, false>(Q + 96 * h, 768, Kb + 96 * h, 768, Vb + 64 * h, 512, MIX + 512 + 64 * h, 1024, b, qb, F.lds, nullptr); } }
            SEAM(pb + 3);
        }
        if (PT(5) && IN(pb + 4)) { asm volatile("; PHASE_MARK 5");
            pg8::DenseOrder S; S.init((const bf16_t*)(ws + R_MIX), 1024, WE + E_WOUT, 1024, NTOK, 1024, F.G, bx);
            pg8::EpiRes E{lp == 0 ? in[0] : X, X, XB, ssq0 + NTOK};
            pg8::gemm_phase(F.lds, pg8::Gemm{1024, 1024, 1024}, S, E);
            SEAM(pb + 4);
        }
        if (PT(6) && IN(pb + 5)) { asm volatile("; PHASE_MARK 6");
            pg8::DenseOrder S; S.init(XB, DM, WE + E_WGU, DM, NTOK, 2 * FF, F.G, bx);
            pg8::EpiSwiGLU<0> E{(bf16_t*)(ws + R_ACT), FF, ssq0 + NTOK};
            REPEAT(6) pg8::gemm_phase(F.lds, pg8::Gemm{DM, DM, DM}, S, E);
            SEAM(pb + 5);
        }
        if (PT(7) && IN(pb + 6)) { asm volatile("; PHASE_MARK 7");
            pg8::DenseOrder S; S.init((const bf16_t*)(ws + R_ACT), FF, WE + E_WDN, FF, NTOK, 1024, F.G, bx);
            pg8::EpiRes E{X, X, XB, ssq0 + 2 * NTOK};
            pg8::gemm_phase(F.lds, pg8::Gemm{FF, FF, FF}, S, E);
            SEAM(pb + 6);
        }
        if (PT(8) && IN(pb + 7)) { asm volatile("; PHASE_MARK 8");
            pg8::DenseOrder S; S.init(XB, DM, WO + O_WIN, DM, NTOK, 2560, F.G, bx);
            pg8::EpiOddIn E{(bf16_t*)(ws + R_QKV), (bf16_t*)(ws + R_UV), ssq0 + 2 * NTOK};
            REPEAT(8) pg8::gemm_phase(F.lds, pg8::Gemm{DM, DM, DM}, S, E);
            SEAM(pb + 7);
        }
        if (PT(9) && IN(pb + 8)) { asm volatile("; PHASE_MARK 9");
            const bf16_t* QKV = (const bf16_t*)(ws + R_QKV); const bf16_t* UV = (const bf16_t*)(ws + R_UV); bf16_t* MIX = (bf16_t*)(ws + R_MIX);
            const float* rb = in[16] + (size_t)lp * 8 * 257;
            REPEAT(9)
            for (int u = F.vcu; u < 512; u += F.G) { const int bh = u >> 4, qb = u & 15, b = bh >> 3, h = bh & 7;
                attn_unit<64, true>(QKV + 64 * h, 1536, QKV + 512 + 64 * h, 1536, QKV + 1024 + 64 * h, 1536, MIX + 64 * h, 1024, b, qb, F.lds, rb + h * 257); }
            REPEAT(10)
            for (int u = F.vcu; u < 512; u += F.G) { const int g = u & 3, n = (u >> 2) & 31, b = u >> 7;
                sgu_unit(UV, in[17] + (size_t)lp * 512, in[18] + (size_t)lp * 512, in[19] + (size_t)lp * 4 * 128 * 128, in[20] + (size_t)lp * 512, MIX, b, n, g, F.lds); }
            SEAM(pb + 8);
        }
        if (PT(10) && IN(pb + 9)) { asm volatile("; PHASE_MARK 10");
            pg8::DenseOrder S; S.init((const bf16_t*)(ws + R_MIX), 1024, WO + O_WOUT, 1024, NTOK, 1024, F.G, bx);
            pg8::EpiRes E{X, X, XB, ssq0 + 3 * NTOK};
            pg8::gemm_phase(F.lds, pg8::Gemm{1024, 1024, 1024}, S, E);
            SEAM(pb + 9);
        }
        unsigned* cnt = F.ctl + CW_CNT + 64 * lp;
        if (PT(11) && IN(pb + 10)) { asm volatile("; PHASE_MARK 11"); p_route(F, ws, X, ssq0 + 3 * NTOK, in[22] + (size_t)lp * 1024, in[23] + (size_t)lp * 8192, cnt); SEAM(pb + 10); }
        if (PT(12) && IN(pb + 11)) { asm volatile("; PHASE_MARK 12"); REPEAT(12) p_gather(F, ws, ssq0 + 3 * NTOK, cnt); SEAM(pb + 11); }
        if (PT(13) && IN(pb + 12)) { asm volatile("; PHASE_MARK 13");
            int off[9], cn[8]; moe_offsets(cnt, off, cn);
            pg8::MoeOrder S; S.A = (const char*)(ws + R_HS); S.Bt = (const char*)(WO + O_WGU); S.bstride = (size_t)2 * EFF * 1024 * 2; S.lda = 1024; S.ldb = 1024; S.nM = off[8] >> 8; S.nN = 2 * EFF / 256; S.G = F.G; S.c = bx; S.ksplit = 1; S.khalf = 0;
#pragma unroll
            for (int e = 0; e < 8; ++e) S.tend[e] = off[e + 1] >> 8;
            pg8::EpiSwiGLU<1> E{(bf16_t*)(ws + R_ACT2), EFF, (const float*)(ws + T_DRS)};
            REPEAT(13) pg8::gemm_phase(F.lds, pg8::Gemm{1024, 1024, 1024}, S, E);
            SEAM(pb + 12);
        }
        if (PT(14) && IN(pb + 13)) { asm volatile("; PHASE_MARK 14");
            int off[9], cn[8]; moe_offsets(cnt, off, cn);
            pg8::MoeOrder S; S.A = (const char*)(ws + R_ACT2); S.Bt = (const char*)(WO + O_WDN); S.bstride = (size_t)1024 * EFF * 2; S.lda = EFF; S.ldb = EFF; S.nM = off[8] >> 8; S.nN = 4; S.G = F.G; S.c = bx; S.ksplit = 2; S.khalf = (EFF / 2) * 2;
#pragma unroll
            for (int e = 0; e < 8; ++e) S.tend[e] = off[e + 1] >> 8;
            pg8::EpiY E{(bf16_t*)(ws + R_Y), (const float*)(ws + T_DGATE), (size_t)(R_Y1 - R_Y) / 2};
            REPEAT(14) pg8::gemm_phase(F.lds, pg8::Gemm{EFF, EFF, EFF / 2}, S, E);
            SEAM(pb + 13);
        }
        if (PT(15) && IN(pb + 14)) { asm volatile("; PHASE_MARK 15"); p_combine(F, ws, X, ssq0 + 4 * NTOK, in[27], lp == 1); SEAM(pb + 14); }
    }
#undef IN
#undef SEAM
}

extern "C" void kernel_launch(void* const* d_in, const int* in_sizes, int n_in, void* d_out, int out_size, void* d_ws, size_t ws_size, hipStream_t stream) {
    static int grid = 0;
    if (grid == 0) {
        if (n_in != 28 || in_sizes[0] != NTOK * DM || out_size != NTOK * DM || ws_size < WS_END) { fprintf(stderr, "kernel_launch: unexpected shapes / workspace (%d inputs, ws %zu, need %zu); nothing launched\n", n_in, ws_size, (size_t)WS_END); grid = -1; return; }
        int dev = 0, cus = 0, per_cu = 0;
        if (hipGetDevice(&dev) != hipSuccess || hipDeviceGetAttribute(&cus, hipDeviceAttributeMultiprocessorCount, dev) != hipSuccess) { grid = -1; return; }
        if (hipFuncSetAttribute((const void*)mk_fwd, hipFuncAttributeMaxDynamicSharedMemorySize, LDS_BYTES) != hipSuccess) { fprintf(stderr, "kernel_launch: hipFuncSetAttribute failed\n"); grid = -1; return; }
        if (hipOccupancyMaxActiveBlocksPerMultiprocessor(&per_cu, (const void*)mk_fwd, NWAVES * 64, LDS_BYTES) != hipSuccess || per_cu < 1) fprintf(stderr, "kernel_launch: occupancy query reports %d\n", per_cu);
        (void)hipGetLastError();
        grid = cus;
        if (grid > 256) grid = 256;
        grid &= ~7;
    }
    if (grid <= 0) return;
    if (hipMemsetAsync((char*)d_ws + WS_CTL, 0, CTL_ZERO_BYTES, stream) != hipSuccess) return;
    Args a{};
    for (int i = 0; i < 28; ++i) a.in[i] = (const float*)d_in[i];
    a.out = (float*)d_out; a.ws = (unsigned char*)d_ws;
#if MK_N_LAUNCHES == 1
    a.ph_lo = 0; a.ph_hi = NPH;
    hipLaunchKernelGGL(mk_fwd, dim3(grid), dim3(NWAVES * 64), LDS_BYTES, stream, a);
#else
    for (int p = 0; p < NPH; ++p) { a.ph_lo = p; a.ph_hi = p + 1; hipLaunchKernelGGL(mk_fwd, dim3(grid), dim3(NWAVES * 64), LDS_BYTES, stream, a); }
#endif
}
```

```cpp
#include <hip/hip_runtime.h>
#include <cstdio>
#include <cstdint>

#ifndef MK_N_LAUNCHES
#define MK_N_LAUNCHES 1
#endif

#ifndef TPROBE_OFS
#define TPROBE_OFS 0.0f
#endif
#ifndef TPROBE_BLK
#define TPROBE_BLK 0
#define TPROBE_TID 0
#endif
#ifndef GEMM4
#define GEMM4 0
#endif
#if GEMM4
#define GEMM_BF16 gemm_phase4
#else
#define GEMM_BF16 gemm_phase
#endif
#ifndef MOE_F8
#define MOE_F8 1
#endif
constexpr int MOE2_KSPLIT = MOE_F8 ? 1 : 2;
#ifndef FFN1_F8
#define FFN1_F8 1
#endif
#define LAS __attribute__((address_space(3)))
#define GAS __attribute__((address_space(1)))
typedef unsigned short bf16_t;
typedef short bf16x8 __attribute__((ext_vector_type(8)));
typedef short s16x4 __attribute__((ext_vector_type(4)));
typedef float f32x4 __attribute__((ext_vector_type(4)));
typedef float f32x2 __attribute__((ext_vector_type(2)));
typedef float f32x16 __attribute__((ext_vector_type(16)));
typedef unsigned u32x4 __attribute__((ext_vector_type(4)));
typedef unsigned u32x2 __attribute__((ext_vector_type(2)));

constexpr int NTOK = 16384, DM = 1024, SEQ = 4096;
constexpr float EPS = 1e-6f;
constexpr float LOG2E = 1.4426950408889634f;
constexpr float QS_MLA = 0.10206207261596575f * LOG2E;
constexpr float QS_BAND = 0.125f * LOG2E;
constexpr int FF = 2816, EFF = 3584, NEXP = 8;
constexpr int MOE_ROWS = 34816, TAIL_M0 = 128, TAIL_KS = 7, TAIL_ROWS = MOE_ROWS - TAIL_M0 * 256;
constexpr int MOE_ROWS_ = 34816;

constexpr size_t MiB = 1u << 20, KiB = 1024;
constexpr size_t WS_CTL = 0, CTL_ZERO_BYTES = 3 * MiB;
constexpr int CW_TMO = 0, CW_CNT = 64, CW_BAR = 4096;
constexpr size_t WS_SSQL = 2 * MiB + 256 * KiB;
constexpr size_t WS_SSQ = 1 * MiB;
constexpr size_t WS_TAB = 3 * MiB;
constexpr size_t T_COS = WS_TAB, T_SIN = WS_TAB + 256 * KiB, T_RQ = WS_TAB + 512 * KiB, T_RKV = WS_TAB + 576 * KiB, T_TE = WS_TAB + 640 * KiB,
                 T_TP = WS_TAB + 704 * KiB, T_TW = WS_TAB + 832 * KiB, T_PAIR = WS_TAB + 960 * KiB, T_DGATE = WS_TAB + 1088 * KiB, T_DRS = WS_TAB + 1280 * KiB, T_HG = WS_TAB + 1472 * KiB;
constexpr size_t WS_W = 5 * MiB;
constexpr size_t E_WIN = 0, E_WQ = 1048576, E_WKV = 1245184, E_WOUT = 1507328, E_WGU = 2555904, E_WDN = 8323072, E_SIZE = 11206656;
constexpr size_t O_WIN = 0, O_WOUT = 2621440, O_WGU = 3670016, O_WDN = 62390272, O_SIZE = 91750400;
constexpr size_t WS_WE = WS_W, WS_WO = WS_W + 2 * E_SIZE * 2;
static_assert(WS_WO + 2 * O_SIZE * 2 <= 400 * MiB, "weights");
constexpr size_t WS_XB = 400 * MiB;
constexpr size_t WS_R = 432 * MiB;
constexpr size_t R_Z = WS_R, R_Q = WS_R + 32 * MiB, R_K = WS_R + 56 * MiB, R_V = WS_R + 80 * MiB, R_MIX = WS_R + 96 * MiB, R_ACT = WS_R;
constexpr size_t R_QKV = WS_R, R_UV = WS_R + 48 * MiB, R_HS = WS_R, R_ACT2 = WS_R + 68 * MiB, R_Y = WS_R, R_Y1 = WS_R + 306 * MiB;
constexpr size_t WS_XB8 = WS_R + 374 * MiB;
constexpr size_t WS_END = WS_XB8 + 16 * MiB;
static_assert((size_t)MOE_ROWS * EFF * 2 <= 238 * MiB && (size_t)MOE_ROWS * 1024 * 2 <= 68 * MiB, "moe buffers");

constexpr int RING_BYTES = 131072, LDSCTL_OFF = 135168, MISC_OFF = LDSCTL_OFF + 320, LDS_BYTES = 151552;
constexpr int NWAVES = 8;

#define RLX_AGENT __ATOMIC_RELAXED, __HIP_MEMORY_SCOPE_AGENT
#define LDS_WAIT() asm volatile("s_waitcnt lgkmcnt(0)" ::: "memory")
#define VM_WAIT() asm volatile("s_waitcnt vmcnt(0)" ::: "memory")

typedef __bf16 bf16x2_t __attribute__((ext_vector_type(2)));
__device__ __forceinline__ unsigned cvt_pk_bf16(float lo, float hi) { const f32x2 v = {lo, hi}; const bf16x2_t b = __builtin_convertvector(v, bf16x2_t); return __builtin_bit_cast(unsigned, b); }
__device__ __forceinline__ float bf2f(unsigned short b) { return __uint_as_float(((unsigned)b) << 16); }
__device__ __forceinline__ float bflo(unsigned w) { return __uint_as_float(w << 16); }
__device__ __forceinline__ float bfhi(unsigned w) { return __uint_as_float(w & 0xffff0000u); }
__device__ __forceinline__ unsigned short f2bf(float f) { return (unsigned short)(cvt_pk_bf16(f, 0.f) & 0xffffu); }
__device__ __forceinline__ u32x4 zero4() { unsigned z; asm volatile("v_mov_b32 %0, 0" : "=v"(z)); return (u32x4){z, z, z, z}; }
__device__ __forceinline__ float wave_sum(float v) {
#pragma unroll
    for (int o = 1; o < 64; o <<= 1) v += __shfl_xor(v, o);
    return v;
}
__device__ __forceinline__ float clamp448(float x) { return __builtin_amdgcn_fmed3f(x, -448.0f, 448.0f); }
__device__ __forceinline__ unsigned pk4_fp8(float a, float b, float c, float d) { unsigned w = 0; w = __builtin_amdgcn_cvt_pk_fp8_f32(clamp448(a), clamp448(b), w, false); w = __builtin_amdgcn_cvt_pk_fp8_f32(clamp448(c), clamp448(d), w, true); return w; }
constexpr float F8_WS = 64.0f, F8_HS = 4.0f, F8_ACT = 8.0f;
constexpr int SC_W = 0x79797979, SC_HS = 0x7D7D7D7D, SC_ACT = 0x7C7C7C7C;
#ifndef WT_STORES
#define WT_STORES 1
#endif
struct WtBuf {
    __amdgpu_buffer_rsrc_t r; unsigned char* base;
    __device__ __forceinline__ void init(void* p) { base = (unsigned char*)p; const unsigned long long b = (unsigned long long)p;
        const unsigned lo = (unsigned)__builtin_amdgcn_readfirstlane((int)(unsigned)b), hi = (unsigned)__builtin_amdgcn_readfirstlane((int)(unsigned)(b >> 32));
        r = __builtin_amdgcn_make_buffer_rsrc((void*)(((unsigned long long)hi << 32) | lo), 0, 0x7FFFFFFF, 0x00020000); }
    __device__ __forceinline__ void st16(size_t off, u32x4 v) const {
#if WT_STORES
        __builtin_amdgcn_raw_buffer_store_b128(v, r, (int)(unsigned)off, 0, 16);
#else
        *(u32x4*)(base + off) = v;
#endif
    }
    __device__ __forceinline__ void st8(size_t off, u32x2 v) const {
#if WT_STORES
        __builtin_amdgcn_raw_buffer_store_b64(v, r, (int)(unsigned)off, 0, 16);
#else
        *(u32x2*)(base + off) = v;
#endif
    }
};
typedef unsigned long long u64;
__device__ __forceinline__ u64 ssq_fix(float s) { return (u64)((double)s * 4294967296.0); }
__device__ __forceinline__ float ssq_get(const u64* p, int row) { const u64 v = p[row]; return (float)(unsigned)(v >> 32) + (float)(unsigned)v * (1.0f / 4294967296.0f); }
__device__ __forceinline__ float rstd_raw(u64 v) { const float f = (float)(unsigned)(v >> 32) + (float)(unsigned)v * (1.0f / 4294967296.0f); return rsqrtf(f * (1.0f / DM) + EPS); }
__device__ __forceinline__ float ssq_f32(u64 v) { return (float)(unsigned)(v >> 32) + (float)(unsigned)v * (1.0f / 4294967296.0f); }
__device__ __forceinline__ float rstd_of(const u64* p, int row) { return rsqrtf(ssq_get(p, row) * (1.0f / DM) + EPS); }
__device__ __forceinline__ float fast_exp2(float x) { return __builtin_amdgcn_exp2f(x); }
__device__ __forceinline__ float fast_rcp(float x) { return __builtin_amdgcn_rcpf(x); }
__device__ __forceinline__ float sigmoidf_(float x) { return fast_rcp(1.0f + fast_exp2(-x * LOG2E)); }

__device__ __forceinline__ int opaque_tid() { int t = threadIdx.x; asm volatile("" : "+v"(t)); return t; }

namespace pg8 {
constexpr int BM = 256, BK = 64, HALF = 128, HTB = HALF * BK * 2, STAGE_BYTES = 8 * HTB, NXCD = 8, WGM = 8;
__host__ __device__ __forceinline__ int lds_byte(int r, int c) { const int st = (r >> 4) * 2 + (c >> 5), rr = r & 15, cc = c & 31, ob = rr * 64 + cc * 2; return st * 1024 + (ob ^ (((ob >> 9) & 1) << 5)); }
__host__ __device__ __forceinline__ void stage_rc(int b, int& R, int& C) { const int st = b / 1024, sb = b % 1024, swz = sb ^ (((sb >> 9) & 1) << 5); R = (st >> 1) * 16 + swz / 64; C = (st & 1) * 32 + (swz % 64) / 2; }
__host__ __device__ __forceinline__ int perm32(int rho) { const int n = rho >> 4, i = rho & 15; return 8 * (i >> 2) + 4 * n + (i & 3); }

struct Unit { int pm, pn, kh, nt; const char* a; const char* b; };
struct Gemm { int lda, ldb, K, sA, sB; float* tp = nullptr; };
typedef int i32x8 __attribute__((ext_vector_type(8)));

__device__ __forceinline__ int idiv_small(int a, int d) {
    int q = (int)(((float)a + 0.5f) * __builtin_amdgcn_rcpf((float)d));
    q -= (q * d > a) ? 1 : 0; q += ((q + 1) * d <= a) ? 1 : 0; return q;
}
__device__ __forceinline__ void tile_of(int L, int nM, int nN, int& pm, int& pn) {
    const int nwg = nM * nN;
    int wgid = L; { const int q = nwg >> 3, r = nwg & 7, xcd = wgid & 7, off = wgid >> 3; wgid = (xcd < r ? xcd * (q + 1) : r * (q + 1) + (xcd - r) * q) + off; }
    const int nig = WGM * nN, gid = idiv_small(wgid, nig), rem = wgid - gid * nig, fm = gid * WGM, gsz = (nM - fm) < WGM ? (nM - fm) : WGM;
    const int pq = gsz == WGM ? (rem >> 3) : idiv_small(rem, gsz);
    pm = fm + (rem - pq * gsz); pn = pq;
}
struct DenseOrder {
    const char* A; const char* Bt; int lda, ldb, nM, nN, G, c, esz = 2;
    __device__ __forceinline__ void init(const void* A_, int lda_, const void* Bt_, int ldb_, int M, int N, int G_, int c_) { A = (const char*)A_; Bt = (const char*)Bt_; lda = lda_; ldb = ldb_; nM = M / BM; nN = N / BM; G = G_; c = c_; asm volatile("" : "+s"(c)); }
    __device__ __forceinline__ bool next(int i, Unit& u) const {
        const long L = (long)i * G + c; if (L >= (long)nM * nN) return false;
        tile_of((int)L, nM, nN, u.pm, u.pn); u.kh = 0; u.nt = 0;
        u.a = A + (size_t)u.pm * BM * lda * esz; u.b = Bt + (size_t)u.pn * BM * ldb * esz; return true;
    }
};
struct MoeOrder {
    const char* A; const char* Bt; size_t bstride; int lda, ldb, esz, nM, nN, G, c, ksplit, khalf, tailM0, tail_ks, tail_kb; int tend[8];
    __device__ __forceinline__ bool next(int i, Unit& u) const {
        const long L = (long)i * G + c; const int nMm = nM < tailM0 ? nM : tailM0, nmain = nMm * nN * ksplit, ntail = (nM - nMm) * nN * tail_ks;
        if (L >= (long)(nmain + ntail)) return false;
        size_t koff = 0;
        if (L < nmain) { const int nwg = nMm * nN; const int kh = (L >= nwg) ? 1 : 0; tile_of((int)(L - (long)kh * nwg), nMm, nN, u.pm, u.pn); u.kh = kh; u.nt = 0; koff = (size_t)kh * khalf; }
        else { const int t = (int)L - nmain, ks = t % tail_ks, tu = t / tail_ks; u.pm = nMm + tu / nN; u.pn = tu % nN; u.kh = 1 + ks; u.nt = tail_kb / (BK * 2); koff = (size_t)ks * tail_kb; }
        int e = 0;
#pragma unroll
        for (int k = 0; k < 7; ++k) e += (u.pm >= tend[k]) ? 1 : 0;
        u.a = A + (size_t)u.pm * BM * lda * esz + koff; u.b = Bt + (size_t)e * bstride + (size_t)u.pn * BM * ldb * esz + koff; return true;
    }
};

template <class Epi, class Sched, bool ALIGN_EPI = true, bool F8 = false>
__device__ __forceinline__ void gemm_phase(LAS unsigned char* lds, const Gemm g, const Sched& S, const Epi& E) {
    const int tid = opaque_tid(), wid = __builtin_amdgcn_readfirstlane(tid >> 6), lane = tid & 63, wr = wid >> 2, wc = wid & 3, fr = lane & 15, fq = lane >> 4;
    int K = g.K; asm volatile("" : "+s"(K));
    constexpr int ESZ = F8 ? 1 : 2;
    const int nt_def = K * ESZ / (BK * 2);
    unsigned voffA[2], voffB[2];
#pragma unroll
    for (int i = 0; i < 2; ++i) { int R, C; stage_rc(tid * 16 + i * 8192, R, C); const int Rb = Epi::PERM ? ((R & ~31) + perm32(R & 31)) : R;
        voffA[i] = (unsigned)(R * g.lda * ESZ + C * 2); voffB[i] = (unsigned)(Rb * g.ldb * ESZ + C * 2); }
    const size_t kstep = (size_t)(BK * 2);
    const size_t hstepA = (size_t)HALF * g.lda * ESZ, hstepB = (size_t)HALF * g.ldb * ESZ;
    const unsigned ldsw = (unsigned)wid * 1024u;
    const int aoff = lds_byte(wr * 64 + fr, fq * 8), boff = lds_byte(wc * 32 + fr, fq * 8);
    const int sclA = g.sA, sclB = g.sB;
#define PG8_SA(b, h) (((b) * 2 + (h)) * HTB)
#define PG8_SB(b, h) ((4 + (b) * 2 + (h)) * HTB)
#define PG8_STAGE(bufoff, gbase, voff) do { _Pragma("unroll") for (int _i = 0; _i < 2; ++_i) \
        __builtin_amdgcn_global_load_lds((const unsigned*)((const char*)(gbase) + (voff)[_i]), (LAS unsigned*)(lds + (bufoff) + ldsw + _i * 8192), 16, 0, 0); } while (0)
#define PG8_LD32(p_) ({ const u32x4 lo_ = *(const LAS u32x4*)(p_), hi_ = *(const LAS u32x4*)((p_) + 1024); (i32x8){(int)lo_.x, (int)lo_.y, (int)lo_.z, (int)lo_.w, (int)hi_.x, (int)hi_.y, (int)hi_.z, (int)hi_.w}; })
#define PG8_LDA(dst, b, h) do { if constexpr (F8) { _Pragma("unroll") for (int m = 0; m < 4; ++m) dst##8[m] = PG8_LD32(lds + PG8_SA(b, h) + aoff + m * 2048); } else { _Pragma("unroll") for (int m = 0; m < 4; ++m) _Pragma("unroll") for (int k = 0; k < 2; ++k) dst[m][k] = *(const LAS bf16x8*)(lds + PG8_SA(b, h) + aoff + m * 2048 + k * 1024); } } while (0)
#define PG8_LDB(dst, b, h) do { if constexpr (F8) { _Pragma("unroll") for (int n = 0; n < 2; ++n) dst##8[n] = PG8_LD32(lds + PG8_SB(b, h) + boff + n * 2048); } else { _Pragma("unroll") for (int n = 0; n < 2; ++n) _Pragma("unroll") for (int k = 0; k < 2; ++k) dst[n][k] = *(const LAS bf16x8*)(lds + PG8_SB(b, h) + boff + n * 2048 + k * 1024); } } while (0)
#define PG8_MMA(ai, bj, At, Bt, Z) do { __builtin_amdgcn_s_setprio(1); if constexpr (F8) { \
        if (Z) { _Pragma("unroll") for (int m = 0; m < 4; ++m) _Pragma("unroll") for (int n = 0; n < 2; ++n) \
            asm volatile("v_mfma_scale_f32_16x16x128_f8f6f4 %0, %1, %2, 0, %3, %4 op_sel_hi:[0,0,0]" : "=v"(acc[ai][bj][m][n]) : "v"(Bt##8[n]), "v"(At##8[m]), "v"(sclB), "v"(sclA)); } \
        else { _Pragma("unroll") for (int m = 0; m < 4; ++m) _Pragma("unroll") for (int n = 0; n < 2; ++n) \
            asm volatile("v_mfma_scale_f32_16x16x128_f8f6f4 %0, %1, %2, %0, %3, %4 op_sel_hi:[0,0,0]" : "+v"(acc[ai][bj][m][n]) : "v"(Bt##8[n]), "v"(At##8[m]), "v"(sclB), "v"(sclA)); } \
        } else { \
        _Pragma("unroll") for (int m = 0; m < 4; ++m) _Pragma("unroll") for (int n = 0; n < 2; ++n) _Pragma("unroll") for (int k = 0; k < 2; ++k) \
            acc[ai][bj][m][n] = __builtin_amdgcn_mfma_f32_16x16x32_bf16(Bt[n][k], At[m][k], acc[ai][bj][m][n], 0, 0, 0); } __builtin_amdgcn_s_setprio(0); } while (0)
#define PG8_WAIT_V(n) asm volatile("s_waitcnt vmcnt(" #n ")" ::: "memory")
#define PG8_WAIT_L(n) asm volatile("s_waitcnt lgkmcnt(" #n ")" ::: "memory")
#define PG8_BAR __builtin_amdgcn_s_barrier()
#define PG8_SCHED __builtin_amdgcn_sched_barrier(0)
    Unit cur, nxt; int ui = 0;
    if (!S.next(0, cur)) return;
    float ers[8]; int epm = -1;
#pragma unroll
    for (int q = 0; q < 8; ++q) ers[q] = 0.f;
#ifdef TPROBE
    unsigned long long tp_s1 = 0, tp_s2 = 0, tp_s3 = 0, tp_s4 = 0, tp_t0 = __builtin_amdgcn_s_memtime(), tp_e = tp_t0;
#endif
    f32x4 acc[2][2][4][2];
    if constexpr (!F8) {
#pragma unroll
    for (int a = 0; a < 2; ++a)
#pragma unroll
        for (int b = 0; b < 2; ++b)
#pragma unroll
            for (int m = 0; m < 4; ++m)
#pragma unroll
                for (int n = 0; n < 2; ++n) acc[a][b][m][n] = (f32x4){0.f, 0.f, 0.f, 0.f};
    }
    bf16x8 At[4][2], B0[2][2], B1[2][2]; i32x8 At8[4], B08[2], B18[2];
    const char* cA = cur.a; const char* cB = cur.b;
    PG8_STAGE(PG8_SB(0, 0), cB, voffB); PG8_STAGE(PG8_SB(0, 1), cB + hstepB, voffB); PG8_STAGE(PG8_SA(0, 0), cA, voffA); PG8_STAGE(PG8_SA(0, 1), cA + hstepA, voffA);
    if (wr == 1) PG8_BAR;
    PG8_WAIT_V(2); PG8_BAR;
    PG8_STAGE(PG8_SB(1, 0), cB + kstep, voffB); PG8_STAGE(PG8_SA(1, 0), cA + kstep, voffA); PG8_STAGE(PG8_SB(1, 1), cB + hstepB + kstep, voffB);
    PG8_WAIT_V(6); PG8_BAR;
    for (;;) {
        const bool has_next = S.next(ui + 1, nxt);
        const char* nA = has_next ? nxt.a : cA; const char* nB = has_next ? nxt.b : cB;
        const int nt = cur.nt ? cur.nt : nt_def;
        if constexpr (Epi::HASPRE) { if constexpr (Epi::PRE_EARLY) { if (cur.pm != epm) { int fr_ = fr; asm volatile("" : "+v"(fr_)); E.pre(cur, wr, fr_, ers); epm = cur.pm; } } }
        for (int t = 0; t < nt; t += 2) {
            const bool last = (t == nt - 2), z0 = (t == 0);
            const char* a1 = cA + (size_t)(t + 1) * kstep;
            const char* a2 = last ? nA : cA + (size_t)(t + 2) * kstep; const char* b2 = last ? nB : cB + (size_t)(t + 2) * kstep;
            const char* a3 = a2 + kstep; const char* b3 = b2 + kstep;
            PG8_LDB(B0, 0, 0); PG8_LDB(B1, 0, 1); PG8_SCHED; PG8_LDA(At, 0, 0); PG8_STAGE(PG8_SA(1, 1), a1 + hstepA, voffA);
            PG8_WAIT_V(8); PG8_WAIT_L(0); PG8_BAR; PG8_MMA(0, 0, At, B0, z0); PG8_MMA(0, 1, At, B1, z0); PG8_BAR; PG8_SCHED;
            PG8_LDA(At, 0, 1); PG8_STAGE(PG8_SB(0, 0), b2, voffB); PG8_STAGE(PG8_SB(0, 1), b2 + hstepB, voffB); PG8_STAGE(PG8_SA(0, 0), a2, voffA);
            PG8_WAIT_V(8); PG8_WAIT_L(0); PG8_BAR; PG8_MMA(1, 0, At, B0, z0); PG8_MMA(1, 1, At, B1, z0); PG8_BAR; PG8_SCHED;
            PG8_LDB(B0, 1, 0); PG8_LDB(B1, 1, 1); PG8_SCHED; PG8_LDA(At, 1, 0); PG8_STAGE(PG8_SA(0, 1), a2 + hstepA, voffA);
            PG8_WAIT_V(8); PG8_WAIT_L(0); PG8_BAR; PG8_MMA(0, 0, At, B0, false); PG8_MMA(0, 1, At, B1, false); PG8_BAR; PG8_SCHED;
            PG8_LDA(At, 1, 1); PG8_STAGE(PG8_SB(1, 0), b3, voffB); PG8_STAGE(PG8_SB(1, 1), b3 + hstepB, voffB); PG8_STAGE(PG8_SA(1, 0), a3, voffA);
            PG8_WAIT_V(8); PG8_WAIT_L(0); PG8_BAR; PG8_MMA(1, 0, At, B0, false); PG8_MMA(1, 1, At, B1, false); PG8_BAR; PG8_SCHED;
        }
#ifdef TPROBE
        const unsigned long long tp_a = __builtin_amdgcn_s_memtime(); tp_s3 += tp_a - tp_e;
#endif
        if constexpr (F8) asm volatile("s_nop 15\n\ts_nop 7" ::: "memory");
        if constexpr (ALIGN_EPI) { if (wr == 0) PG8_BAR; }
#ifdef TPROBE
        const unsigned long long tp_b = __builtin_amdgcn_s_memtime(); tp_s1 += tp_b - tp_a;
#endif
        { int fr_ = fr, fq_ = fq; asm volatile("" : "+v"(fr_), "+v"(fq_));
          if constexpr (Epi::HASPRE) { if constexpr (!Epi::PRE_EARLY) { if (cur.pm != epm) { E.pre(cur, wr, fr_, ers); epm = cur.pm; } } E(acc, cur, wr, wc, fr_, fq_, ers); } else E(acc, cur, wr, wc, fr_, fq_);
#ifdef EPI_REP
          if constexpr (Epi::PROBE2) { asm volatile("" : "+v"(fr_), "+v"(fq_)); E(acc, cur, wr, wc, fr_, fq_); }
#endif
        }
#ifdef TPROBE
        { asm volatile("s_waitcnt vmcnt(0)" ::: "memory"); const unsigned long long tp_c = __builtin_amdgcn_s_memtime(); tp_s2 += tp_c - tp_b; tp_e = tp_c; }
#endif
        if (!has_next) break;
        if constexpr (!F8) {
#pragma unroll
        for (int a = 0; a < 2; ++a)
#pragma unroll
            for (int b = 0; b < 2; ++b)
#pragma unroll
                for (int m = 0; m < 4; ++m)
#pragma unroll
                    for (int n = 0; n < 2; ++n) acc[a][b][m][n] = (f32x4){0.f, 0.f, 0.f, 0.f};
        }
        cur = nxt; cA = nA; cB = nB; ++ui;
        if constexpr (ALIGN_EPI) { if (wr == 1) PG8_BAR; }
    }
    PG8_WAIT_V(0);
    if constexpr (!ALIGN_EPI) { if (wr == 0) PG8_BAR; }
    PG8_BAR;
#ifdef TPROBE
    if (g.tp && blockIdx.x == TPROBE_BLK && tid == TPROBE_TID) { const unsigned long long tt = __builtin_amdgcn_s_memtime() - tp_t0; const unsigned long long sel = TPROBE == 1 ? tp_s1 : TPROBE == 2 ? tp_s2 : tp_s3; const float f_ = (float)((double)sel / (double)tt); *g.tp = 0.02f * rintf(f_ * 20.0f + TPROBE_OFS); }
#endif
#undef PG8_SA
#undef PG8_SB
#undef PG8_STAGE
#undef PG8_LDA
#undef PG8_LD32
#undef PG8_LDB
#undef PG8_MMA
#undef PG8_WAIT_V
#undef PG8_WAIT_L
#undef PG8_BAR
#undef PG8_SCHED
}


__host__ __device__ __forceinline__ int lds_byte32(int r, int c) { const int rr = r & 15, ob = rr * 64 + c * 2; return (r >> 4) * 1024 + (ob ^ (((ob >> 9) & 1) << 5)); }
__host__ __device__ __forceinline__ void stage_rc32(int b, int& R, int& C) { const int st = b / 1024, sb = b % 1024, swz = sb ^ (((sb >> 9) & 1) << 5); R = st * 16 + swz / 64; C = (swz % 64) / 2; }
template <class Epi, class Sched>
__device__ __forceinline__ void gemm_phase4(LAS unsigned char* lds, const Gemm g, const Sched& S, const Epi& E) {
    const int tid = opaque_tid(), wid = __builtin_amdgcn_readfirstlane(tid >> 6), lane = tid & 63, wr = wid >> 2, wc = wid & 3, fr = lane & 15, fq = lane >> 4;
    int K = g.K; asm volatile("" : "+s"(K));
    const int nt = K / 32;
    constexpr int HT = 8192;
    unsigned voffA, voffB;
    { int R, C; stage_rc32(tid * 16, R, C); const int Rb = Epi::PERM ? ((R & ~31) + perm32(R & 31)) : R; voffA = (unsigned)(R * g.lda + C) * 2u; voffB = (unsigned)(Rb * g.ldb + C) * 2u; }
    const size_t kstep = 64, hstepA = (size_t)HALF * g.lda * 2, hstepB = (size_t)HALF * g.ldb * 2;
    const unsigned ldsw = (unsigned)wid * 1024u;
    const int aoff = lds_byte32(wr * 64 + fr, fq * 8), boff = lds_byte32(wc * 32 + fr, fq * 8);
#define G4_SA(s, h) ((((s) & 3) * 2 + (h)) * HT)
#define G4_SB(s, h) ((8 + ((s) & 3) * 2 + (h)) * HT)
#define G4_STAGE(bufoff, gptr, voff) __builtin_amdgcn_global_load_lds((const unsigned*)((const char*)(gptr) + (voff)), (LAS unsigned*)(lds + (bufoff) + ldsw), 16, 0, 0)
#define G4_LDA(s, h) do { _Pragma("unroll") for (int m = 0; m < 4; ++m) At[m] = *(const LAS bf16x8*)(lds + G4_SA(s, h) + aoff + m * 1024); } while (0)
#define G4_LDB(dst, s, h) do { _Pragma("unroll") for (int n = 0; n < 2; ++n) dst[n] = *(const LAS bf16x8*)(lds + G4_SB(s, h) + boff + n * 1024); } while (0)
#define G4_MMA(ai, bj, Bt) do { __builtin_amdgcn_s_setprio(1); _Pragma("unroll") for (int m = 0; m < 4; ++m) _Pragma("unroll") for (int n = 0; n < 2; ++n) \
        acc[ai][bj][m][n] = __builtin_amdgcn_mfma_f32_16x16x32_bf16(Bt[n], At[m], acc[ai][bj][m][n], 0, 0, 0); __builtin_amdgcn_s_setprio(0); } while (0)
#define G4_WAIT_V(n) asm volatile("s_waitcnt vmcnt(" #n ")" ::: "memory")
#define G4_WAIT_L0 asm volatile("s_waitcnt lgkmcnt(0)" ::: "memory")
#define G4_BAR __builtin_amdgcn_s_barrier()
#define G4_SCHED __builtin_amdgcn_sched_barrier(0)
#define G4_PA(tt) ((tt) < nt ? cA + (size_t)(tt) * kstep : nA + (size_t)((tt) - nt) * kstep)
#define G4_PB(tt) ((tt) < nt ? cB + (size_t)(tt) * kstep : nB + (size_t)((tt) - nt) * kstep)
#define G4_TILE(t_, s) do { \
        G4_LDB(B0, s, 0); G4_LDB(B1, s, 1); G4_SCHED; G4_LDA(s, 0); { const char* pa_ = G4_PA((t_) + 3); G4_STAGE(G4_SA((s) + 3, 1), pa_ + hstepA, voffA); } \
        G4_WAIT_V(12); G4_WAIT_L0; G4_BAR; G4_MMA(0, 0, B0); G4_MMA(0, 1, B1); G4_BAR; G4_SCHED; \
        G4_LDA(s, 1); { const char* pb_ = G4_PB((t_) + 4); const char* pa_ = G4_PA((t_) + 4); G4_STAGE(G4_SB(s, 0), pb_, voffB); G4_STAGE(G4_SB(s, 1), pb_ + hstepB, voffB); G4_STAGE(G4_SA(s, 0), pa_, voffA); } \
        G4_WAIT_V(12); G4_WAIT_L0; G4_BAR; G4_MMA(1, 0, B0); G4_MMA(1, 1, B1); G4_BAR; G4_SCHED; } while (0)
    Unit cur, nxt; int ui = 0;
    if (!S.next(0, cur)) return;
    f32x4 acc[2][2][4][2];
#pragma unroll
    for (int a = 0; a < 2; ++a)
#pragma unroll
        for (int b = 0; b < 2; ++b)
#pragma unroll
            for (int m = 0; m < 4; ++m)
#pragma unroll
                for (int n = 0; n < 2; ++n) { float z_; asm volatile("v_mov_b32 %0, 0" : "=v"(z_)); acc[a][b][m][n] = (f32x4){z_, z_, z_, z_}; }
    bf16x8 At[4], B0[2], B1[2];
    const char* cA = cur.a; const char* cB = cur.b;
    G4_STAGE(G4_SB(0, 0), cB, voffB); G4_STAGE(G4_SB(0, 1), cB + hstepB, voffB); G4_STAGE(G4_SA(0, 0), cA, voffA); G4_STAGE(G4_SA(0, 1), cA + hstepA, voffA);
    if (wr == 1) G4_BAR;
    G4_WAIT_V(1); G4_BAR;
    G4_STAGE(G4_SB(1, 0), cB + kstep, voffB); G4_STAGE(G4_SB(1, 1), cB + kstep + hstepB, voffB); G4_STAGE(G4_SA(1, 0), cA + kstep, voffA); G4_STAGE(G4_SA(1, 1), cA + kstep + hstepA, voffA);
    G4_STAGE(G4_SB(2, 0), cB + 2 * kstep, voffB); G4_STAGE(G4_SB(2, 1), cB + 2 * kstep + hstepB, voffB); G4_STAGE(G4_SA(2, 0), cA + 2 * kstep, voffA); G4_STAGE(G4_SA(2, 1), cA + 2 * kstep + hstepA, voffA);
    G4_STAGE(G4_SB(3, 0), cB + 3 * kstep, voffB); G4_STAGE(G4_SB(3, 1), cB + 3 * kstep + hstepB, voffB); G4_STAGE(G4_SA(3, 0), cA + 3 * kstep, voffA);
    G4_WAIT_V(12); G4_BAR;
    for (;;) {
        const bool has_next = S.next(ui + 1, nxt);
        const char* nA = has_next ? nxt.a : cA; const char* nB = has_next ? nxt.b : cB;
        for (int t = 0; t < nt; t += 4) { G4_TILE(t, 0); G4_TILE(t + 1, 1); G4_TILE(t + 2, 2); G4_TILE(t + 3, 3); }
        if (wr == 0) G4_BAR;
        { int fr_ = fr, fq_ = fq; asm volatile("" : "+v"(fr_), "+v"(fq_)); if constexpr (Epi::HASPRE) { float ers_[8]; E.pre(cur, wr, fr_, ers_); E(acc, cur, wr, wc, fr_, fq_, ers_); } else E(acc, cur, wr, wc, fr_, fq_); }
        if (!has_next) break;
#pragma unroll
        for (int a = 0; a < 2; ++a)
#pragma unroll
            for (int b = 0; b < 2; ++b)
#pragma unroll
                for (int m = 0; m < 4; ++m)
#pragma unroll
                    for (int n = 0; n < 2; ++n) { float z_; asm volatile("v_mov_b32 %0, 0" : "=v"(z_)); acc[a][b][m][n] = (f32x4){z_, z_, z_, z_}; }
        cur = nxt; cA = nA; cB = nB; ++ui;
        if (wr == 1) G4_BAR;
    }
    G4_WAIT_V(0);
    G4_BAR;
#undef G4_SA
#undef G4_SB
#undef G4_STAGE
#undef G4_LDA
#undef G4_LDB
#undef G4_MMA
#undef G4_WAIT_V
#undef G4_WAIT_L0
#undef G4_BAR
#undef G4_SCHED
#undef G4_PA
#undef G4_PB
#undef G4_TILE
}

typedef f32x4 Acc[2][2][4][2];

struct EpiZ { static constexpr bool PERM = true, PROBE2 = false, HASPRE = false;
    bf16_t* O; int ldc; const u64* ssq; u64* sq_q; u64* sq_kv; bf16_t* Kb; const float* cosT; const float* sinT;
    static __device__ __forceinline__ float sq8(const u32x4& w) { return (bflo(w.x) * bflo(w.x) + bfhi(w.x) * bfhi(w.x)) + (bflo(w.y) * bflo(w.y) + bfhi(w.y) * bfhi(w.y)) + (bflo(w.z) * bflo(w.z) + bfhi(w.z) * bfhi(w.z)) + (bflo(w.w) * bflo(w.w) + bfhi(w.w) * bfhi(w.w)); }
    __device__ __forceinline__ void operator()(const Acc& acc, const Unit& u, int wr, int wc, int fr, int fq) const {
        const int row0 = u.pm * BM + wr * 64 + fr, col0 = u.pn * BM + wc * 32 + 8 * fq;
        WtBuf ob; ob.init(O);
        u64 raw[8];
#pragma unroll
        for (int q = 0; q < 8; ++q) raw[q] = ssq[row0 + (q >> 2) * HALF + (q & 3) * 16];
#pragma unroll
        for (int ai = 0; ai < 2; ++ai)
#pragma unroll
            for (int m = 0; m < 4; ++m) { const int row = row0 + ai * HALF + m * 16; const float rs = rstd_raw(raw[ai * 4 + m]);
                const size_t ro = ((size_t)row * ldc + col0) * 2;
                u32x4 wv[2];
#pragma unroll
                for (int bj = 0; bj < 2; ++bj) { const f32x4 v0 = acc[ai][bj][m][0] * rs, v1 = acc[ai][bj][m][1] * rs;
                    u32x4 w; w.x = cvt_pk_bf16(v0[0], v0[1]); w.y = cvt_pk_bf16(v0[2], v0[3]); w.z = cvt_pk_bf16(v1[0], v1[1]); w.w = cvt_pk_bf16(v1[2], v1[3]);
                    ob.st16(ro + bj * HALF * 2, w); wv[bj] = w; }
                if (u.pn >= 2) {
                    float s = sq8(wv[0]); if (u.pn == 2) s += sq8(wv[1]);
                    s += __shfl_xor(s, 16); s += __shfl_xor(s, 32);
                    if (fq == 0) __hip_atomic_fetch_add((u.pn == 2 ? sq_q : sq_kv) + row, ssq_fix(s), RLX_AGENT);
                    if (u.pn == 3 && wc == 0) {
                        const u32x4 w = wv[1]; u32x4 pw; pw.x = __shfl_xor(w.x, 32); pw.y = __shfl_xor(w.y, 32); pw.z = __shfl_xor(w.z, 32); pw.w = __shfl_xor(w.w, 32);
                        const int pos = row & (SEQ - 1), jj = 8 * (fq & 1); const float sg = fq < 2 ? -1.0f : 1.0f;
                        const f32x4 c0 = *(const f32x4*)(cosT + pos * 16 + jj), c1 = *(const f32x4*)(cosT + pos * 16 + jj + 4);
                        const f32x4 s0 = *(const f32x4*)(sinT + pos * 16 + jj) * sg, s1 = *(const f32x4*)(sinT + pos * 16 + jj + 4) * sg;
                        u32x4 o;
                        o.x = cvt_pk_bf16(bflo(w.x) * c0[0] + bflo(pw.x) * s0[0], bfhi(w.x) * c0[1] + bfhi(pw.x) * s0[1]);
                        o.y = cvt_pk_bf16(bflo(w.y) * c0[2] + bflo(pw.y) * s0[2], bfhi(w.y) * c0[3] + bfhi(pw.y) * s0[3]);
                        o.z = cvt_pk_bf16(bflo(w.z) * c1[0] + bflo(pw.z) * s1[0], bfhi(w.z) * c1[1] + bfhi(pw.z) * s1[1]);
                        o.w = cvt_pk_bf16(bflo(w.w) * c1[2] + bflo(pw.w) * s1[2], bfhi(w.w) * c1[3] + bfhi(pw.w) * s1[3]);
                        bf16_t* kr = Kb + (size_t)row * 768 + 64 + 8 * fq;
#pragma unroll
                        for (int h = 0; h < 8; ++h) *(u32x4*)(kr + 96 * h) = o; } } }
    }
};
struct EpiQ { static constexpr bool PERM = false, PROBE2 = false, HASPRE = false;
    bf16_t* O; const u64* rq; const float* cosT; const float* sinT;
    __device__ __forceinline__ void operator()(const Acc& acc, const Unit& u, int wr, int wc, int fr, int fq) const {
        const int row0 = u.pm * BM + wr * 64 + fr;
        float rsv[8];
#pragma unroll
        for (int q = 0; q < 8; ++q) rsv[q] = rsqrtf(ssq_f32(rq[row0 + (q >> 2) * HALF + (q & 3) * 16]) * (1.0f / 256.0f) + EPS);
#pragma unroll
        for (int ai = 0; ai < 2; ++ai)
#pragma unroll
            for (int m = 0; m < 4; ++m) { const int row = row0 + ai * HALF + m * 16; const float rs = rsv[ai * 4 + m] * QS_MLA; const int pos = row & (SEQ - 1);
                const f32x4 cs = *(const f32x4*)(cosT + pos * 16 + 4 * fq), sn = *(const f32x4*)(sinT + pos * 16 + 4 * fq);
#pragma unroll
                for (int bj = 0; bj < 2; ++bj) { const int cb = u.pn * BM + bj * HALF + wc * 32; const bool rope = ((cb >> 5) % 3) == 2;
                    f32x4 v0 = acc[ai][bj][m][0] * rs, v1 = acc[ai][bj][m][1] * rs;
                    if (rope) { const f32x4 o0 = v0 * cs - v1 * sn, o1 = v1 * cs + v0 * sn; v0 = o0; v1 = o1; }
                    u32x2 w0, w1; w0.x = cvt_pk_bf16(v0[0], v0[1]); w0.y = cvt_pk_bf16(v0[2], v0[3]); w1.x = cvt_pk_bf16(v1[0], v1[1]); w1.y = cvt_pk_bf16(v1[2], v1[3]);
                    bf16_t* p = O + (size_t)row * 768 + cb + 4 * fq;
                    *(u32x2*)(p) = w0; *(u32x2*)(p + 16) = w1; } }
    }
};
struct EpiKV { static constexpr bool PERM = true, PROBE2 = false, HASPRE = false;
    bf16_t* Kb; bf16_t* Vb; const u64* rkv;
    __device__ __forceinline__ void operator()(const Acc& acc, const Unit& u, int wr, int wc, int fr, int fq) const {
        const int row0 = u.pm * BM + wr * 64 + fr;
        float rsv[8];
#pragma unroll
        for (int q = 0; q < 8; ++q) rsv[q] = rsqrtf(ssq_f32(rkv[row0 + (q >> 2) * HALF + (q & 3) * 16]) * (1.0f / 128.0f) + EPS);
#pragma unroll
        for (int ai = 0; ai < 2; ++ai)
#pragma unroll
            for (int m = 0; m < 4; ++m) { const int row = row0 + ai * HALF + m * 16; const float rs = rsv[ai * 4 + m];
#pragma unroll
                for (int bj = 0; bj < 2; ++bj) { const int h = 2 * u.pn + bj; const f32x4 v0 = acc[ai][bj][m][0] * rs, v1 = acc[ai][bj][m][1] * rs;
                    u32x4 w; w.x = cvt_pk_bf16(v0[0], v0[1]); w.y = cvt_pk_bf16(v0[2], v0[3]); w.z = cvt_pk_bf16(v1[0], v1[1]); w.w = cvt_pk_bf16(v1[2], v1[3]);
                    bf16_t* p = (wc < 2) ? (Kb + (size_t)row * 768 + 96 * h + 32 * wc + 8 * fq) : (Vb + (size_t)row * 512 + 64 * h + 32 * (wc - 2) + 8 * fq);
                    *(u32x4*)p = w; } }
    }
};
struct EpiRes { static constexpr bool PERM = false, PROBE2 = false, HASPRE = false;
    const float* base32; bf16_t* XB; u64* ssq_next; unsigned char* X8;
    __device__ __forceinline__ void finish(const f32x4 (&o)[2][2], int row, size_t off, int fq) const {
        f32x2 s2 = (f32x2){0.f, 0.f};
#pragma unroll
        for (int bj = 0; bj < 2; ++bj)
#pragma unroll
            for (int n = 0; n < 2; ++n) { const f32x4 v = o[bj][n]; const f32x2 va = (f32x2){v[0], v[1]}, vb = (f32x2){v[2], v[3]}; s2 = va * va + s2; s2 = vb * vb + s2;
                u32x2 w; w.x = cvt_pk_bf16(v[0], v[1]); w.y = cvt_pk_bf16(v[2], v[3]); *(u32x2*)(XB + off + bj * HALF + n * 16) = w;
                if (X8) { const f32x2 qa = va * F8_HS, qb = vb * F8_HS; *(unsigned*)(X8 + off + bj * HALF + n * 16) = pk4_fp8(qa.x, qa.y, qb.x, qb.y); } }
        float s = s2.x + s2.y;
        s += __shfl_xor(s, 16); s += __shfl_xor(s, 32);
        if (fq == 0) __hip_atomic_fetch_add(ssq_next + row, ssq_fix(s), RLX_AGENT);
    }
    __device__ __forceinline__ void operator()(const Acc& acc, const Unit& u, int wr, int wc, int fr, int fq) const {
        const int row0 = u.pm * BM + wr * 64 + fr, col0 = u.pn * BM + wc * 32 + 4 * fq;
        if (base32) {
#pragma unroll
            for (int ai = 0; ai < 2; ++ai)
#pragma unroll
                for (int mp = 0; mp < 2; ++mp) { f32x4 bs[2][2][2];
#pragma unroll
                    for (int mm = 0; mm < 2; ++mm) { const size_t off = (size_t)(row0 + ai * HALF + (2 * mp + mm) * 16) * DM + col0;
#pragma unroll
                        for (int bj = 0; bj < 2; ++bj)
#pragma unroll
                            for (int n = 0; n < 2; ++n) bs[mm][bj][n] = *(const f32x4*)(base32 + off + bj * HALF + n * 16); }
#pragma unroll
                    for (int mm = 0; mm < 2; ++mm) { const int m = 2 * mp + mm; const int row = row0 + ai * HALF + m * 16; f32x4 o[2][2];
#pragma unroll
                        for (int bj = 0; bj < 2; ++bj)
#pragma unroll
                            for (int n = 0; n < 2; ++n) o[bj][n] = bs[mm][bj][n] + acc[ai][bj][m][n];
                        finish(o, row, (size_t)row * DM + col0, fq); }
                    asm volatile("" ::: "memory"); }
        } else {
#pragma unroll
            for (int ai = 0; ai < 2; ++ai) { u32x2 raw[4][2][2];
#pragma unroll
                for (int m = 0; m < 4; ++m) { const size_t off = (size_t)(row0 + ai * HALF + m * 16) * DM + col0;
#pragma unroll
                    for (int bj = 0; bj < 2; ++bj)
#pragma unroll
                        for (int n = 0; n < 2; ++n) raw[m][bj][n] = *(const u32x2*)(XB + off + bj * HALF + n * 16); }
#pragma unroll
                for (int m = 0; m < 4; ++m) { const int row = row0 + ai * HALF + m * 16; f32x4 o[2][2];
#pragma unroll
                    for (int bj = 0; bj < 2; ++bj)
#pragma unroll
                        for (int n = 0; n < 2; ++n) { const u32x2 b2 = raw[m][bj][n]; o[bj][n] = (f32x4){bflo(b2.x), bfhi(b2.x), bflo(b2.y), bfhi(b2.y)} + acc[ai][bj][m][n]; }
                    finish(o, row, (size_t)row * DM + col0, fq); }
                asm volatile("" ::: "memory"); }
        }
    }
};
template <int MODE> struct EpiSwiGLU { static constexpr bool PERM = true, PROBE2 = false, HASPRE = true, PRE_EARLY = (MODE == 1 || MODE == 2);
    bf16_t* O; int ldc; const void* rsrc;
    __device__ __forceinline__ void pre(const Unit& u, int wr, int fr, float (&rsv)[8]) const {
        const int row0 = u.pm * BM + wr * 64 + fr;
        if (MODE == 0 || MODE == 3) { u64 raw[8];
#pragma unroll
            for (int q = 0; q < 8; ++q) raw[q] = ((const u64*)rsrc)[row0 + (q >> 2) * HALF + (q & 3) * 16];
#pragma unroll
            for (int q = 0; q < 8; ++q) rsv[q] = rstd_raw(raw[q]);
        } else {
#pragma unroll
            for (int q = 0; q < 8; ++q) rsv[q] = ((const float*)rsrc)[row0 + (q >> 2) * HALF + (q & 3) * 16]; }
    }
    __device__ __forceinline__ void operator()(const Acc& acc, const Unit& u, int wr, int wc, int fr, int fq, const float (&rsv)[8]) const {
        const int row0 = u.pm * BM + wr * 64 + fr, col0 = u.pn * HALF + wc * 32 + 8 * fq;
        WtBuf ob; ob.init(O);
#pragma unroll
        for (int ai = 0; ai < 2; ++ai)
#pragma unroll
            for (int m = 0; m < 4; ++m) { const int row = row0 + ai * HALF + m * 16; const float rs = rsv[ai * 4 + m];
                float o[8];
                const float rsu = rs * (MODE == 2 ? F8_ACT : 1.0f), rsl = rs * (-LOG2E);
#pragma unroll
                for (int n = 0; n < 2; ++n)
#pragma unroll
                    for (int hh = 0; hh < 2; ++hh) { const f32x2 g2 = (f32x2){acc[ai][0][m][n][2 * hh], acc[ai][0][m][n][2 * hh + 1]}, u2 = (f32x2){acc[ai][1][m][n][2 * hh], acc[ai][1][m][n][2 * hh + 1]};
                        const f32x2 gg = g2 * rs, uu = u2 * rsu; f32x2 ee = g2 * rsl;
                        ee.x = fast_exp2(ee.x); ee.y = fast_exp2(ee.y); f32x2 dd = ee + 1.0f; dd.x = fast_rcp(dd.x); dd.y = fast_rcp(dd.y);
                        const f32x2 oo = (gg * dd) * uu; o[n * 4 + 2 * hh] = oo.x; o[n * 4 + 2 * hh + 1] = oo.y; }
                if (MODE == 2) { u32x2 w8; w8.x = pk4_fp8(o[0], o[1], o[2], o[3]); w8.y = pk4_fp8(o[4], o[5], o[6], o[7]);
                    ob.st8((size_t)row * ldc + col0, w8); }
                else { u32x4 w; w.x = cvt_pk_bf16(o[0], o[1]); w.y = cvt_pk_bf16(o[2], o[3]); w.z = cvt_pk_bf16(o[4], o[5]); w.w = cvt_pk_bf16(o[6], o[7]);
                    ob.st16(((size_t)row * ldc + col0) * 2, w); } }
    }
};
struct EpiOddIn { static constexpr bool PERM = true, PROBE2 = false, HASPRE = true, PRE_EARLY = false;
    bf16_t* QKV; bf16_t* UV; const u64* ssq;
    __device__ __forceinline__ void pre(const Unit& u, int wr, int fr, float (&rsv)[8]) const {
        const int row0 = u.pm * BM + wr * 64 + fr; u64 raw[8];
#pragma unroll
        for (int q = 0; q < 8; ++q) raw[q] = ssq[row0 + (q >> 2) * HALF + (q & 3) * 16];
#pragma unroll
        for (int q = 0; q < 8; ++q) rsv[q] = rstd_raw(raw[q]);
    }
    __device__ __forceinline__ void operator()(const Acc& acc, const Unit& u, int wr, int wc, int fr, int fq, const float (&rsv)[8]) const {
        const int row0 = u.pm * BM + wr * 64 + fr; const bool isuv = u.pn >= 6; const float qsc = u.pn < 2 ? QS_BAND : 1.0f;
#pragma unroll
        for (int ai = 0; ai < 2; ++ai)
#pragma unroll
            for (int m = 0; m < 4; ++m) { const int row = row0 + ai * HALF + m * 16; const float rs = rsv[ai * 4 + m];
#pragma unroll
                for (int bj = 0; bj < 2; ++bj) { float o[8];
#pragma unroll
                    for (int n = 0; n < 2; ++n)
#pragma unroll
                        for (int hh = 0; hh < 2; ++hh) { f32x2 v = (f32x2){acc[ai][bj][m][n][2 * hh], acc[ai][bj][m][n][2 * hh + 1]} * rs;
                            if (isuv) { constexpr float K0 = -2.0f * 0.7978845608028654f * LOG2E, K1 = K0 * 0.044715f;
                                f32x2 e = v * (v * v * K1 + K0); e.x = fast_exp2(e.x); e.y = fast_exp2(e.y); f32x2 d = e + 1.0f; d.x = fast_rcp(d.x); d.y = fast_rcp(d.y); v = v * d; }
                            else v = v * qsc;
                            o[n * 4 + 2 * hh] = v.x; o[n * 4 + 2 * hh + 1] = v.y; }
                    u32x4 w; w.x = cvt_pk_bf16(o[0], o[1]); w.y = cvt_pk_bf16(o[2], o[3]); w.z = cvt_pk_bf16(o[4], o[5]); w.w = cvt_pk_bf16(o[6], o[7]);
                    bf16_t* p = isuv ? (UV + (size_t)row * 1024 + (u.pn - 6) * BM + bj * HALF + wc * 32 + 8 * fq) : (QKV + (size_t)row * 1536 + u.pn * BM + bj * HALF + wc * 32 + 8 * fq);
                    *(u32x4*)p = w; } }
    }
};
struct EpiY { static constexpr bool PERM = true, PROBE2 = false, HASPRE = true, PRE_EARLY = true;
    bf16_t* O; const float* gate; size_t ys; bf16_t* YP; int tail_row0;
    __device__ __forceinline__ void pre(const Unit& u, int wr, int fr, float (&rsv)[8]) const {
        const int row0 = u.pm * BM + wr * 64 + fr;
#pragma unroll
        for (int q = 0; q < 8; ++q) rsv[q] = gate[row0 + (q >> 2) * HALF + (q & 3) * 16];
    }
    __device__ __forceinline__ void operator()(const Acc& acc, const Unit& u, int wr, int wc, int fr, int fq, const float (&rsv)[8]) const {
        const int row0 = u.pm * BM + wr * 64 + fr, col0 = u.pn * BM + wc * 32 + 8 * fq;
        WtBuf ob, oy; ob.init(O); oy.init(YP ? YP : O);
#pragma unroll
        for (int ai = 0; ai < 2; ++ai)
#pragma unroll
            for (int m = 0; m < 4; ++m) { const int row = row0 + ai * HALF + m * 16; const float rs = rsv[ai * 4 + m];
                const bool tl = YP && u.kh; const size_t ro = (tl ? (((size_t)(u.kh - 1) * TAIL_ROWS + (size_t)(row - tail_row0)) * DM + col0) : ((size_t)u.kh * ys + (size_t)row * DM + col0)) * 2;
#pragma unroll
                for (int bj = 0; bj < 2; ++bj) { const f32x4 v0 = acc[ai][bj][m][0] * rs, v1 = acc[ai][bj][m][1] * rs;
                    u32x4 w; w.x = cvt_pk_bf16(v0[0], v0[1]); w.y = cvt_pk_bf16(v0[2], v0[3]); w.z = cvt_pk_bf16(v1[0], v1[1]); w.w = cvt_pk_bf16(v1[2], v1[3]);
                    if (tl) oy.st16(ro + bj * HALF * 2, w); else ob.st16(ro + bj * HALF * 2, w); } }
    }
};
}

#define XB_TMO      128
#define XB_XCNT(j)  (256  + 64 * (j))
#define XB_XSUB(j)  (1280 + 64 * (j))
#define XB_XGEN(j)  (2304 + 64 * (j))
#define XB_TOP      3328
#define XB_TOPGEN   3392
#define XCD_BAR_WORDS 3456
#define XB_SPIN_CAP (1u << 18)
__device__ __forceinline__ unsigned xb_ld(unsigned* p)              { return __hip_atomic_load(p, __ATOMIC_RELAXED, __HIP_MEMORY_SCOPE_AGENT); }
__device__ __forceinline__ unsigned xb_add(unsigned* p, unsigned v) { return __hip_atomic_fetch_add(p, v, __ATOMIC_RELAXED, __HIP_MEMORY_SCOPE_AGENT); }
__device__ __forceinline__ unsigned xb_xcc_id() { return (unsigned)__builtin_amdgcn_s_getreg((3 << 11) | 20) & 0xFu; }
#define XB_SPIN(cond, bar) do { unsigned _sp = 0; while (cond) { __builtin_amdgcn_s_sleep(1); \
    if ((++_sp & 255u) == 0u) { if (xb_ld(&(bar)[XB_TMO])) break; if (_sp > XB_SPIN_CAP) { atomicAdd(&(bar)[XB_TMO], 1u); break; } } } } while (0)
struct XcdBarrier { unsigned* bar; unsigned x; volatile LAS unsigned* st; };
__device__ __forceinline__ XcdBarrier xcd_barrier_post(unsigned* bar, volatile LAS unsigned* st) {
    XcdBarrier b; b.bar = bar; b.x = xb_xcc_id(); b.st = st;
    if (threadIdx.x == 0) (void)xb_add(&bar[XB_XCNT(b.x)], 1u);
    return b;
}
__device__ __forceinline__ void xcd_barrier_complete(unsigned* bar, unsigned x, unsigned& nloc, unsigned& nx) {
    const unsigned G = gridDim.x * gridDim.y * gridDim.z;
    unsigned sum, cnt, mine, sp = 0u;
    for (;;) {
        sum = 0u; cnt = 0u; mine = 0u;
#pragma unroll
        for (unsigned j = 0; j < 16; ++j) { const unsigned c = xb_ld(&bar[XB_XCNT(j)]); sum += c; cnt += (c > 0u) ? 1u : 0u; mine = (j == x) ? c : mine; }
        if (sum == G) break;
        __builtin_amdgcn_s_sleep(1);
        if ((++sp & 255u) == 0u) { if (xb_ld(&bar[XB_TMO])) break; if (sp > XB_SPIN_CAP) { atomicAdd(&bar[XB_TMO], 1u); break; } }
    }
    nloc = mine > 0u ? mine : 1u; nx = cnt > 0u ? cnt : 1u;
}
__device__ __forceinline__ void xcd_barrier(const XcdBarrier& b) {
    asm volatile("s_waitcnt vmcnt(0)" ::: "memory");
    __syncthreads();
    if (threadIdx.x == 0) {
        unsigned* bar = b.bar;
        __builtin_amdgcn_s_waitcnt(0);
        unsigned nloc = b.st[0], nx = b.st[1];
        if (nloc == 0u) { xcd_barrier_complete(bar, b.x, nloc, nx); b.st[0] = nloc; b.st[1] = nx; }
        const unsigned old = xb_add(&bar[XB_XSUB(b.x)], 1u);
        const unsigned gen = old / nloc;
        if (old + 1u == (gen + 1u) * nloc) {
            __builtin_amdgcn_fence(__ATOMIC_RELEASE, "agent");
            asm volatile("s_waitcnt vmcnt(0)" ::: "memory");
            const unsigned og = xb_add(&bar[XB_TOP], 1u);
            const unsigned tg = og / nx;
            if (og + 1u == (tg + 1u) * nx) xb_add(&bar[XB_TOPGEN], 1u);
            else XB_SPIN(xb_ld(&bar[XB_TOPGEN]) == tg, bar);
            __builtin_amdgcn_fence(__ATOMIC_ACQUIRE, "agent");
            xb_add(&bar[XB_XGEN(b.x)], 1u);
            asm volatile("s_waitcnt vmcnt(0)" ::: "memory");
        } else {
            XB_SPIN(xb_ld(&bar[XB_XGEN(b.x)]) == gen, bar);
            __builtin_amdgcn_fence(__ATOMIC_ACQUIRE, "agent");
            asm volatile("s_waitcnt vmcnt(0)" ::: "memory");
        }
    }
    __syncthreads();
}

struct Frame {
    LAS unsigned char* lds;
    unsigned* ctl;
    int tid, lane, wave, vcu, G;
    __device__ __forceinline__ void refresh() { tid = opaque_tid(); lane = tid & 63; wave = __builtin_amdgcn_readfirstlane(tid >> 6); }
};

struct XJob { const float* W; const float* gain; bf16_t* WT; int K, N, ldt, mode, nb; size_t sb, db; int istart, f8; };
__device__ __forceinline__ void xpose_load(const XJob& J, int item, f32x4 (&v)[16], int lane) {
    const int nblk = (J.N + 63) / 64, nkb = J.K / 64, per = nkb * nblk, e = item / per, r = item % per, kb = r % nkb, nbk = r / nkb, k0 = 64 * kb, n0 = 64 * nbk;
    const float* W = J.W + (size_t)e * J.sb;
    const int lr = lane >> 4, lc = 4 * (lane & 15);
    const bool colok = (n0 + lc) < J.N;
#pragma unroll
    for (int i = 0; i < 16; ++i) v[i] = colok ? __builtin_nontemporal_load((const f32x4*)(W + (size_t)(k0 + 4 * i + lr) * J.N + n0 + lc)) : (f32x4){0.f, 0.f, 0.f, 0.f};
}
__device__ __forceinline__ void xpose_store(const XJob& J, int item, const f32x4 (&v)[16], LAS float* scr, int lane) {
    const int nblk = (J.N + 63) / 64, nkb = J.K / 64, per = nkb * nblk, e = item / per, r = item % per, kb = r % nkb, nbk = r / nkb, k0 = 64 * kb, n0 = 64 * nbk;
    bf16_t* WT = J.WT + (size_t)e * J.db;
    const int lr = lane >> 4, lc = 4 * (lane & 15);
#pragma unroll
    for (int i = 0; i < 16; ++i) { const int kk = 4 * i + lr; const float gs = J.gain ? J.gain[k0 + kk] : 1.0f; LAS float* d = scr + kk * 65 + lc;
        d[0] = v[i][0] * gs; d[1] = v[i][1] * gs; d[2] = v[i][2] * gs; d[3] = v[i][3] * gs; }
    LDS_WAIT(); asm volatile("" ::: "memory");
    const int c = lane & 7;
#pragma unroll
    for (int j = 0; j < 8; ++j) { const int n = (lane >> 3) + 8 * j; const LAS float* s = scr + (8 * c) * 65 + n;
        u32x4 o; o.x = cvt_pk_bf16(s[0 * 65], s[1 * 65]); o.y = cvt_pk_bf16(s[2 * 65], s[3 * 65]); o.z = cvt_pk_bf16(s[4 * 65], s[5 * 65]); o.w = cvt_pk_bf16(s[6 * 65], s[7 * 65]);
        const int ng = n0 + n; const int row = J.mode == 0 ? ng : ((ng >> 7) * 256 + (ng & 127) + (J.mode == 2 ? 128 : 0));
        if (J.f8) { u32x2 o8; o8.x = pk4_fp8(s[0 * 65] * F8_WS, s[1 * 65] * F8_WS, s[2 * 65] * F8_WS, s[3 * 65] * F8_WS); o8.y = pk4_fp8(s[4 * 65] * F8_WS, s[5 * 65] * F8_WS, s[6 * 65] * F8_WS, s[7 * 65] * F8_WS);
            *(u32x2*)((unsigned char*)J.WT + (size_t)e * J.db + (size_t)row * J.ldt + k0 + 8 * c) = o8; }
        else if (ng < J.N) *(u32x4*)(WT + (size_t)row * J.ldt + k0 + 8 * c) = o; }
    LDS_WAIT(); asm volatile("" ::: "memory");
}
constexpr int NJT = 12;
__device__ __forceinline__ void make_job(int i, int t, const float* const* in, unsigned char* ws, XJob& J) {
    J.gain = nullptr; J.mode = 0; J.nb = 1; J.sb = 0; J.db = 0; J.istart = 0; J.f8 = 0;
    bf16_t* WE = (bf16_t*)(ws + WS_WE) + (size_t)i * E_SIZE; bf16_t* WO = (bf16_t*)(ws + WS_WO) + (size_t)i * O_SIZE;
    switch (t) {
    case 0: J.W = in[2] + (size_t)i * 1024 * 928; J.gain = in[1] + i * 1024; J.WT = WE + E_WIN; J.K = 1024; J.N = 928; J.ldt = 1024; break;
    case 1: J.W = in[6] + (size_t)i * 256 * 768; J.gain = in[5] + i * 256; J.WT = WE + E_WQ; J.K = 256; J.N = 768; J.ldt = 256; break;
    case 2: J.W = in[8] + (size_t)i * 128 * 1024; J.gain = in[7] + i * 128; J.WT = WE + E_WKV; J.K = 128; J.N = 1024; J.ldt = 256; break;
    case 3: J.W = in[9] + (size_t)i * 1024 * 1024 + (size_t)512 * 1024; J.WT = WE + E_WOUT + 512; J.K = 512; J.N = 1024; J.ldt = 1024; break;
    case 4: J.W = in[11] + (size_t)i * 1024 * FF; J.gain = in[10] + i * 1024; J.WT = WE + E_WGU; J.K = 1024; J.N = FF; J.ldt = 1024; J.mode = 1; J.f8 = FFN1_F8; break;
    case 5: J.W = in[12] + (size_t)i * 1024 * FF; J.gain = in[10] + i * 1024; J.WT = WE + E_WGU; J.K = 1024; J.N = FF; J.ldt = 1024; J.mode = 2; J.f8 = FFN1_F8; break;
    case 6: J.W = in[13] + (size_t)i * FF * 1024; J.WT = WE + E_WDN; J.K = FF; J.N = 1024; J.ldt = FF; break;
    case 7: J.W = in[15] + (size_t)i * 1024 * 2560; J.gain = in[14] + i * 1024; J.WT = WO + O_WIN; J.K = 1024; J.N = 2560; J.ldt = 1024; break;
    case 8: J.W = in[21] + (size_t)i * 1024 * 1024; J.WT = WO + O_WOUT; J.K = 1024; J.N = 1024; J.ldt = 1024; break;
    case 9: J.W = in[24] + (size_t)i * NEXP * 1024 * EFF; J.gain = in[22] + i * 1024; J.WT = WO + O_WGU; J.K = 1024; J.N = EFF; J.ldt = 1024; J.mode = 1; J.nb = NEXP; J.sb = (size_t)1024 * EFF; J.db = (size_t)2 * EFF * 1024; J.f8 = MOE_F8; break;
    case 10: J.W = in[25] + (size_t)i * NEXP * 1024 * EFF; J.gain = in[22] + i * 1024; J.WT = WO + O_WGU; J.K = 1024; J.N = EFF; J.ldt = 1024; J.mode = 2; J.nb = NEXP; J.sb = (size_t)1024 * EFF; J.db = (size_t)2 * EFF * 1024; J.f8 = MOE_F8; break;
    default: J.W = in[26] + (size_t)i * NEXP * EFF * 1024; J.WT = WO + O_WDN; J.K = EFF; J.N = 1024; J.ldt = EFF; J.nb = NEXP; J.sb = (size_t)EFF * 1024; J.db = (size_t)1024 * EFF; J.f8 = MOE_F8; break;
    }
}
__host__ __device__ constexpr int job_items_t(int t) {
    return t == 0 ? 16 * 15 : t == 1 ? 4 * 12 : t == 2 ? 2 * 16 : t == 3 ? 8 * 16 : t == 4 ? 16 * 44 : t == 5 ? 16 * 44 : t == 6 ? 44 * 16 : t == 7 ? 16 * 40 : t == 8 ? 16 * 16 : t == 9 ? 8 * 16 * 56 : t == 10 ? 8 * 16 * 56 : 8 * 56 * 16;
}
__host__ __device__ constexpr int job_start_t(int t) { int a = 0; for (int k = 0; k < t; ++k) a += job_items_t(k); return a; }
constexpr int ITEMS_PER_PAIR = job_start_t(NJT);

__device__ __forceinline__ void p0_prologue(Frame& F, const float* const* in, unsigned char* ws) {
    F.refresh();
    LAS float* scr = (LAS float*)(F.lds + F.wave * 16640);
    const int gw = F.vcu * NWAVES + F.wave, NGW = F.G * NWAVES;
#define XP_DECODE(it_, J_, r_) do { const int i_ = (it_) / ITEMS_PER_PAIR, rr_ = (it_) % ITEMS_PER_PAIR; int t_ = 0; \
        _Pragma("unroll") for (int k = 1; k < NJT; ++k) t_ += (rr_ >= job_start_t(k)) ? 1 : 0; int st_ = 0; \
        _Pragma("unroll") for (int k = 1; k < NJT; ++k) st_ = (t_ == k) ? job_start_t(k) : st_; make_job(i_, t_, in, ws, J_); r_ = rr_ - st_; } while (0)
    { constexpr int NIT = 2 * ITEMS_PER_PAIR; int it = gw; XJob Jc; int rc = 0; f32x4 vc[16];
      if (it < NIT) { XP_DECODE(it, Jc, rc); xpose_load(Jc, rc, vc, F.lane); }
      while (it < NIT) {
          const int itn = it + NGW; XJob Jn = Jc; int rn = 0; f32x4 vn[16];
          if (itn < NIT) { XP_DECODE(itn, Jn, rn); xpose_load(Jn, rn, vn, F.lane); }
          xpose_store(Jc, rc, vc, scr, F.lane);
          it = itn; Jc = Jn; rc = rn;
#pragma unroll
          for (int i = 0; i < 16; ++i) vc[i] = vn[i];
      } }
#undef XP_DECODE
    const int gt = F.vcu * 512 + F.tid, NGT = F.G * 512;
    for (int i = 0; i < 2; ++i) {
        bf16_t* WE = (bf16_t*)(ws + WS_WE) + (size_t)i * E_SIZE;
        for (int x = gt; x < 96 * 1024 / 8; x += NGT) *(u32x4*)(WE + E_WIN + (size_t)928 * 1024 + (size_t)x * 8) = zero4();
        for (int x = gt; x < 1024 * 16; x += NGT) { const int r = x >> 4, c = x & 15; *(u32x4*)(WE + E_WKV + (size_t)r * 256 + 128 + c * 8) = zero4(); }
    }
    for (int x = gt; x < 2 * 64 * 1024; x += NGT) {
        const int n = x & 1023, kg = __builtin_amdgcn_readfirstlane((x >> 10) & 63), i = __builtin_amdgcn_readfirstlane(x >> 16), g = kg >> 4, c0 = (8 * kg) & 127;
        const float* pr = in[3] + (size_t)i * 4 * 128 * 128 + ((size_t)g * 128 + c0) * 128; const float* sr = in[4] + (size_t)i * 512 + g * 128;
        const float* wr_ = in[9] + (size_t)i * 1024 * 1024 + (size_t)(g * 128) * 1024 + n;
        float a[8];
#pragma unroll
        for (int kk = 0; kk < 8; ++kk) a[kk] = 0.f;
        float wc[8], wn[8];
#pragma unroll
        for (int u = 0; u < 8; ++u) { wc[u] = wr_[(size_t)u * 1024]; wn[u] = 0.f; }
#pragma unroll 1
        for (int d0 = 0; d0 < 128; d0 += 8) {
            if (d0 + 8 < 128) {
#pragma unroll
                for (int u = 0; u < 8; ++u) wn[u] = wr_[(size_t)(d0 + 8 + u) * 1024]; }
#pragma unroll
            for (int u = 0; u < 8; ++u) { const float wv = wc[u] * sr[d0 + u];
#pragma unroll
                for (int kk = 0; kk < 8; ++kk) a[kk] += pr[kk * 128 + d0 + u] * wv; }
#pragma unroll
            for (int u = 0; u < 8; ++u) wc[u] = wn[u]; }
        u32x4 o; o.x = cvt_pk_bf16(a[0], a[1]); o.y = cvt_pk_bf16(a[2], a[3]); o.z = cvt_pk_bf16(a[4], a[5]); o.w = cvt_pk_bf16(a[6], a[7]);
        *(u32x4*)((bf16_t*)(ws + WS_WE) + (size_t)i * E_SIZE + E_WOUT + (size_t)n * 1024 + 8 * kg) = o;
    }
    { float* cosT = (float*)(ws + T_COS); float* sinT = (float*)(ws + T_SIN);
      for (int x = gt; x < SEQ * 16; x += NGT) { const int pos = x >> 4, j = x & 15;
          const float inv = 1.0f / powf(10000.0f, (float)(2 * j) / 32.0f); const float angf = (float)pos * inv;
          double a = (double)angf; const double twopi = 6.283185307179586476925; a -= twopi * rint(a / twopi);
          const double y = a * 0.125, y2 = y * y;
          double s = y * (1.0 + y2 * (-1.0 / 6 + y2 * (1.0 / 120 + y2 * (-1.0 / 5040 + y2 * (1.0 / 362880 + y2 * (-1.0 / 39916800 + y2 * (1.0 / 6227020800.0)))))));
          double c = 1.0 + y2 * (-0.5 + y2 * (1.0 / 24 + y2 * (-1.0 / 720 + y2 * (1.0 / 40320 + y2 * (-1.0 / 3628800 + y2 * (1.0 / 479001600.0 + y2 * (-1.0 / 87178291200.0)))))));
#pragma unroll
          for (int k = 0; k < 3; ++k) { const double s2 = 2.0 * s * c, c2 = c * c - s * s; s = s2; c = c2; }
          cosT[x] = (float)c; sinT[x] = (float)s; } }
    { const float* x = in[0]; bf16_t* XB = (bf16_t*)(ws + WS_XB); u64* ssq = (u64*)(ws + WS_SSQ);
      for (int m = gw; m < NTOK; m += NGW) { const f32x4* xr = (const f32x4*)(x + (size_t)m * DM) + F.lane; float s = 0.f;
#pragma unroll
          for (int j = 0; j < 4; ++j) { const f32x4 v = xr[64 * j]; s += (v[0] * v[0] + v[1] * v[1]) + (v[2] * v[2] + v[3] * v[3]);
              u32x2 w; w.x = cvt_pk_bf16(v[0], v[1]); w.y = cvt_pk_bf16(v[2], v[3]); *((u32x2*)(XB + (size_t)m * DM) + F.lane + 64 * j) = w; }
          s = wave_sum(s); if (F.lane == 0) ssq[m] = ssq_fix(s); } }
}

typedef float f32p2 __attribute__((ext_vector_type(2)));
__device__ __forceinline__ void p_pooled(Frame& F, unsigned char* ws, int bx) {
    F.refresh();
    const bf16_t* Z = (const bf16_t*)(ws + R_Z); bf16_t* MIX = (bf16_t*)(ws + R_MIX);
    const bool tailwg = F.G == 256; if (tailwg && bx < 192) return;
    const int gw = (tailwg ? bx - 192 : F.vcu) * NWAVES + F.wave, NGW = (tailwg ? 64 : F.G) * NWAVES;
    const int w = 2 << (F.lane >> 4);
    for (int g = gw; g < NTOK / 8; g += NGW) { const int t0 = 8 * g, p0 = t0 & (SEQ - 1);
        u32x4 R[23];
#pragma unroll
        for (int k = 0; k < 23; ++k) { const int d = 15 - k; const bool inseq = p0 - d >= 0; const int dd = (inseq && d < w) ? d : 0;
            u32x4 v = *((const u32x4*)(Z + (size_t)(t0 - dd) * 1024) + F.lane); const unsigned mk = inseq ? 0xFFFFFFFFu : 0u;
            if (d > 0) { v.x &= mk; v.y &= mk; v.z &= mk; v.w &= mk; }
            R[k] = v; }
        float ic[8];
#pragma unroll
        for (int r = 0; r < 8; ++r) { const int cnt = (p0 + r + 1 < w) ? (p0 + r + 1) : w; ic[r] = fast_rcp((float)cnt); }
        u32x4 out[8];
#pragma unroll
        for (int c = 0; c < 4; ++c) { f32p2 a[23], self[8], res[8];
#pragma unroll
            for (int k = 0; k < 23; ++k) a[k] = (f32p2){bflo(R[k][c]), bfhi(R[k][c])};
#pragma unroll
            for (int r = 0; r < 8; ++r) self[r] = a[15 + r];
#pragma unroll
            for (int k = 22; k >= 1; --k) a[k] += a[k - 1];
#pragma unroll
            for (int r = 0; r < 8; ++r) res[r] = a[15 + r];
#pragma unroll
            for (int k = 22; k >= 3; --k) a[k] += a[k - 2];
#pragma unroll
            for (int r = 0; r < 8; ++r) res[r] = w >= 4 ? a[15 + r] : res[r];
#pragma unroll
            for (int k = 22; k >= 7; --k) a[k] += a[k - 4];
#pragma unroll
            for (int r = 0; r < 8; ++r) res[r] = w >= 8 ? a[15 + r] : res[r];
#pragma unroll
            for (int k = 22; k >= 15; --k) a[k] += a[k - 8];
#pragma unroll
            for (int r = 0; r < 8; ++r) { res[r] = w >= 16 ? a[15 + r] : res[r]; const f32p2 o = res[r] * ic[r] - self[r]; out[r][c] = cvt_pk_bf16(o.x, o.y); } }
#pragma unroll
        for (int r = 0; r < 8; ++r) *((u32x4*)(MIX + (size_t)(t0 + r) * 1024) + F.lane) = out[r]; }
}

__device__ __forceinline__ int crow(int r, int hi) { return (r & 3) + 8 * (r >> 2) + 4 * hi; }
__device__ __forceinline__ s16x4 vtr(const LAS unsigned char* p) { return __builtin_bit_cast(s16x4, __builtin_amdgcn_ds_read_tr16_b64_v4i16((LAS s16x4*)p)); }

template <int DQK, bool BAND>
__device__ __forceinline__ void attn_unit(const bf16_t* __restrict__ Qp, int ldq, const bf16_t* __restrict__ Kp, int ldk, const bf16_t* __restrict__ Vp, int ldv,
                                          bf16_t* Op, int ldo, int b, int qb, LAS unsigned char* lds, const float* bias_g) {
    constexpr int KSTR = (DQK + 8) * 2, KBUF = 64 * KSTR, VBUF = 8192, KCH = DQK / 8, NKS = DQK / 16;
    const int tid = opaque_tid(), lane = tid & 63, wave = __builtin_amdgcn_readfirstlane(tid >> 6), r32 = lane & 31, hi = lane >> 5;
    LAS unsigned char* Kl = lds; LAS unsigned char* Vl = lds + 2 * KBUF;
    LAS float* sc = (LAS float*)(lds + 2 * KBUF + 2 * VBUF) + wave * 32;
    LAS float* biasL = (LAS float*)(lds + 2 * KBUF + 2 * VBUF + 1024);
    const int chunkw = 4 * qb + (wave >> 1), t1 = 4 * qb + 3, t0 = BAND ? ((4 * qb - 8) > 0 ? (4 * qb - 8) : 0) : 0;
    const size_t rowb = (size_t)b * SEQ;
    if (BAND) { if (tid < 257) biasL[tid] = bias_g[tid] * LOG2E; }
    if (wave < 4) __builtin_amdgcn_s_setprio(2);
    bf16x8 qf[NKS];
    { const bf16_t* qrow = Qp + (rowb + 256 * qb + 32 * wave + r32) * ldq + 8 * hi;
#pragma unroll
      for (int ks = 0; ks < NKS; ++ks) qf[ks] = *(const bf16x8*)(qrow + 16 * ks); }
    const int kkey0 = tid / KCH, kch0 = tid % KCH; const int idx1 = tid + 512; const bool has1 = idx1 < 64 * KCH; const int kkey1 = has1 ? idx1 / KCH : 0, kch1 = has1 ? idx1 % KCH : 0;
    const int vkey = tid >> 3, vch = tid & 7;
    const bf16_t* kg0 = Kp + (rowb + kkey0) * ldk + 8 * kch0; const bf16_t* kg1 = Kp + (rowb + kkey1) * ldk + 8 * kch1; const bf16_t* vg = Vp + (rowb + vkey) * ldv + 8 * vch;
    const int kl0 = kkey0 * KSTR + kch0 * 16, kl1 = kkey1 * KSTR + kch1 * 16, vl = (vch >> 2) * 4096 + vkey * 64 + (vch & 3) * 16;
    u32x4 st[2][3];
#pragma unroll
    for (int q = 0; q < 2; ++q) { st[q][0] = (u32x4){0u, 0u, 0u, 0u}; st[q][1] = (u32x4){0u, 0u, 0u, 0u}; st[q][2] = (u32x4){0u, 0u, 0u, 0u}; }
#define ATT_LOAD(set, tt) do { const size_t to_ = (size_t)(tt) * 64; st[set][0] = *(const u32x4*)(kg0 + to_ * ldk); if (has1) st[set][1] = *(const u32x4*)(kg1 + to_ * ldk); st[set][2] = *(const u32x4*)(vg + to_ * ldv); } while (0)
#define ATT_WRITE(set, buf) do { *(LAS u32x4*)(Kl + (buf) * KBUF + kl0) = st[set][0]; if (has1) *(LAS u32x4*)(Kl + (buf) * KBUF + kl1) = st[set][1]; *(LAS u32x4*)(Vl + (buf) * VBUF + vl) = st[set][2]; } while (0)
    ATT_LOAD(0, t0); ATT_WRITE(0, 0);
    if (t0 + 1 <= t1) ATT_LOAD(1, t0 + 1);
    __syncthreads();
    float m_run = 0.f; f32x16 o0 = {}, o1 = {}, lacc = {}, negm = {}; bool first = true;
    const bf16x8 ones8 = (bf16x8){0x3F80, 0x3F80, 0x3F80, 0x3F80, 0x3F80, 0x3F80, 0x3F80, 0x3F80};
    const int vtoff = (16 * ((lane >> 4) & 1) + 4 * (lane & 3)) * 2 + (4 * hi + ((lane & 15) >> 2)) * 64;
    for (int tb = t0; tb <= t1; tb += 2) {
#pragma unroll
      for (int ph = 0; ph < 2; ++ph) {
        const int t = tb + ph; if (t > t1) break;
        const int cur = (t - t0) & 1; const bool more = t < t1;
        if (t + 2 <= t1) ATT_LOAD(ph, t + 2);
        const bool active = BAND ? (t <= chunkw && t >= chunkw - 8) : (t <= chunkw);
        if (active) {
            const LAS unsigned char* Ks = Kl + cur * KBUF; const LAS unsigned char* Vs = Vl + cur * VBUF;
            f32x16 s0, s1;
#pragma unroll
            for (int ks = 0; ks < NKS; ++ks) {
                const bf16x8 k0 = *(const LAS bf16x8*)(Ks + r32 * KSTR + ks * 32 + hi * 16);
                const bf16x8 k1 = *(const LAS bf16x8*)(Ks + (32 + r32) * KSTR + ks * 32 + hi * 16);
                s0 = __builtin_amdgcn_mfma_f32_32x32x16_bf16(k0, qf[ks], ks == 0 ? negm : s0, 0, 0, 0);
                s1 = __builtin_amdgcn_mfma_f32_32x32x16_bf16(k1, qf[ks], ks == 0 ? negm : s1, 0, 0, 0);
            }
            if (BAND) {
                if (t <= chunkw - 3) { const float cb = biasL[256];
#pragma unroll
                    for (int r = 0; r < 16; ++r) { s0[r] += cb; s1[r] += cb; } }
                else { const int qpos = 256 * qb + 32 * wave + r32, kb0 = 64 * t;
#pragma unroll
                    for (int r = 0; r < 16; ++r) { const int rel = qpos - (kb0 + crow(r, hi)); int i0 = rel < -128 ? -128 : (rel > 128 ? 128 : rel); int rel1 = rel - 32; int i1 = rel1 < -128 ? -128 : (rel1 > 128 ? 128 : rel1);
                        s0[r] += biasL[i0 + 128]; s1[r] += biasL[i1 + 128]; } }
            }
            float mx = s0[0];
#pragma unroll
            for (int r = 1; r < 16; ++r) mx = fmaxf(mx, s0[r]);
#pragma unroll
            for (int r = 0; r < 16; ++r) mx = fmaxf(mx, s1[r]);
            { const auto rr_ = __builtin_amdgcn_permlane32_swap(__float_as_uint(mx), __float_as_uint(mx), false, false); mx = fmaxf(__uint_as_float(rr_[0]), __uint_as_float(rr_[1])); }
            if (first || __any(mx > 8.0f)) {
                const float dl = first ? mx : fmaxf(mx, 0.f); m_run += dl;
#pragma unroll
                for (int r = 0; r < 16; ++r) { s0[r] -= dl; s1[r] -= dl; }
                const float alpha = first ? 1.0f : fast_exp2(-dl);
#pragma unroll
                for (int r = 0; r < 16; ++r) negm[r] = -m_run;
                if (hi == 0) sc[r32] = alpha;
                LDS_WAIT();
#pragma unroll
                for (int r = 0; r < 16; ++r) { const float a = sc[crow(r, hi)]; o0[r] *= a; o1[r] *= a; lacc[r] *= a; }
                LDS_WAIT();
                first = false;
            }
#pragma unroll
            for (int r = 0; r < 16; ++r) { s0[r] = fast_exp2(s0[r]); s1[r] = fast_exp2(s1[r]); }
#pragma unroll
            for (int hf = 0; hf < 2; ++hf)
#pragma unroll
                for (int s2 = 0; s2 < 2; ++s2) {
                    u32x4 pw;
                    if (hf == 0) { pw.x = cvt_pk_bf16(s0[8 * s2 + 0], s0[8 * s2 + 1]); pw.y = cvt_pk_bf16(s0[8 * s2 + 2], s0[8 * s2 + 3]); pw.z = cvt_pk_bf16(s0[8 * s2 + 4], s0[8 * s2 + 5]); pw.w = cvt_pk_bf16(s0[8 * s2 + 6], s0[8 * s2 + 7]); }
                    else         { pw.x = cvt_pk_bf16(s1[8 * s2 + 0], s1[8 * s2 + 1]); pw.y = cvt_pk_bf16(s1[8 * s2 + 2], s1[8 * s2 + 3]); pw.z = cvt_pk_bf16(s1[8 * s2 + 4], s1[8 * s2 + 5]); pw.w = cvt_pk_bf16(s1[8 * s2 + 6], s1[8 * s2 + 7]); }
                    const bf16x8 pa = __builtin_bit_cast(bf16x8, pw);
                    lacc = __builtin_amdgcn_mfma_f32_32x32x16_bf16(pa, ones8, lacc, 0, 0, 0);
                    const LAS unsigned char* vb = Vs + (32 * hf + 16 * s2) * 64 + vtoff;
#pragma unroll
                    for (int dh = 0; dh < 2; ++dh) {
                        const s16x4 lo = vtr(vb + dh * 4096), hh = vtr(vb + dh * 4096 + 8 * 64);
                        const bf16x8 vf = (bf16x8){lo[0], lo[1], lo[2], lo[3], hh[0], hh[1], hh[2], hh[3]};
                        if (dh == 0) o0 = __builtin_amdgcn_mfma_f32_32x32x16_bf16(pa, vf, o0, 0, 0, 0);
                        else         o1 = __builtin_amdgcn_mfma_f32_32x32x16_bf16(pa, vf, o1, 0, 0, 0);
                    }
                }
        }
        if (more) ATT_WRITE(ph ^ 1, cur ^ 1);
        __syncthreads();
      }
    }
#undef ATT_LOAD
#undef ATT_WRITE
    __builtin_amdgcn_s_setprio(0);
    { bf16_t* orow = Op + (rowb + 256 * qb + 32 * wave) * ldo + r32;
#pragma unroll
      for (int r = 0; r < 16; ++r) { const int q = crow(r, hi); const float inv = fast_rcp(lacc[r]);
          orow[(size_t)q * ldo] = f2bf(o0[r] * inv); orow[(size_t)q * ldo + 32] = f2bf(o1[r] * inv); } }
}

__device__ __forceinline__ void sgu_unit(const bf16_t* UV, const float* ng, const float* nb, const float* W, const float* bs, bf16_t* MIX, int b, int n, int g, LAS unsigned char* lds) {
    const int tid = opaque_tid(), lane = tid & 63, wave = __builtin_amdgcn_readfirstlane(tid >> 6), r32 = lane & 31, hi = lane >> 5;
    const size_t t0 = (size_t)b * SEQ + (size_t)n * 128;
    { const int s = tid >> 2, qd = tid & 3; const bf16_t* src = UV + (t0 + s) * 1024 + 512 + g * 128 + 32 * qd;
      float x[32];
#pragma unroll
      for (int j = 0; j < 4; ++j) { const u32x4 v = *((const u32x4*)src + j); x[8 * j + 0] = bflo(v.x); x[8 * j + 1] = bfhi(v.x); x[8 * j + 2] = bflo(v.y); x[8 * j + 3] = bfhi(v.y); x[8 * j + 4] = bflo(v.z); x[8 * j + 5] = bfhi(v.z); x[8 * j + 6] = bflo(v.w); x[8 * j + 7] = bfhi(v.w); }
      float sm = 0.f;
#pragma unroll
      for (int j = 0; j < 32; ++j) sm += x[j];
      sm += __shfl_xor(sm, 1); sm += __shfl_xor(sm, 2);
      const float mu = sm * (1.0f / 128.0f); float vs = 0.f;
#pragma unroll
      for (int j = 0; j < 32; ++j) { x[j] -= mu; vs += x[j] * x[j]; }
      vs += __shfl_xor(vs, 1); vs += __shfl_xor(vs, 2);
      const float rstd = rsqrtf(vs * (1.0f / 128.0f) + EPS);
      const float* gp = ng + g * 128 + 32 * qd; const float* bp = nb + g * 128 + 32 * qd;
#pragma unroll
      for (int j = 0; j < 4; ++j) { float y[8];
#pragma unroll
          for (int i = 0; i < 8; ++i) y[i] = x[8 * j + i] * rstd * gp[8 * j + i] + bp[8 * j + i];
          u32x4 w; w.x = cvt_pk_bf16(y[0], y[1]); w.y = cvt_pk_bf16(y[2], y[3]); w.z = cvt_pk_bf16(y[4], y[5]); w.w = cvt_pk_bf16(y[6], y[7]);
          *(LAS u32x4*)(lds + qd * 8192 + s * 64 + j * 16) = w; } }
    __syncthreads();
    { const int tb = wave >> 1, cb0 = 2 * (wave & 1), trow = 32 * tb + r32;
      f32x16 acc0 = {}, acc1 = {};
      const float* wrow = W + ((size_t)g * 128 + trow) * 128 + 8 * hi;
      const int vto = (8 * hi + ((lane & 15) >> 2)) * 64 + (16 * ((lane >> 4) & 1) + 4 * (lane & 3)) * 2;
      for (int ks = 0; ks < 2 * (tb + 1); ++ks) {
          const f32x4 w0 = *(const f32x4*)(wrow + 16 * ks), w1 = *(const f32x4*)(wrow + 16 * ks + 4);
          const int s0 = 16 * ks + 8 * hi; float a[8];
#pragma unroll
          for (int j = 0; j < 4; ++j) { a[j] = (s0 + j <= trow) ? w0[j] : 0.f; a[4 + j] = (s0 + 4 + j <= trow) ? w1[j] : 0.f; }
          u32x4 aw; aw.x = cvt_pk_bf16(a[0], a[1]); aw.y = cvt_pk_bf16(a[2], a[3]); aw.z = cvt_pk_bf16(a[4], a[5]); aw.w = cvt_pk_bf16(a[6], a[7]);
          const bf16x8 af = __builtin_bit_cast(bf16x8, aw);
          const LAS unsigned char* vb = lds + (16 * ks) * 64 + vto;
          { const s16x4 lo = vtr(vb + cb0 * 8192), hh = vtr(vb + cb0 * 8192 + 4 * 64); const bf16x8 bfr = (bf16x8){lo[0], lo[1], lo[2], lo[3], hh[0], hh[1], hh[2], hh[3]};
            acc0 = __builtin_amdgcn_mfma_f32_32x32x16_bf16(af, bfr, acc0, 0, 0, 0); }
          { const s16x4 lo = vtr(vb + (cb0 + 1) * 8192), hh = vtr(vb + (cb0 + 1) * 8192 + 4 * 64); const bf16x8 bfr = (bf16x8){lo[0], lo[1], lo[2], lo[3], hh[0], hh[1], hh[2], hh[3]};
            acc1 = __builtin_amdgcn_mfma_f32_32x32x16_bf16(af, bfr, acc1, 0, 0, 0); }
      }
#pragma unroll
      for (int r = 0; r < 16; ++r) { const int t = 32 * tb + crow(r, hi); const float bias = bs[g * 128 + t];
          const size_t ro = (t0 + t) * 1024 + g * 128 + 32 * cb0 + r32;
          const float u0 = bf2f(UV[ro]), u1 = bf2f(UV[ro + 32]);
          MIX[ro + 512] = f2bf(u0 * (acc0[r] + bias)); MIX[ro + 512 + 32] = f2bf(u1 * (acc1[r] + bias)); } }
    __syncthreads();
}

__device__ __forceinline__ void p_route(Frame& F, unsigned char* ws, const bf16_t* XBr, const u64* ssq, const float* gain, const float* router, unsigned* cnt) {
    F.refresh();
    LAS int* hist = (LAS int*)(F.lds + 32768);
    LAS int* gbase = (LAS int*)(F.lds + 32768 + 64);
    LAS int* pe = (LAS int*)(F.lds + 32768 + 128);
    LAS float* pwt = (LAS float*)(F.lds + 32768 + 128 + 1024);
    int* TE = (int*)(ws + T_TE); int* TP = (int*)(ws + T_TP); float* TW = (float*)(ws + T_TW); int* HG = (int*)(ws + T_HG);
    float rw[8][16];
#pragma unroll
    for (int j = 0; j < 4; ++j)
#pragma unroll
        for (int i = 0; i < 4; ++i) { const int k = 256 * j + 4 * F.lane + i; const float gk = gain[k]; const f32x4 a = *(const f32x4*)(router + k * 8), b = *(const f32x4*)(router + k * 8 + 4);
            rw[0][j * 4 + i] = a[0] * gk; rw[1][j * 4 + i] = a[1] * gk; rw[2][j * 4 + i] = a[2] * gk; rw[3][j * 4 + i] = a[3] * gk;
            rw[4][j * 4 + i] = b[0] * gk; rw[5][j * 4 + i] = b[1] * gk; rw[6][j * 4 + i] = b[2] * gk; rw[7][j * 4 + i] = b[3] * gk; }
    for (int blk = F.vcu; blk < NTOK / 64; blk += F.G) {
        __syncthreads();
        u32x2 xc[4], xn[4];
#pragma unroll
        for (int j = 0; j < 4; ++j) { xc[j] = *((const u32x2*)(XBr + (size_t)(blk * 64 + F.wave) * DM) + F.lane + 64 * j); xn[j] = xc[j]; }
        for (int r = F.wave; r < 64; r += NWAVES) { const int t = blk * 64 + r;
            if (r + NWAVES < 64) {
#pragma unroll
                for (int j = 0; j < 4; ++j) xn[j] = *((const u32x2*)(XBr + (size_t)(t + NWAVES) * DM) + F.lane + 64 * j); }
            float lg[8];
#pragma unroll
            for (int e = 0; e < 8; ++e) lg[e] = 0.f;
#pragma unroll
            for (int j = 0; j < 4; ++j) { const u32x2 v2 = xc[j]; const f32x4 v = (f32x4){bflo(v2.x), bfhi(v2.x), bflo(v2.y), bfhi(v2.y)};
#pragma unroll
                for (int e = 0; e < 8; ++e) lg[e] += (v[0] * rw[e][j * 4 + 0] + v[1] * rw[e][j * 4 + 1]) + (v[2] * rw[e][j * 4 + 2] + v[3] * rw[e][j * 4 + 3]); }
#pragma unroll
            for (int e = 0; e < 8; ++e) lg[e] = wave_sum(lg[e]);
            if (F.lane == 0) { const float rs = rstd_of(ssq, t);
                int e1 = 0; float v1 = lg[0];
#pragma unroll
                for (int e = 1; e < 8; ++e) if (lg[e] > v1) { v1 = lg[e]; e1 = e; }
                int e2 = -1; float v2 = -INFINITY;
#pragma unroll
                for (int e = 0; e < 8; ++e) if (e != e1 && lg[e] > v2) { v2 = lg[e]; e2 = e; }
                const float w1 = 1.0f / (1.0f + __expf((v2 - v1) * rs)), w2 = 1.0f - w1;
                pe[r * 4 + 0] = e1; pe[r * 4 + 1] = e2; pwt[r * 2 + 0] = w1; pwt[r * 2 + 1] = w2; }
#pragma unroll
            for (int j = 0; j < 4; ++j) xc[j] = xn[j]; }
        __syncthreads();
        if (F.wave == 0) {
            const int r = F.lane, t = blk * 64 + r; const int e1 = pe[r * 4 + 0], e2 = pe[r * 4 + 1]; int p1 = 0, p2 = 0;
            const unsigned long long below = (1ull << r) - 1ull;
#pragma unroll
            for (int e = 0; e < 8; ++e) { const unsigned long long m = __ballot(e1 == e || e2 == e); const int pos = __popcll(m & below);
                if (e1 == e) p1 = pos; if (e2 == e) p2 = pos; if (r == 0) HG[blk * 8 + e] = __popcll(m); }
            TE[t] = e1 | (e2 << 8); TP[2 * t] = p1; TP[2 * t + 1] = p2; TW[2 * t] = pwt[r * 2 + 0]; TW[2 * t + 1] = pwt[r * 2 + 1]; }
        __syncthreads();
    }
}
__device__ __forceinline__ void moe_offsets(const unsigned* cnt, int (&off)[9], int (&cn)[8]) {
    int a = 0;
#pragma unroll
    for (int e = 0; e < 8; ++e) { cn[e] = (int)__hip_atomic_load(cnt + e, RLX_AGENT); off[e] = a; a += (cn[e] + 255) & ~255; }
    off[8] = a;
}
__device__ __forceinline__ void p_gather(Frame& F, unsigned char* ws, const u64* ssq, unsigned* cnt) {
    F.refresh();
    const bf16_t* XB = (const bf16_t*)(ws + WS_XB); bf16_t* HS = (bf16_t*)(ws + R_HS);
    const int* TE = (const int*)(ws + T_TE); const int* TP = (const int*)(ws + T_TP); const float* TW = (const float*)(ws + T_TW); const int* HG = (const int*)(ws + T_HG);
    int* PAIR = (int*)(ws + T_PAIR); float* DGATE = (float*)(ws + T_DGATE); float* DRS = (float*)(ws + T_DRS);
    LAS int* arr = (LAS int*)F.lds; LAS int* bt = arr + 2048;
    const int gw = F.vcu * NWAVES + F.wave, NGW = F.G * NWAVES;
    int off[9], cn[8], bse[8];
#pragma unroll
    for (int e = 0; e < 8; ++e) { off[e] = 0; cn[e] = 0; bse[e] = 0; }
    off[8] = 0;
    for (int blk = F.vcu; blk < NTOK / 64; blk += F.G) {
        __syncthreads();
        { const u32x4 hv = *((const u32x4*)HG + F.tid); *((LAS u32x4*)arr + F.tid) = hv; }
        __syncthreads();
        if (F.wave == 0) {
            int h[4][8], tot[8], inc[8];
#pragma unroll
            for (int k = 0; k < 4; ++k) { const u32x4 a = *((const LAS u32x4*)arr + (4 * F.lane + k) * 2), b = *((const LAS u32x4*)arr + (4 * F.lane + k) * 2 + 1);
                h[k][0] = (int)a.x; h[k][1] = (int)a.y; h[k][2] = (int)a.z; h[k][3] = (int)a.w; h[k][4] = (int)b.x; h[k][5] = (int)b.y; h[k][6] = (int)b.z; h[k][7] = (int)b.w; }
#pragma unroll
            for (int e = 0; e < 8; ++e) { tot[e] = (h[0][e] + h[1][e]) + (h[2][e] + h[3][e]); inc[e] = tot[e]; }
#pragma unroll
            for (int d = 1; d < 64; d <<= 1)
#pragma unroll
                for (int e = 0; e < 8; ++e) { const int v = __shfl_up(inc[e], d); inc[e] += (F.lane >= d) ? v : 0; }
            const int lb = blk >> 2, kb = blk & 3;
            if (F.lane == lb) {
#pragma unroll
                for (int e = 0; e < 8; ++e) { int bs = inc[e] - tot[e];
#pragma unroll
                    for (int k = 0; k < 3; ++k) bs += (k < kb) ? h[k][e] : 0;
                    bt[e] = bs; } }
            if (F.lane == 63) {
#pragma unroll
                for (int e = 0; e < 8; ++e) bt[8 + e] = inc[e]; } }
        __syncthreads();
        { int a = 0;
#pragma unroll
          for (int e = 0; e < 8; ++e) { bse[e] = bt[e]; cn[e] = bt[8 + e]; off[e] = a; a += (cn[e] + 255) & ~255; }
          off[8] = a; }
        if (blk == 0 && F.tid < 8) __hip_atomic_store(cnt + F.tid, (unsigned)bt[8 + F.tid], RLX_AGENT);
#define GT_LOAD(tt, TE_, TP0_, TP1_, TW0_, TW1_, SQ_, A0_, A1_) do { TE_ = TE[tt]; TP0_ = TP[2 * (tt)]; TP1_ = TP[2 * (tt) + 1]; TW0_ = TW[2 * (tt)]; TW1_ = TW[2 * (tt) + 1]; SQ_ = ssq[tt]; \
            A0_ = *((const u32x4*)(XB + (size_t)(tt) * DM) + 2 * F.lane); A1_ = *((const u32x4*)(XB + (size_t)(tt) * DM) + 2 * F.lane + 1); } while (0)
        int te, ten, tp0, tp0n, tp1, tp1n; float tw0, tw0n, tw1, tw1n; u64 sq, sqn; u32x4 a0, a0n, a1, a1n;
        GT_LOAD(blk * 64 + F.wave, te, tp0, tp1, tw0, tw1, sq, a0, a1);
        ten = te; tp0n = tp0; tp1n = tp1; tw0n = tw0; tw1n = tw1; sqn = sq; a0n = a0; a1n = a1;
        for (int r = F.wave; r < 64; r += NWAVES) { const int t = blk * 64 + r;
            if (r + NWAVES < 64) GT_LOAD(t + NWAVES, ten, tp0n, tp1n, tw0n, tw1n, sqn, a0n, a1n);
            const float rs = rstd_raw(sq);
#if MOE_F8
            u32x4 h8; h8.x = pk4_fp8(bflo(a0.x) * F8_HS, bfhi(a0.x) * F8_HS, bflo(a0.y) * F8_HS, bfhi(a0.y) * F8_HS); h8.y = pk4_fp8(bflo(a0.z) * F8_HS, bfhi(a0.z) * F8_HS, bflo(a0.w) * F8_HS, bfhi(a0.w) * F8_HS);
            h8.z = pk4_fp8(bflo(a1.x) * F8_HS, bfhi(a1.x) * F8_HS, bflo(a1.y) * F8_HS, bfhi(a1.y) * F8_HS); h8.w = pk4_fp8(bflo(a1.z) * F8_HS, bfhi(a1.z) * F8_HS, bflo(a1.w) * F8_HS, bfhi(a1.w) * F8_HS);
#endif
#pragma unroll
            for (int k = 0; k < 2; ++k) { const int e = (te >> (8 * k)) & 255; int o = 0;
#pragma unroll
                for (int q = 0; q < 8; ++q) o = (q == e) ? off[q] + bse[q] : o;
                const int dest = o + (k == 0 ? tp0 : tp1);
#if MOE_F8
                *((u32x4*)((unsigned char*)HS + (size_t)dest * DM) + F.lane) = h8;
#else
                *((u32x4*)(HS + (size_t)dest * DM) + 2 * F.lane) = a0; *((u32x4*)(HS + (size_t)dest * DM) + 2 * F.lane + 1) = a1;
#endif
                if (F.lane == 0) { PAIR[2 * t + k] = dest; DGATE[dest] = (k == 0 ? tw0 : tw1); DRS[dest] = rs; } }
            te = ten; tp0 = tp0n; tp1 = tp1n; tw0 = tw0n; tw1 = tw1n; sq = sqn; a0 = a0n; a1 = a1n; }
#undef GT_LOAD
    }
#pragma unroll
    for (int e = 0; e < 8; ++e) { const int lo = off[e] + cn[e], hi = off[e + 1];
        for (int r = lo + gw; r < hi; r += NGW) {
#if MOE_F8
            *((u32x4*)((unsigned char*)HS + (size_t)r * DM) + F.lane) = zero4();
#else
            *((u32x4*)(HS + (size_t)r * DM) + F.lane) = zero4(); *((u32x4*)(HS + (size_t)r * DM) + 64 + F.lane) = zero4();
#endif
            if (F.lane == 0) { DGATE[r] = 0.f; DRS[r] = 0.f; } } }
}
__device__ __forceinline__ void p_combine(Frame& F, unsigned char* ws, float* X, u64* ssq_next, const float* fnorm, bool final_) {
    F.refresh();
    const bf16_t* Y = (const bf16_t*)(ws + R_Y); const bf16_t* Yb = (const bf16_t*)(ws + R_Y1); bf16_t* XB = (bf16_t*)(ws + WS_XB); const int* PAIR = (const int*)(ws + T_PAIR);
    const int gw = F.vcu * NWAVES + F.wave, NGW = F.G * NWAVES;
#define CB_LOAD(tt, P1_, P2_, B_, A1_, A2_) do { const u32x2* xb_ = (const u32x2*)(XB + (size_t)(tt) * DM) + F.lane; \
        const u32x2* y1_ = (const u32x2*)(Y + (size_t)((MOE2_KSPLIT == 1 && (P1_) >= TAIL_M0 * 256) ? 0 : (P1_)) * DM) + F.lane; const u32x2* y2_ = (const u32x2*)(Y + (size_t)((MOE2_KSPLIT == 1 && (P2_) >= TAIL_M0 * 256) ? 0 : (P2_)) * DM) + F.lane; \
        _Pragma("unroll") for (int j = 0; j < 4; ++j) { B_[j] = xb_[64 * j]; A1_[j] = y1_[64 * j]; A2_[j] = y2_[64 * j]; } } while (0)
    u32x2 cb[4], c1[4], c2[4], nb[4], n1[4], n2[4];
#pragma unroll
    for (int j = 0; j < 4; ++j) { cb[j] = (u32x2){0u, 0u}; c1[j] = cb[j]; c2[j] = cb[j]; nb[j] = cb[j]; n1[j] = cb[j]; n2[j] = cb[j]; }
    int p1c = 0, p2c = 0, p1n = 0, p2n = 0;
    if (gw < NTOK) { p1c = PAIR[2 * gw]; p2c = PAIR[2 * gw + 1]; CB_LOAD(gw, p1c, p2c, cb, c1, c2); }
    if (gw + NGW < NTOK) { p1n = PAIR[2 * (gw + NGW)]; p2n = PAIR[2 * (gw + NGW) + 1]; }
    for (int t = gw; t < NTOK; t += NGW) { const int p1 = p1c, p2 = p2c; int p1nn = 0, p2nn = 0;
        if (t + NGW < NTOK) CB_LOAD(t + NGW, p1n, p2n, nb, n1, n2);
        if (t + 2 * NGW < NTOK) { p1nn = PAIR[2 * (t + 2 * NGW)]; p2nn = PAIR[2 * (t + 2 * NGW) + 1]; }
        f32x4* xr = (f32x4*)(X + (size_t)t * DM) + F.lane;
        f32x4 v[4]; float s = 0.f;
        const bool tail1 = MOE2_KSPLIT == 1 && p1 >= TAIL_M0 * 256, tail2 = MOE2_KSPLIT == 1 && p2 >= TAIL_M0 * 256;
        if (MOE2_KSPLIT == 1 && !tail1 && !tail2) {
#pragma unroll
            for (int j = 0; j < 4; ++j) { v[j][0] = (bflo(cb[j].x) + bflo(c1[j].x)) + bflo(c2[j].x); v[j][1] = (bfhi(cb[j].x) + bfhi(c1[j].x)) + bfhi(c2[j].x);
                v[j][2] = (bflo(cb[j].y) + bflo(c1[j].y)) + bflo(c2[j].y); v[j][3] = (bfhi(cb[j].y) + bfhi(c1[j].y)) + bfhi(c2[j].y); }
        } else {
#pragma unroll
        for (int j = 0; j < 4; ++j) { const u32x2 b2 = cb[j]; v[j] = (f32x4){bflo(b2.x), bfhi(b2.x), bflo(b2.y), bfhi(b2.y)}; }
#pragma unroll
        for (int k = 0; k < 2; ++k) { const int p = k == 0 ? p1 : p2;
            if (MOE2_KSPLIT == 1 && p >= TAIL_M0 * 256) {
                for (int ks = 0; ks < TAIL_KS; ++ks) { const u32x2* yp = (const u32x2*)(Yb + ((size_t)ks * TAIL_ROWS + (size_t)(p - TAIL_M0 * 256)) * DM) + F.lane;
#pragma unroll
                    for (int j = 0; j < 4; ++j) { const u32x2 a = yp[64 * j]; v[j][0] += bflo(a.x); v[j][1] += bfhi(a.x); v[j][2] += bflo(a.y); v[j][3] += bfhi(a.y); } }
            } else {
#pragma unroll
                for (int j = 0; j < 4; ++j) { const u32x2 a = k == 0 ? c1[j] : c2[j]; v[j][0] += bflo(a.x); v[j][1] += bfhi(a.x); v[j][2] += bflo(a.y); v[j][3] += bfhi(a.y); }
                if (MOE2_KSPLIT == 2) { const u32x2* y3 = (const u32x2*)(Yb + (size_t)p * DM) + F.lane;
#pragma unroll
                    for (int j = 0; j < 4; ++j) { const u32x2 a = y3[64 * j]; v[j][0] += bflo(a.x); v[j][1] += bfhi(a.x); v[j][2] += bflo(a.y); v[j][3] += bfhi(a.y); } } } }
        }
#pragma unroll
        for (int j = 0; j < 4; ++j) s += (v[j][0] * v[j][0] + v[j][1] * v[j][1]) + (v[j][2] * v[j][2] + v[j][3] * v[j][3]);
        s = wave_sum(s);
        if (!final_) {
#pragma unroll
            for (int j = 0; j < 4; ++j) { u32x2 w; w.x = cvt_pk_bf16(v[j][0], v[j][1]); w.y = cvt_pk_bf16(v[j][2], v[j][3]); *((u32x2*)(XB + (size_t)t * DM) + F.lane + 64 * j) = w; }
            if (F.lane == 0) ssq_next[t] = ssq_fix(s);
        } else { float rs = rsqrtf(s * (1.0f / DM) + EPS);
#ifdef TPROBE
            rs *= 1.0f + __uint_as_float(__hip_atomic_load((const unsigned*)(ws + WS_CTL) + 32, RLX_AGENT));
#endif
#pragma unroll
            for (int j = 0; j < 4; ++j) { const f32x4 g = *((const f32x4*)fnorm + F.lane + 64 * j); xr[64 * j] = v[j] * rs * g; } }
#pragma unroll
        for (int j = 0; j < 4; ++j) { cb[j] = nb[j]; c1[j] = n1[j]; c2[j] = n2[j]; }
        p1c = p1n; p2c = p2n; p1n = p1nn; p2n = p2nn;
    }
}

#undef CB_LOAD
constexpr int NPH = 31;
struct Args { const float* in[28]; float* out; unsigned char* ws; int ph_lo, ph_hi; };
__global__ void __launch_bounds__(NWAVES * 64, 2) mk_fwd(Args args) {
    extern __shared__ __attribute__((aligned(16))) unsigned char lds_raw[];
    Frame F;
    F.lds = (LAS unsigned char*)lds_raw;
    F.refresh();
    F.G = gridDim.x; { const int bx = blockIdx.x; F.vcu = (F.G % 8 == 0) ? (bx % 8) * (F.G / 8) + bx / 8 : bx; }
    unsigned char* ws = args.ws;
    F.ctl = (unsigned*)(ws + WS_CTL);
    volatile LAS unsigned* MISC = (volatile LAS unsigned*)(F.lds + MISC_OFF);
    for (int u = F.tid; u < (LDS_BYTES - LDSCTL_OFF) / 4; u += NWAVES * 64) ((LAS unsigned*)(F.lds + LDSCTL_OFF))[u] = 0u;
    __syncthreads();
    const int lo = args.ph_lo, hi = args.ph_hi;
    XcdBarrier bar = xcd_barrier_post(F.ctl + CW_BAR + lo * XCD_BAR_WORDS, MISC + 8);
#ifndef PH_MASK
#define PH_MASK 0xFFFF
#endif
#define PT(t) (((PH_MASK) >> (t)) & 1)
#ifndef REP_MASK
#define REP_MASK 0
#endif
#define NREP(t) ((((REP_MASK) >> (t)) & 1) ? 2 : 1)
#define REPEAT(t) for (int rep_ = 0; rep_ < NREP(t); ++rep_, (rep_ < NREP(t) ? xcd_barrier(bar) : (void)0))
#define IN(k) (lo <= (k) && (k) < hi)
#define SEAM(k) do { if ((k) + 1 < hi) xcd_barrier(bar); } while (0)
    const float* const* in = args.in;
    float* X = args.out;
    u64* SSQ = (u64*)(ws + WS_SSQ);
    bf16_t* XB = (bf16_t*)(ws + WS_XB);
    const int bx = (int)blockIdx.x;

    if (PT(0) && IN(0)) { asm volatile("; PHASE_MARK 0"); REPEAT(0) p0_prologue(F, in, ws); SEAM(0); }

    for (int lp = 0; lp < 2; ++lp) {
        const int pb = 1 + 15 * lp;
        bf16_t* WE = (bf16_t*)(ws + WS_WE) + (size_t)lp * E_SIZE; bf16_t* WO = (bf16_t*)(ws + WS_WO) + (size_t)lp * O_SIZE;
        u64* ssq0 = SSQ + (size_t)(4 * lp) * NTOK;
        u64* ssql = (u64*)(ws + WS_SSQL) + (size_t)(2 * lp) * NTOK;
        if (PT(1) && IN(pb + 0)) { asm volatile("; PHASE_MARK 1");
            pg8::DenseOrder S; S.init(XB, DM, WE + E_WIN, DM, NTOK, 1024, F.G, bx);
            pg8::EpiZ E{(bf16_t*)(ws + R_Z), 1024, ssq0, ssql, ssql + NTOK, (bf16_t*)(ws + R_K), (const float*)(ws + T_COS), (const float*)(ws + T_SIN)};
            REPEAT(1) pg8::GEMM_BF16(F.lds, pg8::Gemm{DM, DM, DM, 0, 0}, S, E);
            SEAM(pb + 0);
        }
        if (PT(2) && IN(pb + 1)) { asm volatile("; PHASE_MARK 2"); REPEAT(2) p_pooled(F, ws, bx); }
        if (PT(3) && IN(pb + 2)) { asm volatile("; PHASE_MARK 3");
            REPEAT(3) {
            { pg8::DenseOrder S; S.init((const bf16_t*)(ws + R_Z) + 512, 1024, WE + E_WQ, 256, NTOK, 768, F.G, bx);
              pg8::EpiQ E{(bf16_t*)(ws + R_Q), ssql, (const float*)(ws + T_COS), (const float*)(ws + T_SIN)};
              pg8::GEMM_BF16(F.lds, pg8::Gemm{1024, 256, 256, 0, 0}, S, E); }
            { pg8::DenseOrder S; S.init((const bf16_t*)(ws + R_Z) + 768, 1024, WE + E_WKV, 256, NTOK, 1024, F.G, bx);
              pg8::EpiKV E{(bf16_t*)(ws + R_K), (bf16_t*)(ws + R_V), ssql + NTOK};
              pg8::GEMM_BF16(F.lds, pg8::Gemm{1024, 256, 128, 0, 0}, S, E); }
            }
            SEAM(pb + 2);
        }
        if (PT(4) && IN(pb + 3)) { asm volatile("; PHASE_MARK 4");
            const bf16_t* Q = (const bf16_t*)(ws + R_Q); const bf16_t* Kb = (const bf16_t*)(ws + R_K); const bf16_t* Vb = (const bf16_t*)(ws + R_V); bf16_t* MIX = (bf16_t*)(ws + R_MIX);
            int pi0 = F.vcu; asm volatile("" : "+s"(pi0));
            REPEAT(4)
            for (int pi = pi0; pi < 256; pi += F.G) { const int bh = pi >> 3, s = pi & 7, b = bh >> 3, h = bh & 7;
#pragma unroll 1
                for (int k = 0; k < 2; ++k) { const int qb = k == 0 ? (15 - s) : s;
                    attn_unit<96, false>(Q + 96 * h, 768, Kb + 96 * h, 768, Vb + 64 * h, 512, MIX + 512 + 64 * h, 1024, b, qb, F.lds, nullptr); } }
            SEAM(pb + 3);
        }
        if (PT(5) && IN(pb + 4)) { asm volatile("; PHASE_MARK 5");
            pg8::DenseOrder S; S.init((const bf16_t*)(ws + R_MIX), 1024, WE + E_WOUT, 1024, NTOK, 1024, F.G, bx);
            pg8::EpiRes E{lp == 0 ? in[0] : nullptr, XB, ssq0 + NTOK, FFN1_F8 ? (unsigned char*)(ws + WS_XB8) : nullptr};
            pg8::GEMM_BF16(F.lds, pg8::Gemm{1024, 1024, 1024, 0, 0}, S, E);
            SEAM(pb + 4);
        }
        if (PT(6) && IN(pb + 5)) { asm volatile("; PHASE_MARK 6");
            pg8::EpiSwiGLU<0> E{(bf16_t*)(ws + R_ACT), FF, ssq0 + NTOK};
#if FFN1_F8
            pg8::DenseOrder S; S.init(ws + WS_XB8, DM, WE + E_WGU, DM, NTOK, 2 * FF, F.G, bx); S.esz = 1;
            REPEAT(6) pg8::gemm_phase<pg8::EpiSwiGLU<0>, pg8::DenseOrder, true, true>(F.lds, pg8::Gemm{DM, DM, DM, SC_HS, SC_W}, S, E);
#else
            pg8::DenseOrder S; S.init(XB, DM, WE + E_WGU, DM, NTOK, 2 * FF, F.G, bx);
            REPEAT(6) pg8::GEMM_BF16(F.lds, pg8::Gemm{DM, DM, DM, 0, 0}, S, E);
#endif
            SEAM(pb + 5);
        }
        if (PT(7) && IN(pb + 6)) { asm volatile("; PHASE_MARK 7");
            pg8::DenseOrder S; S.init((const bf16_t*)(ws + R_ACT), FF, WE + E_WDN, FF, NTOK, 1024, F.G, bx);
            pg8::EpiRes E{nullptr, XB, ssq0 + 2 * NTOK, nullptr};
            pg8::GEMM_BF16(F.lds, pg8::Gemm{FF, FF, FF, 0, 0}, S, E);
            SEAM(pb + 6);
        }
        if (PT(8) && IN(pb + 7)) { asm volatile("; PHASE_MARK 8");
            pg8::DenseOrder S; S.init(XB, DM, WO + O_WIN, DM, NTOK, 2560, F.G, bx);
            pg8::EpiOddIn E{(bf16_t*)(ws + R_QKV), (bf16_t*)(ws + R_UV), ssq0 + 2 * NTOK};
            REPEAT(8) pg8::GEMM_BF16(F.lds, pg8::Gemm{DM, DM, DM, 0, 0}, S, E);
            SEAM(pb + 7);
        }
        if (PT(9) && IN(pb + 8)) { asm volatile("; PHASE_MARK 9");
            const bf16_t* QKV = (const bf16_t*)(ws + R_QKV); const bf16_t* UV = (const bf16_t*)(ws + R_UV); bf16_t* MIX = (bf16_t*)(ws + R_MIX);
            const float* rb = in[16] + (size_t)lp * 8 * 257;
            int u0 = F.vcu; asm volatile("" : "+s"(u0));
            REPEAT(9)
            for (int u = u0; u < 512; u += F.G) { const int bh = u >> 4, qb = u & 15, b = bh >> 3, h = bh & 7;
                attn_unit<64, true>(QKV + 64 * h, 1536, QKV + 512 + 64 * h, 1536, QKV + 1024 + 64 * h, 1536, MIX + 64 * h, 1024, b, qb, F.lds, rb + h * 257); }
            REPEAT(10)
            for (int u = u0; u < 512; u += F.G) { const int g = u & 3, n = (u >> 2) & 31, b = u >> 7;
                sgu_unit(UV, in[17] + (size_t)lp * 512, in[18] + (size_t)lp * 512, in[19] + (size_t)lp * 4 * 128 * 128, in[20] + (size_t)lp * 512, MIX, b, n, g, F.lds); }
            SEAM(pb + 8);
        }
        if (PT(10) && IN(pb + 9)) { asm volatile("; PHASE_MARK 10");
            pg8::DenseOrder S; S.init((const bf16_t*)(ws + R_MIX), 1024, WO + O_WOUT, 1024, NTOK, 1024, F.G, bx);
            pg8::EpiRes E{nullptr, XB, ssq0 + 3 * NTOK, nullptr};
            pg8::GEMM_BF16(F.lds, pg8::Gemm{1024, 1024, 1024, 0, 0}, S, E);
            SEAM(pb + 9);
        }
        unsigned* cnt = F.ctl + CW_CNT + 64 * lp;
        if (PT(11) && IN(pb + 10)) { asm volatile("; PHASE_MARK 11"); p_route(F, ws, XB, ssq0 + 3 * NTOK, in[22] + (size_t)lp * 1024, in[23] + (size_t)lp * 8192, cnt); SEAM(pb + 10); }
        if (PT(12) && IN(pb + 11)) { asm volatile("; PHASE_MARK 12"); REPEAT(12) p_gather(F, ws, ssq0 + 3 * NTOK, cnt); SEAM(pb + 11); }
        if (PT(13) && IN(pb + 12)) { asm volatile("; PHASE_MARK 13");
            int off[9], cn[8]; moe_offsets(cnt, off, cn);
            pg8::MoeOrder S; S.A = (const char*)(ws + R_HS); S.Bt = (const char*)(WO + O_WGU); S.esz = MOE_F8 ? 1 : 2; S.bstride = (size_t)2 * EFF * 1024 * S.esz; S.lda = 1024; S.ldb = 1024; S.nM = off[8] >> 8; S.nN = 2 * EFF / 256; S.G = F.G; S.c = bx; asm volatile("" : "+s"(S.c)); S.ksplit = 1; S.khalf = 0; S.tailM0 = 1 << 20; S.tail_ks = 1; S.tail_kb = 256;
#pragma unroll
            for (int e = 0; e < 8; ++e) S.tend[e] = off[e + 1] >> 8;
            pg8::EpiSwiGLU<MOE_F8 ? 2 : 1> E{(bf16_t*)(ws + R_ACT2), EFF, (const float*)(ws + T_DRS)};
            REPEAT(13) pg8::gemm_phase<pg8::EpiSwiGLU<MOE_F8 ? 2 : 1>, pg8::MoeOrder, true, MOE_F8 != 0>(F.lds, pg8::Gemm{1024, 1024, 1024, SC_HS, SC_W, lp == 0 ? (float*)(F.ctl + 32) : nullptr}, S, E);
            SEAM(pb + 12);
        }
        if (PT(14) && IN(pb + 13)) { asm volatile("; PHASE_MARK 14");
            int off[9], cn[8]; moe_offsets(cnt, off, cn);
            pg8::MoeOrder S; S.A = (const char*)(ws + R_ACT2); S.Bt = (const char*)(WO + O_WDN); S.esz = MOE_F8 ? 1 : 2; S.bstride = (size_t)1024 * EFF * S.esz; S.lda = EFF; S.ldb = EFF; S.nM = off[8] >> 8; S.nN = 4; S.G = F.G; S.c = bx; asm volatile("" : "+s"(S.c)); S.ksplit = MOE2_KSPLIT; S.khalf = (EFF / 2) * S.esz; S.tailM0 = MOE2_KSPLIT == 1 ? TAIL_M0 : (1 << 20); S.tail_ks = TAIL_KS; S.tail_kb = EFF * S.esz / TAIL_KS;
#pragma unroll
            for (int e = 0; e < 8; ++e) S.tend[e] = off[e + 1] >> 8;
            pg8::EpiY E{(bf16_t*)(ws + R_Y), (const float*)(ws + T_DGATE), (size_t)(R_Y1 - R_Y) / 2, MOE2_KSPLIT == 1 ? (bf16_t*)(ws + R_Y1) : nullptr, TAIL_M0 * 256};
            REPEAT(14) pg8::gemm_phase<pg8::EpiY, pg8::MoeOrder, true, MOE_F8 != 0>(F.lds, pg8::Gemm{EFF, EFF, EFF / MOE2_KSPLIT, SC_ACT, SC_W}, S, E);
            SEAM(pb + 13);
        }
        if (PT(15) && IN(pb + 14)) { asm volatile("; PHASE_MARK 15"); p_combine(F, ws, X, ssq0 + 4 * NTOK, in[27], lp == 1); SEAM(pb + 14); }
    }
#undef IN
#undef SEAM
}

extern "C" void kernel_launch(void* const* d_in, const int* in_sizes, int n_in, void* d_out, int out_size, void* d_ws, size_t ws_size, hipStream_t stream) {
    static int grid = 0;
    if (grid == 0) {
        if (n_in != 28 || in_sizes[0] != NTOK * DM || out_size != NTOK * DM || ws_size < WS_END) { fprintf(stderr, "kernel_launch: unexpected shapes / workspace (%d inputs, ws %zu, need %zu); nothing launched\n", n_in, ws_size, (size_t)WS_END); grid = -1; return; }
        int dev = 0, cus = 0, per_cu = 0;
        if (hipGetDevice(&dev) != hipSuccess || hipDeviceGetAttribute(&cus, hipDeviceAttributeMultiprocessorCount, dev) != hipSuccess) { grid = -1; return; }
        if (hipFuncSetAttribute((const void*)mk_fwd, hipFuncAttributeMaxDynamicSharedMemorySize, LDS_BYTES) != hipSuccess) { fprintf(stderr, "kernel_launch: hipFuncSetAttribute failed\n"); grid = -1; return; }
        if (hipOccupancyMaxActiveBlocksPerMultiprocessor(&per_cu, (const void*)mk_fwd, NWAVES * 64, LDS_BYTES) != hipSuccess || per_cu < 1) fprintf(stderr, "kernel_launch: occupancy query reports %d\n", per_cu);
        (void)hipGetLastError();
        grid = cus;
        if (grid > 256) grid = 256;
        grid &= ~7;
    }
    if (grid <= 0) return;
    if (hipMemsetAsync((char*)d_ws + WS_CTL, 0, CTL_ZERO_BYTES, stream) != hipSuccess) return;
    Args a{};
    for (int i = 0; i < 28; ++i) a.in[i] = (const float*)d_in[i];
    a.out = (float*)d_out; a.ws = (unsigned char*)d_ws;
#if MK_N_LAUNCHES == 1
    a.ph_lo = 0; a.ph_hi = NPH;
    hipLaunchKernelGGL(mk_fwd, dim3(grid), dim3(NWAVES * 64), LDS_BYTES, stream, a);
#else
    for (int p = 0; p < NPH; ++p) { a.ph_lo = p; a.ph_hi = p + 1; hipLaunchKernelGGL(mk_fwd, dim3(grid), dim3(NWAVES * 64), LDS_BYTES, stream, a); }
#endif
}
```

```cpp
#include <hip/hip_runtime.h>
#include <cstdio>
#include <cstdint>

#ifndef MK_N_LAUNCHES
#define MK_N_LAUNCHES 1
#endif

#ifndef TPROBE_OFS
#define TPROBE_OFS 0.0f
#endif
#ifndef TPROBE_BLK
#define TPROBE_BLK 0
#define TPROBE_TID 0
#endif
#ifndef GEMM4
#define GEMM4 0
#endif
#if GEMM4
#define GEMM_BF16 gemm_phase4
#else
#define GEMM_BF16 gemm_phase
#endif
#ifndef MOE_F8
#define MOE_F8 1
#endif
constexpr int MOE2_KSPLIT = MOE_F8 ? 1 : 2;
#ifndef FFN1_F8
#define FFN1_F8 1
#endif
#define LAS __attribute__((address_space(3)))
#define GAS __attribute__((address_space(1)))
typedef unsigned short bf16_t;
typedef short bf16x8 __attribute__((ext_vector_type(8)));
typedef short s16x4 __attribute__((ext_vector_type(4)));
typedef float f32x4 __attribute__((ext_vector_type(4)));
typedef float f32x2 __attribute__((ext_vector_type(2)));
typedef float f32x16 __attribute__((ext_vector_type(16)));
typedef unsigned u32x4 __attribute__((ext_vector_type(4)));
typedef unsigned u32x2 __attribute__((ext_vector_type(2)));

constexpr int NTOK = 16384, DM = 1024, SEQ = 4096;
constexpr float EPS = 1e-6f;
constexpr float LOG2E = 1.4426950408889634f;
constexpr float QS_MLA = 0.10206207261596575f * LOG2E;
constexpr float QS_BAND = 0.125f * LOG2E;
constexpr int FF = 2816, EFF = 3584, NEXP = 8;
constexpr int MOE_ROWS = 34816, TAIL_M0 = 128, TAIL_KS = 7, TAIL_ROWS = MOE_ROWS - TAIL_M0 * 256;
constexpr int MOE_ROWS_ = 34816;

constexpr size_t MiB = 1u << 20, KiB = 1024;
constexpr size_t WS_CTL = 0, CTL_ZERO_BYTES = 3 * MiB;
constexpr int CW_TMO = 0, CW_CNT = 64, CW_BAR = 4096;
constexpr size_t WS_SSQL = 2 * MiB + 256 * KiB;
constexpr size_t WS_SSQ = 1 * MiB;
constexpr size_t WS_TAB = 3 * MiB;
constexpr size_t T_COS = WS_TAB, T_SIN = WS_TAB + 256 * KiB, T_RQ = WS_TAB + 512 * KiB, T_RKV = WS_TAB + 576 * KiB, T_TE = WS_TAB + 640 * KiB,
                 T_TP = WS_TAB + 704 * KiB, T_TW = WS_TAB + 832 * KiB, T_PAIR = WS_TAB + 960 * KiB, T_DGATE = WS_TAB + 1088 * KiB, T_DRS = WS_TAB + 1280 * KiB, T_HG = WS_TAB + 1472 * KiB;
constexpr size_t WS_W = 5 * MiB;
constexpr size_t E_WIN = 0, E_WQ = 1048576, E_WKV = 1245184, E_WOUT = 1507328, E_WGU = 2555904, E_WDN = 8323072, E_SIZE = 11206656;
constexpr size_t O_WIN = 0, O_WOUT = 2621440, O_WGU = 3670016, O_WDN = 62390272, O_SIZE = 91750400;
constexpr size_t WS_WE = WS_W, WS_WO = WS_W + 2 * E_SIZE * 2;
static_assert(WS_WO + 2 * O_SIZE * 2 <= 400 * MiB, "weights");
constexpr size_t WS_XB = 400 * MiB;
constexpr size_t WS_R = 432 * MiB;
constexpr size_t R_Z = WS_R, R_Q = WS_R + 32 * MiB, R_K = WS_R + 56 * MiB, R_V = WS_R + 80 * MiB, R_MIX = WS_R + 96 * MiB, R_ACT = WS_R;
constexpr size_t R_QKV = WS_R, R_UV = WS_R + 48 * MiB, R_HS = WS_R, R_ACT2 = WS_R + 68 * MiB, R_Y = WS_R, R_Y1 = WS_R + 306 * MiB;
constexpr size_t WS_XB8 = WS_R + 374 * MiB;
constexpr size_t WS_END = WS_XB8 + 16 * MiB;
static_assert((size_t)MOE_ROWS * EFF * 2 <= 238 * MiB && (size_t)MOE_ROWS * 1024 * 2 <= 68 * MiB, "moe buffers");

constexpr int RING_BYTES = 131072, LDSCTL_OFF = 135168, MISC_OFF = LDSCTL_OFF + 320, LDS_BYTES = 151552;
constexpr int NWAVES = 8;

#define RLX_AGENT __ATOMIC_RELAXED, __HIP_MEMORY_SCOPE_AGENT
#define LDS_WAIT() asm volatile("s_waitcnt lgkmcnt(0)" ::: "memory")
#define VM_WAIT() asm volatile("s_waitcnt vmcnt(0)" ::: "memory")

typedef __bf16 bf16x2_t __attribute__((ext_vector_type(2)));
__device__ __forceinline__ unsigned cvt_pk_bf16(float lo, float hi) { const f32x2 v = {lo, hi}; const bf16x2_t b = __builtin_convertvector(v, bf16x2_t); return __builtin_bit_cast(unsigned, b); }
__device__ __forceinline__ float bf2f(unsigned short b) { return __uint_as_float(((unsigned)b) << 16); }
__device__ __forceinline__ float bflo(unsigned w) { return __uint_as_float(w << 16); }
__device__ __forceinline__ float bfhi(unsigned w) { return __uint_as_float(w & 0xffff0000u); }
__device__ __forceinline__ unsigned short f2bf(float f) { return (unsigned short)(cvt_pk_bf16(f, 0.f) & 0xffffu); }
__device__ __forceinline__ u32x4 zero4() { unsigned z; asm volatile("v_mov_b32 %0, 0" : "=v"(z)); return (u32x4){z, z, z, z}; }
__device__ __forceinline__ float wave_sum(float v) {
#pragma unroll
    for (int o = 1; o < 64; o <<= 1) v += __shfl_xor(v, o);
    return v;
}
__device__ __forceinline__ float clamp448(float x) { return __builtin_amdgcn_fmed3f(x, -448.0f, 448.0f); }
__device__ __forceinline__ unsigned pk4_fp8(float a, float b, float c, float d) { unsigned w = 0; w = __builtin_amdgcn_cvt_pk_fp8_f32(clamp448(a), clamp448(b), w, false); w = __builtin_amdgcn_cvt_pk_fp8_f32(clamp448(c), clamp448(d), w, true); return w; }
constexpr float F8_WS = 64.0f, F8_HS = 4.0f, F8_ACT = 8.0f;
constexpr int SC_W = 0x79797979, SC_HS = 0x7D7D7D7D, SC_ACT = 0x7C7C7C7C;
#ifndef WT_STORES
#define WT_STORES 1
#endif
struct WtBuf {
    __amdgpu_buffer_rsrc_t r; unsigned char* base;
    __device__ __forceinline__ void init(void* p) { base = (unsigned char*)p; const unsigned long long b = (unsigned long long)p;
        const unsigned lo = (unsigned)__builtin_amdgcn_readfirstlane((int)(unsigned)b), hi = (unsigned)__builtin_amdgcn_readfirstlane((int)(unsigned)(b >> 32));
        r = __builtin_amdgcn_make_buffer_rsrc((void*)(((unsigned long long)hi << 32) | lo), 0, 0x7FFFFFFF, 0x00020000); }
    __device__ __forceinline__ void st16(size_t off, u32x4 v) const {
#if WT_STORES
        __builtin_amdgcn_raw_buffer_store_b128(v, r, (int)(unsigned)off, 0, 16);
#else
        *(u32x4*)(base + off) = v;
#endif
    }
    __device__ __forceinline__ void st8(size_t off, u32x2 v) const {
#if WT_STORES
        __builtin_amdgcn_raw_buffer_store_b64(v, r, (int)(unsigned)off, 0, 16);
#else
        *(u32x2*)(base + off) = v;
#endif
    }
};
typedef unsigned long long u64;
__device__ __forceinline__ u64 ssq_fix(float s) { return (u64)((double)s * 4294967296.0); }
__device__ __forceinline__ float ssq_get(const u64* p, int row) { const u64 v = p[row]; return (float)(unsigned)(v >> 32) + (float)(unsigned)v * (1.0f / 4294967296.0f); }
__device__ __forceinline__ float rstd_raw(u64 v) { const float f = (float)(unsigned)(v >> 32) + (float)(unsigned)v * (1.0f / 4294967296.0f); return rsqrtf(f * (1.0f / DM) + EPS); }
__device__ __forceinline__ float ssq_f32(u64 v) { return (float)(unsigned)(v >> 32) + (float)(unsigned)v * (1.0f / 4294967296.0f); }
__device__ __forceinline__ float rstd_of(const u64* p, int row) { return rsqrtf(ssq_get(p, row) * (1.0f / DM) + EPS); }
__device__ __forceinline__ float fast_exp2(float x) { return __builtin_amdgcn_exp2f(x); }
__device__ __forceinline__ float fast_rcp(float x) { return __builtin_amdgcn_rcpf(x); }
__device__ __forceinline__ float sigmoidf_(float x) { return fast_rcp(1.0f + fast_exp2(-x * LOG2E)); }

__device__ __forceinline__ int opaque_tid() { int t = threadIdx.x; asm volatile("" : "+v"(t)); return t; }

namespace pg8 {
constexpr int BM = 256, BK = 64, HALF = 128, HTB = HALF * BK * 2, STAGE_BYTES = 8 * HTB, NXCD = 8, WGM = 8;
__host__ __device__ __forceinline__ int lds_byte(int r, int c) { const int st = (r >> 4) * 2 + (c >> 5), rr = r & 15, cc = c & 31, ob = rr * 64 + cc * 2; return st * 1024 + (ob ^ (((ob >> 9) & 1) << 5)); }
__host__ __device__ __forceinline__ void stage_rc(int b, int& R, int& C) { const int st = b / 1024, sb = b % 1024, swz = sb ^ (((sb >> 9) & 1) << 5); R = (st >> 1) * 16 + swz / 64; C = (st & 1) * 32 + (swz % 64) / 2; }
__host__ __device__ __forceinline__ int perm32(int rho) { const int n = rho >> 4, i = rho & 15; return 8 * (i >> 2) + 4 * n + (i & 3); }

struct Unit { int pm, pn, kh, nt; const char* a; const char* b; };
struct Gemm { int lda, ldb, K, sA, sB; float* tp = nullptr; };
typedef int i32x8 __attribute__((ext_vector_type(8)));

__device__ __forceinline__ int idiv_small(int a, int d) {
    int q = (int)(((float)a + 0.5f) * __builtin_amdgcn_rcpf((float)d));
    q -= (q * d > a) ? 1 : 0; q += ((q + 1) * d <= a) ? 1 : 0; return q;
}
__device__ __forceinline__ void tile_of(int L, int nM, int nN, int& pm, int& pn) {
    const int nwg = nM * nN;
    int wgid = L; { const int q = nwg >> 3, r = nwg & 7, xcd = wgid & 7, off = wgid >> 3; wgid = (xcd < r ? xcd * (q + 1) : r * (q + 1) + (xcd - r) * q) + off; }
    const int nig = WGM * nN, gid = idiv_small(wgid, nig), rem = wgid - gid * nig, fm = gid * WGM, gsz = (nM - fm) < WGM ? (nM - fm) : WGM;
    const int pq = gsz == WGM ? (rem >> 3) : idiv_small(rem, gsz);
    pm = fm + (rem - pq * gsz); pn = pq;
}
struct DenseOrder {
    const char* A; const char* Bt; int lda, ldb, nM, nN, G, c, esz = 2;
    __device__ __forceinline__ void init(const void* A_, int lda_, const void* Bt_, int ldb_, int M, int N, int G_, int c_) { A = (const char*)A_; Bt = (const char*)Bt_; lda = lda_; ldb = ldb_; nM = M / BM; nN = N / BM; G = G_; c = c_; asm volatile("" : "+s"(c)); }
    __device__ __forceinline__ bool next(int i, Unit& u) const {
        const long L = (long)i * G + c; if (L >= (long)nM * nN) return false;
        tile_of((int)L, nM, nN, u.pm, u.pn); u.kh = 0; u.nt = 0;
        u.a = A + (size_t)u.pm * BM * lda * esz; u.b = Bt + (size_t)u.pn * BM * ldb * esz; return true;
    }
};
struct MoeOrder {
    const char* A; const char* Bt; size_t bstride; int lda, ldb, esz, nM, nN, G, c, ksplit, khalf, tailM0, tail_ks, tail_kb; int tend[8];
    __device__ __forceinline__ bool next(int i, Unit& u) const {
        const long L = (long)i * G + c; const int nMm = nM < tailM0 ? nM : tailM0, nmain = nMm * nN * ksplit, ntail = (nM - nMm) * nN * tail_ks;
        if (L >= (long)(nmain + ntail)) return false;
        size_t koff = 0;
        if (L < nmain) { const int nwg = nMm * nN; const int kh = (L >= nwg) ? 1 : 0; tile_of((int)(L - (long)kh * nwg), nMm, nN, u.pm, u.pn); u.kh = kh; u.nt = 0; koff = (size_t)kh * khalf; }
        else { const int t = (int)L - nmain, ks = t % tail_ks, tu = t / tail_ks; u.pm = nMm + tu / nN; u.pn = tu % nN; u.kh = 1 + ks; u.nt = tail_kb / (BK * 2); koff = (size_t)ks * tail_kb; }
        int e = 0;
#pragma unroll
        for (int k = 0; k < 7; ++k) e += (u.pm >= tend[k]) ? 1 : 0;
        u.a = A + (size_t)u.pm * BM * lda * esz + koff; u.b = Bt + (size_t)e * bstride + (size_t)u.pn * BM * ldb * esz + koff; return true;
    }
};

template <class Epi, class Sched, bool ALIGN_EPI = true, bool F8 = false>
__device__ __forceinline__ void gemm_phase(LAS unsigned char* lds, const Gemm g, const Sched& S, const Epi& E) {
    const int tid = opaque_tid(), wid = __builtin_amdgcn_readfirstlane(tid >> 6), lane = tid & 63, wr = wid >> 2, wc = wid & 3, fr = lane & 15, fq = lane >> 4;
    int K = g.K; asm volatile("" : "+s"(K));
    constexpr int ESZ = F8 ? 1 : 2;
    const int nt_def = K * ESZ / (BK * 2);
    unsigned voffA[2], voffB[2];
#pragma unroll
    for (int i = 0; i < 2; ++i) { int R, C; stage_rc(tid * 16 + i * 8192, R, C); const int Rb = Epi::PERM ? ((R & ~31) + perm32(R & 31)) : R;
        voffA[i] = (unsigned)(R * g.lda * ESZ + C * 2); voffB[i] = (unsigned)(Rb * g.ldb * ESZ + C * 2); }
    const size_t kstep = (size_t)(BK * 2);
    const size_t hstepA = (size_t)HALF * g.lda * ESZ, hstepB = (size_t)HALF * g.ldb * ESZ;
    const unsigned ldsw = (unsigned)wid * 1024u;
    const int aoff = lds_byte(wr * 64 + fr, fq * 8), boff = lds_byte(wc * 32 + fr, fq * 8);
    const int sclA = g.sA, sclB = g.sB;
#define PG8_SA(b, h) (((b) * 2 + (h)) * HTB)
#define PG8_SB(b, h) ((4 + (b) * 2 + (h)) * HTB)
#define PG8_STAGE(bufoff, gbase, voff) do { _Pragma("unroll") for (int _i = 0; _i < 2; ++_i) \
        __builtin_amdgcn_global_load_lds((const unsigned*)((const char*)(gbase) + (voff)[_i]), (LAS unsigned*)(lds + (bufoff) + ldsw + _i * 8192), 16, 0, 0); } while (0)
#define PG8_LD32(p_) ({ const u32x4 lo_ = *(const LAS u32x4*)(p_), hi_ = *(const LAS u32x4*)((p_) + 1024); (i32x8){(int)lo_.x, (int)lo_.y, (int)lo_.z, (int)lo_.w, (int)hi_.x, (int)hi_.y, (int)hi_.z, (int)hi_.w}; })
#define PG8_LDA(dst, b, h) do { if constexpr (F8) { _Pragma("unroll") for (int m = 0; m < 4; ++m) dst##8[m] = PG8_LD32(lds + PG8_SA(b, h) + aoff + m * 2048); } else { _Pragma("unroll") for (int m = 0; m < 4; ++m) _Pragma("unroll") for (int k = 0; k < 2; ++k) dst[m][k] = *(const LAS bf16x8*)(lds + PG8_SA(b, h) + aoff + m * 2048 + k * 1024); } } while (0)
#define PG8_LDB(dst, b, h) do { if constexpr (F8) { _Pragma("unroll") for (int n = 0; n < 2; ++n) dst##8[n] = PG8_LD32(lds + PG8_SB(b, h) + boff + n * 2048); } else { _Pragma("unroll") for (int n = 0; n < 2; ++n) _Pragma("unroll") for (int k = 0; k < 2; ++k) dst[n][k] = *(const LAS bf16x8*)(lds + PG8_SB(b, h) + boff + n * 2048 + k * 1024); } } while (0)
#define PG8_MMA(ai, bj, At, Bt, Z) do { __builtin_amdgcn_s_setprio(1); if constexpr (F8) { \
        if (Z) { _Pragma("unroll") for (int m = 0; m < 4; ++m) _Pragma("unroll") for (int n = 0; n < 2; ++n) \
            asm volatile("v_mfma_scale_f32_16x16x128_f8f6f4 %0, %1, %2, 0, %3, %4 op_sel_hi:[0,0,0]" : "=v"(acc[ai][bj][m][n]) : "v"(Bt##8[n]), "v"(At##8[m]), "v"(sclB), "v"(sclA)); } \
        else { _Pragma("unroll") for (int m = 0; m < 4; ++m) _Pragma("unroll") for (int n = 0; n < 2; ++n) \
            asm volatile("v_mfma_scale_f32_16x16x128_f8f6f4 %0, %1, %2, %0, %3, %4 op_sel_hi:[0,0,0]" : "+v"(acc[ai][bj][m][n]) : "v"(Bt##8[n]), "v"(At##8[m]), "v"(sclB), "v"(sclA)); } \
        } else { \
        _Pragma("unroll") for (int m = 0; m < 4; ++m) _Pragma("unroll") for (int n = 0; n < 2; ++n) _Pragma("unroll") for (int k = 0; k < 2; ++k) \
            acc[ai][bj][m][n] = __builtin_amdgcn_mfma_f32_16x16x32_bf16(Bt[n][k], At[m][k], acc[ai][bj][m][n], 0, 0, 0); } __builtin_amdgcn_s_setprio(0); } while (0)
#define PG8_WAIT_V(n) asm volatile("s_waitcnt vmcnt(" #n ")" ::: "memory")
#define PG8_WAIT_L(n) asm volatile("s_waitcnt lgkmcnt(" #n ")" ::: "memory")
#define PG8_BAR __builtin_amdgcn_s_barrier()
#define PG8_SCHED __builtin_amdgcn_sched_barrier(0)
    Unit cur, nxt; int ui = 0;
    if (!S.next(0, cur)) return;
    float ers[8]; int epm = -1;
#pragma unroll
    for (int q = 0; q < 8; ++q) ers[q] = 0.f;
#ifdef TPROBE
    unsigned long long tp_s1 = 0, tp_s2 = 0, tp_s3 = 0, tp_s4 = 0, tp_t0 = __builtin_amdgcn_s_memtime(), tp_e = tp_t0;
#endif
    f32x4 acc[2][2][4][2];
    if constexpr (!F8) {
#pragma unroll
    for (int a = 0; a < 2; ++a)
#pragma unroll
        for (int b = 0; b < 2; ++b)
#pragma unroll
            for (int m = 0; m < 4; ++m)
#pragma unroll
                for (int n = 0; n < 2; ++n) acc[a][b][m][n] = (f32x4){0.f, 0.f, 0.f, 0.f};
    }
    bf16x8 At[4][2], B0[2][2], B1[2][2]; i32x8 At8[4], B08[2], B18[2];
    const char* cA = cur.a; const char* cB = cur.b;
    PG8_STAGE(PG8_SB(0, 0), cB, voffB); PG8_STAGE(PG8_SB(0, 1), cB + hstepB, voffB); PG8_STAGE(PG8_SA(0, 0), cA, voffA); PG8_STAGE(PG8_SA(0, 1), cA + hstepA, voffA);
    if (wr == 1) PG8_BAR;
    PG8_WAIT_V(2); PG8_BAR;
    PG8_STAGE(PG8_SB(1, 0), cB + kstep, voffB); PG8_STAGE(PG8_SA(1, 0), cA + kstep, voffA); PG8_STAGE(PG8_SB(1, 1), cB + hstepB + kstep, voffB);
    PG8_WAIT_V(6); PG8_BAR;
    for (;;) {
        const bool has_next = S.next(ui + 1, nxt);
        const char* nA = has_next ? nxt.a : cA; const char* nB = has_next ? nxt.b : cB;
        const int nt = cur.nt ? cur.nt : nt_def;
        if constexpr (Epi::HASPRE) { if constexpr (Epi::PRE_EARLY) { if (cur.pm != epm) { int fr_ = fr; asm volatile("" : "+v"(fr_)); E.pre(cur, wr, fr_, ers); epm = cur.pm; } } }
        for (int t = 0; t < nt; t += 2) {
            const bool last = (t == nt - 2), z0 = (t == 0);
            const char* a1 = cA + (size_t)(t + 1) * kstep;
            const char* a2 = last ? nA : cA + (size_t)(t + 2) * kstep; const char* b2 = last ? nB : cB + (size_t)(t + 2) * kstep;
            const char* a3 = a2 + kstep; const char* b3 = b2 + kstep;
            PG8_LDB(B0, 0, 0); PG8_LDB(B1, 0, 1); PG8_SCHED; PG8_LDA(At, 0, 0); PG8_STAGE(PG8_SA(1, 1), a1 + hstepA, voffA);
            PG8_WAIT_V(8); PG8_WAIT_L(0); PG8_BAR; PG8_MMA(0, 0, At, B0, z0); PG8_MMA(0, 1, At, B1, z0); PG8_BAR; PG8_SCHED;
            PG8_LDA(At, 0, 1); PG8_STAGE(PG8_SB(0, 0), b2, voffB); PG8_STAGE(PG8_SB(0, 1), b2 + hstepB, voffB); PG8_STAGE(PG8_SA(0, 0), a2, voffA);
            PG8_WAIT_V(8); PG8_WAIT_L(0); PG8_BAR; PG8_MMA(1, 0, At, B0, z0); PG8_MMA(1, 1, At, B1, z0); PG8_BAR; PG8_SCHED;
            PG8_LDB(B0, 1, 0); PG8_LDB(B1, 1, 1); PG8_SCHED; PG8_LDA(At, 1, 0); PG8_STAGE(PG8_SA(0, 1), a2 + hstepA, voffA);
            PG8_WAIT_V(8); PG8_WAIT_L(0); PG8_BAR; PG8_MMA(0, 0, At, B0, false); PG8_MMA(0, 1, At, B1, false); PG8_BAR; PG8_SCHED;
            PG8_LDA(At, 1, 1); PG8_STAGE(PG8_SB(1, 0), b3, voffB); PG8_STAGE(PG8_SB(1, 1), b3 + hstepB, voffB); PG8_STAGE(PG8_SA(1, 0), a3, voffA);
            PG8_WAIT_V(8); PG8_WAIT_L(0); PG8_BAR; PG8_MMA(1, 0, At, B0, false); PG8_MMA(1, 1, At, B1, false); PG8_BAR; PG8_SCHED;
        }
#ifdef TPROBE
        const unsigned long long tp_a = __builtin_amdgcn_s_memtime(); tp_s3 += tp_a - tp_e;
#endif
        if constexpr (F8) asm volatile("s_nop 15\n\ts_nop 7" ::: "memory");
        if constexpr (ALIGN_EPI) { if (wr == 0) PG8_BAR; }
#ifdef TPROBE
        const unsigned long long tp_b = __builtin_amdgcn_s_memtime(); tp_s1 += tp_b - tp_a;
#endif
        { int fr_ = fr, fq_ = fq; asm volatile("" : "+v"(fr_), "+v"(fq_));
          if constexpr (Epi::HASPRE) { if constexpr (!Epi::PRE_EARLY) { if (cur.pm != epm) { E.pre(cur, wr, fr_, ers); epm = cur.pm; } } E(acc, cur, wr, wc, fr_, fq_, ers); } else E(acc, cur, wr, wc, fr_, fq_);
#ifdef EPI_REP
          if constexpr (Epi::PROBE2) { asm volatile("" : "+v"(fr_), "+v"(fq_)); E(acc, cur, wr, wc, fr_, fq_); }
#endif
        }
#ifdef TPROBE
        { asm volatile("s_waitcnt vmcnt(0)" ::: "memory"); const unsigned long long tp_c = __builtin_amdgcn_s_memtime(); tp_s2 += tp_c - tp_b; tp_e = tp_c; }
#endif
        if (!has_next) break;
        if constexpr (!F8) {
#pragma unroll
        for (int a = 0; a < 2; ++a)
#pragma unroll
            for (int b = 0; b < 2; ++b)
#pragma unroll
                for (int m = 0; m < 4; ++m)
#pragma unroll
                    for (int n = 0; n < 2; ++n) acc[a][b][m][n] = (f32x4){0.f, 0.f, 0.f, 0.f};
        }
        cur = nxt; cA = nA; cB = nB; ++ui;
        if constexpr (ALIGN_EPI) { if (wr == 1) PG8_BAR; }
    }
    PG8_WAIT_V(0);
    if constexpr (!ALIGN_EPI) { if (wr == 0) PG8_BAR; }
    PG8_BAR;
#ifdef TPROBE
    if (g.tp && blockIdx.x == TPROBE_BLK && tid == TPROBE_TID) { const unsigned long long tt = __builtin_amdgcn_s_memtime() - tp_t0; const unsigned long long sel = TPROBE == 1 ? tp_s1 : TPROBE == 2 ? tp_s2 : tp_s3; const float f_ = (float)((double)sel / (double)tt); *g.tp = 0.02f * rintf(f_ * 20.0f + TPROBE_OFS); }
#endif
#undef PG8_SA
#undef PG8_SB
#undef PG8_STAGE
#undef PG8_LDA
#undef PG8_LD32
#undef PG8_LDB
#undef PG8_MMA
#undef PG8_WAIT_V
#undef PG8_WAIT_L
#undef PG8_BAR
#undef PG8_SCHED
}


__host__ __device__ __forceinline__ int lds_byte32(int r, int c) { const int rr = r & 15, ob = rr * 64 + c * 2; return (r >> 4) * 1024 + (ob ^ (((ob >> 9) & 1) << 5)); }
__host__ __device__ __forceinline__ void stage_rc32(int b, int& R, int& C) { const int st = b / 1024, sb = b % 1024, swz = sb ^ (((sb >> 9) & 1) << 5); R = st * 16 + swz / 64; C = (swz % 64) / 2; }
template <class Epi, class Sched>
__device__ __forceinline__ void gemm_phase4(LAS unsigned char* lds, const Gemm g, const Sched& S, const Epi& E) {
    const int tid = opaque_tid(), wid = __builtin_amdgcn_readfirstlane(tid >> 6), lane = tid & 63, wr = wid >> 2, wc = wid & 3, fr = lane & 15, fq = lane >> 4;
    int K = g.K; asm volatile("" : "+s"(K));
    const int nt = K / 32;
    constexpr int HT = 8192;
    unsigned voffA, voffB;
    { int R, C; stage_rc32(tid * 16, R, C); const int Rb = Epi::PERM ? ((R & ~31) + perm32(R & 31)) : R; voffA = (unsigned)(R * g.lda + C) * 2u; voffB = (unsigned)(Rb * g.ldb + C) * 2u; }
    const size_t kstep = 64, hstepA = (size_t)HALF * g.lda * 2, hstepB = (size_t)HALF * g.ldb * 2;
    const unsigned ldsw = (unsigned)wid * 1024u;
    const int aoff = lds_byte32(wr * 64 + fr, fq * 8), boff = lds_byte32(wc * 32 + fr, fq * 8);
#define G4_SA(s, h) ((((s) & 3) * 2 + (h)) * HT)
#define G4_SB(s, h) ((8 + ((s) & 3) * 2 + (h)) * HT)
#define G4_STAGE(bufoff, gptr, voff) __builtin_amdgcn_global_load_lds((const unsigned*)((const char*)(gptr) + (voff)), (LAS unsigned*)(lds + (bufoff) + ldsw), 16, 0, 0)
#define G4_LDA(s, h) do { _Pragma("unroll") for (int m = 0; m < 4; ++m) At[m] = *(const LAS bf16x8*)(lds + G4_SA(s, h) + aoff + m * 1024); } while (0)
#define G4_LDB(dst, s, h) do { _Pragma("unroll") for (int n = 0; n < 2; ++n) dst[n] = *(const LAS bf16x8*)(lds + G4_SB(s, h) + boff + n * 1024); } while (0)
#define G4_MMA(ai, bj, Bt) do { __builtin_amdgcn_s_setprio(1); _Pragma("unroll") for (int m = 0; m < 4; ++m) _Pragma("unroll") for (int n = 0; n < 2; ++n) \
        acc[ai][bj][m][n] = __builtin_amdgcn_mfma_f32_16x16x32_bf16(Bt[n], At[m], acc[ai][bj][m][n], 0, 0, 0); __builtin_amdgcn_s_setprio(0); } while (0)
#define G4_WAIT_V(n) asm volatile("s_waitcnt vmcnt(" #n ")" ::: "memory")
#define G4_WAIT_L0 asm volatile("s_waitcnt lgkmcnt(0)" ::: "memory")
#define G4_BAR __builtin_amdgcn_s_barrier()
#define G4_SCHED __builtin_amdgcn_sched_barrier(0)
#define G4_PA(tt) ((tt) < nt ? cA + (size_t)(tt) * kstep : nA + (size_t)((tt) - nt) * kstep)
#define G4_PB(tt) ((tt) < nt ? cB + (size_t)(tt) * kstep : nB + (size_t)((tt) - nt) * kstep)
#define G4_TILE(t_, s) do { \
        G4_LDB(B0, s, 0); G4_LDB(B1, s, 1); G4_SCHED; G4_LDA(s, 0); { const char* pa_ = G4_PA((t_) + 3); G4_STAGE(G4_SA((s) + 3, 1), pa_ + hstepA, voffA); } \
        G4_WAIT_V(12); G4_WAIT_L0; G4_BAR; G4_MMA(0, 0, B0); G4_MMA(0, 1, B1); G4_BAR; G4_SCHED; \
        G4_LDA(s, 1); { const char* pb_ = G4_PB((t_) + 4); const char* pa_ = G4_PA((t_) + 4); G4_STAGE(G4_SB(s, 0), pb_, voffB); G4_STAGE(G4_SB(s, 1), pb_ + hstepB, voffB); G4_STAGE(G4_SA(s, 0), pa_, voffA); } \
        G4_WAIT_V(12); G4_WAIT_L0; G4_BAR; G4_MMA(1, 0, B0); G4_MMA(1, 1, B1); G4_BAR; G4_SCHED; } while (0)
    Unit cur, nxt; int ui = 0;
    if (!S.next(0, cur)) return;
    f32x4 acc[2][2][4][2];
#pragma unroll
    for (int a = 0; a < 2; ++a)
#pragma unroll
        for (int b = 0; b < 2; ++b)
#pragma unroll
            for (int m = 0; m < 4; ++m)
#pragma unroll
                for (int n = 0; n < 2; ++n) { float z_; asm volatile("v_mov_b32 %0, 0" : "=v"(z_)); acc[a][b][m][n] = (f32x4){z_, z_, z_, z_}; }
    bf16x8 At[4], B0[2], B1[2];
    const char* cA = cur.a; const char* cB = cur.b;
    G4_STAGE(G4_SB(0, 0), cB, voffB); G4_STAGE(G4_SB(0, 1), cB + hstepB, voffB); G4_STAGE(G4_SA(0, 0), cA, voffA); G4_STAGE(G4_SA(0, 1), cA + hstepA, voffA);
    if (wr == 1) G4_BAR;
    G4_WAIT_V(1); G4_BAR;
    G4_STAGE(G4_SB(1, 0), cB + kstep, voffB); G4_STAGE(G4_SB(1, 1), cB + kstep + hstepB, voffB); G4_STAGE(G4_SA(1, 0), cA + kstep, voffA); G4_STAGE(G4_SA(1, 1), cA + kstep + hstepA, voffA);
    G4_STAGE(G4_SB(2, 0), cB + 2 * kstep, voffB); G4_STAGE(G4_SB(2, 1), cB + 2 * kstep + hstepB, voffB); G4_STAGE(G4_SA(2, 0), cA + 2 * kstep, voffA); G4_STAGE(G4_SA(2, 1), cA + 2 * kstep + hstepA, voffA);
    G4_STAGE(G4_SB(3, 0), cB + 3 * kstep, voffB); G4_STAGE(G4_SB(3, 1), cB + 3 * kstep + hstepB, voffB); G4_STAGE(G4_SA(3, 0), cA + 3 * kstep, voffA);
    G4_WAIT_V(12); G4_BAR;
    for (;;) {
        const bool has_next = S.next(ui + 1, nxt);
        const char* nA = has_next ? nxt.a : cA; const char* nB = has_next ? nxt.b : cB;
        for (int t = 0; t < nt; t += 4) { G4_TILE(t, 0); G4_TILE(t + 1, 1); G4_TILE(t + 2, 2); G4_TILE(t + 3, 3); }
        if (wr == 0) G4_BAR;
        { int fr_ = fr, fq_ = fq; asm volatile("" : "+v"(fr_), "+v"(fq_)); if constexpr (Epi::HASPRE) { float ers_[8]; E.pre(cur, wr, fr_, ers_); E(acc, cur, wr, wc, fr_, fq_, ers_); } else E(acc, cur, wr, wc, fr_, fq_); }
        if (!has_next) break;
#pragma unroll
        for (int a = 0; a < 2; ++a)
#pragma unroll
            for (int b = 0; b < 2; ++b)
#pragma unroll
                for (int m = 0; m < 4; ++m)
#pragma unroll
                    for (int n = 0; n < 2; ++n) { float z_; asm volatile("v_mov_b32 %0, 0" : "=v"(z_)); acc[a][b][m][n] = (f32x4){z_, z_, z_, z_}; }
        cur = nxt; cA = nA; cB = nB; ++ui;
        if (wr == 1) G4_BAR;
    }
    G4_WAIT_V(0);
    G4_BAR;
#undef G4_SA
#undef G4_SB
#undef G4_STAGE
#undef G4_LDA
#undef G4_LDB
#undef G4_MMA
#undef G4_WAIT_V
#undef G4_WAIT_L0
#undef G4_BAR
#undef G4_SCHED
#undef G4_PA
#undef G4_PB
#undef G4_TILE
}

typedef f32x4 Acc[2][2][4][2];

struct EpiZ { static constexpr bool PERM = true, PROBE2 = false, HASPRE = false;
    bf16_t* O; int ldc; const u64* ssq; u64* sq_q; u64* sq_kv; bf16_t* Kb; const float* cosT; const float* sinT;
    static __device__ __forceinline__ float sq8(const u32x4& w) { return (bflo(w.x) * bflo(w.x) + bfhi(w.x) * bfhi(w.x)) + (bflo(w.y) * bflo(w.y) + bfhi(w.y) * bfhi(w.y)) + (bflo(w.z) * bflo(w.z) + bfhi(w.z) * bfhi(w.z)) + (bflo(w.w) * bflo(w.w) + bfhi(w.w) * bfhi(w.w)); }
    __device__ __forceinline__ void operator()(const Acc& acc, const Unit& u, int wr, int wc, int fr, int fq) const {
        const int row0 = u.pm * BM + wr * 64 + fr, col0 = u.pn * BM + wc * 32 + 8 * fq;
        WtBuf ob; ob.init(O);
        u64 raw[8];
#pragma unroll
        for (int q = 0; q < 8; ++q) raw[q] = ssq[row0 + (q >> 2) * HALF + (q & 3) * 16];
#pragma unroll
        for (int ai = 0; ai < 2; ++ai)
#pragma unroll
            for (int m = 0; m < 4; ++m) { const int row = row0 + ai * HALF + m * 16; const float rs = rstd_raw(raw[ai * 4 + m]);
                const size_t ro = ((size_t)row * ldc + col0) * 2;
                u32x4 wv[2];
#pragma unroll
                for (int bj = 0; bj < 2; ++bj) { const f32x4 v0 = acc[ai][bj][m][0] * rs, v1 = acc[ai][bj][m][1] * rs;
                    u32x4 w; w.x = cvt_pk_bf16(v0[0], v0[1]); w.y = cvt_pk_bf16(v0[2], v0[3]); w.z = cvt_pk_bf16(v1[0], v1[1]); w.w = cvt_pk_bf16(v1[2], v1[3]);
                    ob.st16(ro + bj * HALF * 2, w); wv[bj] = w; }
                if (u.pn >= 2) {
                    float s = sq8(wv[0]); if (u.pn == 2) s += sq8(wv[1]);
                    s += __shfl_xor(s, 16); s += __shfl_xor(s, 32);
                    if (fq == 0) __hip_atomic_fetch_add((u.pn == 2 ? sq_q : sq_kv) + row, ssq_fix(s), RLX_AGENT);
                    if (u.pn == 3 && wc == 0) {
                        const u32x4 w = wv[1]; u32x4 pw; pw.x = __shfl_xor(w.x, 32); pw.y = __shfl_xor(w.y, 32); pw.z = __shfl_xor(w.z, 32); pw.w = __shfl_xor(w.w, 32);
                        const int pos = row & (SEQ - 1), jj = 8 * (fq & 1); const float sg = fq < 2 ? -1.0f : 1.0f;
                        const f32x4 c0 = *(const f32x4*)(cosT + pos * 16 + jj), c1 = *(const f32x4*)(cosT + pos * 16 + jj + 4);
                        const f32x4 s0 = *(const f32x4*)(sinT + pos * 16 + jj) * sg, s1 = *(const f32x4*)(sinT + pos * 16 + jj + 4) * sg;
                        u32x4 o;
                        o.x = cvt_pk_bf16(bflo(w.x) * c0[0] + bflo(pw.x) * s0[0], bfhi(w.x) * c0[1] + bfhi(pw.x) * s0[1]);
                        o.y = cvt_pk_bf16(bflo(w.y) * c0[2] + bflo(pw.y) * s0[2], bfhi(w.y) * c0[3] + bfhi(pw.y) * s0[3]);
                        o.z = cvt_pk_bf16(bflo(w.z) * c1[0] + bflo(pw.z) * s1[0], bfhi(w.z) * c1[1] + bfhi(pw.z) * s1[1]);
                        o.w = cvt_pk_bf16(bflo(w.w) * c1[2] + bflo(pw.w) * s1[2], bfhi(w.w) * c1[3] + bfhi(pw.w) * s1[3]);
                        bf16_t* kr = Kb + (size_t)row * 768 + 64 + 8 * fq;
#pragma unroll
                        for (int h = 0; h < 8; ++h) *(u32x4*)(kr + 96 * h) = o; } } }
    }
};
struct EpiQ { static constexpr bool PERM = false, PROBE2 = false, HASPRE = false;
    bf16_t* O; const u64* rq; const float* cosT; const float* sinT;
    __device__ __forceinline__ void operator()(const Acc& acc, const Unit& u, int wr, int wc, int fr, int fq) const {
        const int row0 = u.pm * BM + wr * 64 + fr;
        float rsv[8];
#pragma unroll
        for (int q = 0; q < 8; ++q) rsv[q] = rsqrtf(ssq_f32(rq[row0 + (q >> 2) * HALF + (q & 3) * 16]) * (1.0f / 256.0f) + EPS);
#pragma unroll
        for (int ai = 0; ai < 2; ++ai)
#pragma unroll
            for (int m = 0; m < 4; ++m) { const int row = row0 + ai * HALF + m * 16; const float rs = rsv[ai * 4 + m] * QS_MLA; const int pos = row & (SEQ - 1);
                const f32x4 cs = *(const f32x4*)(cosT + pos * 16 + 4 * fq), sn = *(const f32x4*)(sinT + pos * 16 + 4 * fq);
#pragma unroll
                for (int bj = 0; bj < 2; ++bj) { const int cb = u.pn * BM + bj * HALF + wc * 32; const bool rope = ((cb >> 5) % 3) == 2;
                    f32x4 v0 = acc[ai][bj][m][0] * rs, v1 = acc[ai][bj][m][1] * rs;
                    if (rope) { const f32x4 o0 = v0 * cs - v1 * sn, o1 = v1 * cs + v0 * sn; v0 = o0; v1 = o1; }
                    u32x2 w0, w1; w0.x = cvt_pk_bf16(v0[0], v0[1]); w0.y = cvt_pk_bf16(v0[2], v0[3]); w1.x = cvt_pk_bf16(v1[0], v1[1]); w1.y = cvt_pk_bf16(v1[2], v1[3]);
                    bf16_t* p = O + (size_t)row * 768 + cb + 4 * fq;
                    *(u32x2*)(p) = w0; *(u32x2*)(p + 16) = w1; } }
    }
};
struct EpiKV { static constexpr bool PERM = true, PROBE2 = false, HASPRE = false;
    bf16_t* Kb; bf16_t* Vb; const u64* rkv;
    __device__ __forceinline__ void operator()(const Acc& acc, const Unit& u, int wr, int wc, int fr, int fq) const {
        const int row0 = u.pm * BM + wr * 64 + fr;
        float rsv[8];
#pragma unroll
        for (int q = 0; q < 8; ++q) rsv[q] = rsqrtf(ssq_f32(rkv[row0 + (q >> 2) * HALF + (q & 3) * 16]) * (1.0f / 128.0f) + EPS);
#pragma unroll
        for (int ai = 0; ai < 2; ++ai)
#pragma unroll
            for (int m = 0; m < 4; ++m) { const int row = row0 + ai * HALF + m * 16; const float rs = rsv[ai * 4 + m];
#pragma unroll
                for (int bj = 0; bj < 2; ++bj) { const int h = 2 * u.pn + bj; const f32x4 v0 = acc[ai][bj][m][0] * rs, v1 = acc[ai][bj][m][1] * rs;
                    u32x4 w; w.x = cvt_pk_bf16(v0[0], v0[1]); w.y = cvt_pk_bf16(v0[2], v0[3]); w.z = cvt_pk_bf16(v1[0], v1[1]); w.w = cvt_pk_bf16(v1[2], v1[3]);
                    bf16_t* p = (wc < 2) ? (Kb + (size_t)row * 768 + 96 * h + 32 * wc + 8 * fq) : (Vb + (size_t)row * 512 + 64 * h + 32 * (wc - 2) + 8 * fq);
                    *(u32x4*)p = w; } }
    }
};
struct EpiRes { static constexpr bool PERM = false, PROBE2 = false, HASPRE = false;
    const float* base32; bf16_t* XB; u64* ssq_next; unsigned char* X8;
    __device__ __forceinline__ void finish(const f32x4 (&o)[2][2], int row, size_t off, int fq) const {
        f32x2 s2 = (f32x2){0.f, 0.f};
#pragma unroll
        for (int bj = 0; bj < 2; ++bj)
#pragma unroll
            for (int n = 0; n < 2; ++n) { const f32x4 v = o[bj][n]; const f32x2 va = (f32x2){v[0], v[1]}, vb = (f32x2){v[2], v[3]}; s2 = va * va + s2; s2 = vb * vb + s2;
                u32x2 w; w.x = cvt_pk_bf16(v[0], v[1]); w.y = cvt_pk_bf16(v[2], v[3]); *(u32x2*)(XB + off + bj * HALF + n * 16) = w;
                if (X8) { const f32x2 qa = va * F8_HS, qb = vb * F8_HS; *(unsigned*)(X8 + off + bj * HALF + n * 16) = pk4_fp8(qa.x, qa.y, qb.x, qb.y); } }
        float s = s2.x + s2.y;
        s += __shfl_xor(s, 16); s += __shfl_xor(s, 32);
        if (fq == 0) __hip_atomic_fetch_add(ssq_next + row, ssq_fix(s), RLX_AGENT);
    }
    __device__ __forceinline__ void operator()(const Acc& acc, const Unit& u, int wr, int wc, int fr, int fq) const {
        const int row0 = u.pm * BM + wr * 64 + fr, col0 = u.pn * BM + wc * 32 + 4 * fq;
        if (base32) {
#pragma unroll
            for (int ai = 0; ai < 2; ++ai)
#pragma unroll
                for (int mp = 0; mp < 2; ++mp) { f32x4 bs[2][2][2];
#pragma unroll
                    for (int mm = 0; mm < 2; ++mm) { const size_t off = (size_t)(row0 + ai * HALF + (2 * mp + mm) * 16) * DM + col0;
#pragma unroll
                        for (int bj = 0; bj < 2; ++bj)
#pragma unroll
                            for (int n = 0; n < 2; ++n) bs[mm][bj][n] = *(const f32x4*)(base32 + off + bj * HALF + n * 16); }
#pragma unroll
                    for (int mm = 0; mm < 2; ++mm) { const int m = 2 * mp + mm; const int row = row0 + ai * HALF + m * 16; f32x4 o[2][2];
#pragma unroll
                        for (int bj = 0; bj < 2; ++bj)
#pragma unroll
                            for (int n = 0; n < 2; ++n) o[bj][n] = bs[mm][bj][n] + acc[ai][bj][m][n];
                        finish(o, row, (size_t)row * DM + col0, fq); }
                    asm volatile("" ::: "memory"); }
        } else {
#pragma unroll
            for (int ai = 0; ai < 2; ++ai) { u32x2 raw[4][2][2];
#pragma unroll
                for (int m = 0; m < 4; ++m) { const size_t off = (size_t)(row0 + ai * HALF + m * 16) * DM + col0;
#pragma unroll
                    for (int bj = 0; bj < 2; ++bj)
#pragma unroll
                        for (int n = 0; n < 2; ++n) raw[m][bj][n] = *(const u32x2*)(XB + off + bj * HALF + n * 16); }
#pragma unroll
                for (int m = 0; m < 4; ++m) { const int row = row0 + ai * HALF + m * 16; f32x4 o[2][2];
#pragma unroll
                    for (int bj = 0; bj < 2; ++bj)
#pragma unroll
                        for (int n = 0; n < 2; ++n) { const u32x2 b2 = raw[m][bj][n]; o[bj][n] = (f32x4){bflo(b2.x), bfhi(b2.x), bflo(b2.y), bfhi(b2.y)} + acc[ai][bj][m][n]; }
                    finish(o, row, (size_t)row * DM + col0, fq); }
                asm volatile("" ::: "memory"); }
        }
    }
};
template <int MODE> struct EpiSwiGLU { static constexpr bool PERM = true, PROBE2 = false, HASPRE = true, PRE_EARLY = (MODE == 1 || MODE == 2);
    bf16_t* O; int ldc; const void* rsrc;
    __device__ __forceinline__ void pre(const Unit& u, int wr, int fr, float (&rsv)[8]) const {
        const int row0 = u.pm * BM + wr * 64 + fr;
        if (MODE == 0 || MODE == 3) { u64 raw[8];
#pragma unroll
            for (int q = 0; q < 8; ++q) raw[q] = ((const u64*)rsrc)[row0 + (q >> 2) * HALF + (q & 3) * 16];
#pragma unroll
            for (int q = 0; q < 8; ++q) rsv[q] = rstd_raw(raw[q]);
        } else {
#pragma unroll
            for (int q = 0; q < 8; ++q) rsv[q] = ((const float*)rsrc)[row0 + (q >> 2) * HALF + (q & 3) * 16]; }
    }
    __device__ __forceinline__ void operator()(const Acc& acc, const Unit& u, int wr, int wc, int fr, int fq, const float (&rsv)[8]) const {
        const int row0 = u.pm * BM + wr * 64 + fr, col0 = u.pn * HALF + wc * 32 + 8 * fq;
        WtBuf ob; ob.init(O);
#pragma unroll
        for (int ai = 0; ai < 2; ++ai)
#pragma unroll
            for (int m = 0; m < 4; ++m) { const int row = row0 + ai * HALF + m * 16; const float rs = rsv[ai * 4 + m];
                float o[8];
                const float rsu = rs * (MODE == 2 ? F8_ACT : 1.0f), rsl = rs * (-LOG2E);
#pragma unroll
                for (int n = 0; n < 2; ++n)
#pragma unroll
                    for (int hh = 0; hh < 2; ++hh) { const f32x2 g2 = (f32x2){acc[ai][0][m][n][2 * hh], acc[ai][0][m][n][2 * hh + 1]}, u2 = (f32x2){acc[ai][1][m][n][2 * hh], acc[ai][1][m][n][2 * hh + 1]};
                        const f32x2 gg = g2 * rs, uu = u2 * rsu; f32x2 ee = g2 * rsl;
                        ee.x = fast_exp2(ee.x); ee.y = fast_exp2(ee.y); f32x2 dd = ee + 1.0f; dd.x = fast_rcp(dd.x); dd.y = fast_rcp(dd.y);
                        const f32x2 oo = (gg * dd) * uu; o[n * 4 + 2 * hh] = oo.x; o[n * 4 + 2 * hh + 1] = oo.y; }
                if (MODE == 2) { u32x2 w8; w8.x = pk4_fp8(o[0], o[1], o[2], o[3]); w8.y = pk4_fp8(o[4], o[5], o[6], o[7]);
                    ob.st8((size_t)row * ldc + col0, w8); }
                else { u32x4 w; w.x = cvt_pk_bf16(o[0], o[1]); w.y = cvt_pk_bf16(o[2], o[3]); w.z = cvt_pk_bf16(o[4], o[5]); w.w = cvt_pk_bf16(o[6], o[7]);
                    ob.st16(((size_t)row * ldc + col0) * 2, w); } }
    }
};
struct EpiOddIn { static constexpr bool PERM = true, PROBE2 = false, HASPRE = true, PRE_EARLY = false;
    bf16_t* QKV; bf16_t* UV; const u64* ssq;
    __device__ __forceinline__ void pre(const Unit& u, int wr, int fr, float (&rsv)[8]) const {
        const int row0 = u.pm * BM + wr * 64 + fr; u64 raw[8];
#pragma unroll
        for (int q = 0; q < 8; ++q) raw[q] = ssq[row0 + (q >> 2) * HALF + (q & 3) * 16];
#pragma unroll
        for (int q = 0; q < 8; ++q) rsv[q] = rstd_raw(raw[q]);
    }
    __device__ __forceinline__ void operator()(const Acc& acc, const Unit& u, int wr, int wc, int fr, int fq, const float (&rsv)[8]) const {
        const int row0 = u.pm * BM + wr * 64 + fr; const bool isuv = u.pn >= 6; const float qsc = u.pn < 2 ? QS_BAND : 1.0f;
#pragma unroll
        for (int ai = 0; ai < 2; ++ai)
#pragma unroll
            for (int m = 0; m < 4; ++m) { const int row = row0 + ai * HALF + m * 16; const float rs = rsv[ai * 4 + m];
#pragma unroll
                for (int bj = 0; bj < 2; ++bj) { float o[8];
#pragma unroll
                    for (int n = 0; n < 2; ++n)
#pragma unroll
                        for (int hh = 0; hh < 2; ++hh) { f32x2 v = (f32x2){acc[ai][bj][m][n][2 * hh], acc[ai][bj][m][n][2 * hh + 1]} * rs;
                            if (isuv) { constexpr float K0 = -2.0f * 0.7978845608028654f * LOG2E, K1 = K0 * 0.044715f;
                                f32x2 e = v * (v * v * K1 + K0); e.x = fast_exp2(e.x); e.y = fast_exp2(e.y); f32x2 d = e + 1.0f; d.x = fast_rcp(d.x); d.y = fast_rcp(d.y); v = v * d; }
                            else v = v * qsc;
                            o[n * 4 + 2 * hh] = v.x; o[n * 4 + 2 * hh + 1] = v.y; }
                    u32x4 w; w.x = cvt_pk_bf16(o[0], o[1]); w.y = cvt_pk_bf16(o[2], o[3]); w.z = cvt_pk_bf16(o[4], o[5]); w.w = cvt_pk_bf16(o[6], o[7]);
                    bf16_t* p = isuv ? (UV + (size_t)row * 1024 + (u.pn - 6) * BM + bj * HALF + wc * 32 + 8 * fq) : (QKV + (size_t)row * 1536 + u.pn * BM + bj * HALF + wc * 32 + 8 * fq);
                    *(u32x4*)p = w; } }
    }
};
struct EpiY { static constexpr bool PERM = true, PROBE2 = false, HASPRE = true, PRE_EARLY = true;
    bf16_t* O; const float* gate; size_t ys; bf16_t* YP; int tail_row0;
    __device__ __forceinline__ void pre(const Unit& u, int wr, int fr, float (&rsv)[8]) const {
        const int row0 = u.pm * BM + wr * 64 + fr;
#pragma unroll
        for (int q = 0; q < 8; ++q) rsv[q] = gate[row0 + (q >> 2) * HALF + (q & 3) * 16];
    }
    __device__ __forceinline__ void operator()(const Acc& acc, const Unit& u, int wr, int wc, int fr, int fq, const float (&rsv)[8]) const {
        const int row0 = u.pm * BM + wr * 64 + fr, col0 = u.pn * BM + wc * 32 + 8 * fq;
        WtBuf ob, oy; ob.init(O); oy.init(YP ? YP : O);
#pragma unroll
        for (int ai = 0; ai < 2; ++ai)
#pragma unroll
            for (int m = 0; m < 4; ++m) { const int row = row0 + ai * HALF + m * 16; const float rs = rsv[ai * 4 + m];
                const bool tl = YP && u.kh; const size_t ro = (tl ? (((size_t)(u.kh - 1) * TAIL_ROWS + (size_t)(row - tail_row0)) * DM + col0) : ((size_t)u.kh * ys + (size_t)row * DM + col0)) * 2;
#pragma unroll
                for (int bj = 0; bj < 2; ++bj) { const f32x4 v0 = acc[ai][bj][m][0] * rs, v1 = acc[ai][bj][m][1] * rs;
                    u32x4 w; w.x = cvt_pk_bf16(v0[0], v0[1]); w.y = cvt_pk_bf16(v0[2], v0[3]); w.z = cvt_pk_bf16(v1[0], v1[1]); w.w = cvt_pk_bf16(v1[2], v1[3]);
                    if (tl) oy.st16(ro + bj * HALF * 2, w); else ob.st16(ro + bj * HALF * 2, w); } }
    }
};
}

#define XB_TMO      128
#define XB_XCNT(j)  (256  + 64 * (j))
#define XB_XSUB(j)  (1280 + 64 * (j))
#define XB_XGEN(j)  (2304 + 64 * (j))
#define XB_TOP      3328
#define XB_TOPGEN   3392
#define XCD_BAR_WORDS 3456
#define XB_SPIN_CAP (1u << 18)
__device__ __forceinline__ unsigned xb_ld(unsigned* p)              { return __hip_atomic_load(p, __ATOMIC_RELAXED, __HIP_MEMORY_SCOPE_AGENT); }
__device__ __forceinline__ unsigned xb_add(unsigned* p, unsigned v) { return __hip_atomic_fetch_add(p, v, __ATOMIC_RELAXED, __HIP_MEMORY_SCOPE_AGENT); }
__device__ __forceinline__ unsigned xb_xcc_id() { return (unsigned)__builtin_amdgcn_s_getreg((3 << 11) | 20) & 0xFu; }
#define XB_SPIN(cond, bar) do { unsigned _sp = 0; while (cond) { __builtin_amdgcn_s_sleep(1); \
    if ((++_sp & 255u) == 0u) { if (xb_ld(&(bar)[XB_TMO])) break; if (_sp > XB_SPIN_CAP) { atomicAdd(&(bar)[XB_TMO], 1u); break; } } } } while (0)
struct XcdBarrier { unsigned* bar; unsigned x; volatile LAS unsigned* st; };
__device__ __forceinline__ XcdBarrier xcd_barrier_post(unsigned* bar, volatile LAS unsigned* st) {
    XcdBarrier b; b.bar = bar; b.x = xb_xcc_id(); b.st = st;
    if (threadIdx.x == 0) (void)xb_add(&bar[XB_XCNT(b.x)], 1u);
    return b;
}
__device__ __forceinline__ void xcd_barrier_complete(unsigned* bar, unsigned x, unsigned& nloc, unsigned& nx) {
    const unsigned G = gridDim.x * gridDim.y * gridDim.z;
    unsigned sum, cnt, mine, sp = 0u;
    for (;;) {
        sum = 0u; cnt = 0u; mine = 0u;
#pragma unroll
        for (unsigned j = 0; j < 16; ++j) { const unsigned c = xb_ld(&bar[XB_XCNT(j)]); sum += c; cnt += (c > 0u) ? 1u : 0u; mine = (j == x) ? c : mine; }
        if (sum == G) break;
        __builtin_amdgcn_s_sleep(1);
        if ((++sp & 255u) == 0u) { if (xb_ld(&bar[XB_TMO])) break; if (sp > XB_SPIN_CAP) { atomicAdd(&bar[XB_TMO], 1u); break; } }
    }
    nloc = mine > 0u ? mine : 1u; nx = cnt > 0u ? cnt : 1u;
}
__device__ __forceinline__ void xcd_barrier(const XcdBarrier& b) {
    asm volatile("s_waitcnt vmcnt(0)" ::: "memory");
    __syncthreads();
    if (threadIdx.x == 0) {
        unsigned* bar = b.bar;
        __builtin_amdgcn_s_waitcnt(0);
        unsigned nloc = b.st[0], nx = b.st[1];
        if (nloc == 0u) { xcd_barrier_complete(bar, b.x, nloc, nx); b.st[0] = nloc; b.st[1] = nx; }
        const unsigned old = xb_add(&bar[XB_XSUB(b.x)], 1u);
        const unsigned gen = old / nloc;
        if (old + 1u == (gen + 1u) * nloc) {
            __builtin_amdgcn_fence(__ATOMIC_RELEASE, "agent");
            asm volatile("s_waitcnt vmcnt(0)" ::: "memory");
            const unsigned og = xb_add(&bar[XB_TOP], 1u);
            const unsigned tg = og / nx;
            if (og + 1u == (tg + 1u) * nx) xb_add(&bar[XB_TOPGEN], 1u);
            else XB_SPIN(xb_ld(&bar[XB_TOPGEN]) == tg, bar);
            __builtin_amdgcn_fence(__ATOMIC_ACQUIRE, "agent");
            xb_add(&bar[XB_XGEN(b.x)], 1u);
            asm volatile("s_waitcnt vmcnt(0)" ::: "memory");
        } else {
            XB_SPIN(xb_ld(&bar[XB_XGEN(b.x)]) == gen, bar);
            __builtin_amdgcn_fence(__ATOMIC_ACQUIRE, "agent");
            asm volatile("s_waitcnt vmcnt(0)" ::: "memory");
        }
    }
    __syncthreads();
}

struct Frame {
    LAS unsigned char* lds;
    unsigned* ctl;
    int tid, lane, wave, vcu, G;
    __device__ __forceinline__ void refresh() { tid = opaque_tid(); lane = tid & 63; wave = __builtin_amdgcn_readfirstlane(tid >> 6); }
};

struct XJob { const float* W; const float* gain; bf16_t* WT; int K, N, ldt, mode, nb; size_t sb, db; int istart, f8; };
__device__ __forceinline__ void xpose_load(const XJob& J, int item, f32x4 (&v)[16], int lane) {
    const int nblk = (J.N + 63) / 64, nkb = J.K / 64, per = nkb * nblk, e = item / per, r = item % per, kb = r % nkb, nbk = r / nkb, k0 = 64 * kb, n0 = 64 * nbk;
    const float* W = J.W + (size_t)e * J.sb;
    const int lr = lane >> 4, lc = 4 * (lane & 15);
    const bool colok = (n0 + lc) < J.N;
#pragma unroll
    for (int i = 0; i < 16; ++i) v[i] = colok ? __builtin_nontemporal_load((const f32x4*)(W + (size_t)(k0 + 4 * i + lr) * J.N + n0 + lc)) : (f32x4){0.f, 0.f, 0.f, 0.f};
}
__device__ __forceinline__ void xpose_store(const XJob& J, int item, const f32x4 (&v)[16], LAS float* scr, int lane) {
    const int nblk = (J.N + 63) / 64, nkb = J.K / 64, per = nkb * nblk, e = item / per, r = item % per, kb = r % nkb, nbk = r / nkb, k0 = 64 * kb, n0 = 64 * nbk;
    bf16_t* WT = J.WT + (size_t)e * J.db;
    const int lr = lane >> 4, lc = 4 * (lane & 15);
#pragma unroll
    for (int i = 0; i < 16; ++i) { const int kk = 4 * i + lr; const float gs = J.gain ? J.gain[k0 + kk] : 1.0f; LAS float* d = scr + kk * 65 + lc;
        d[0] = v[i][0] * gs; d[1] = v[i][1] * gs; d[2] = v[i][2] * gs; d[3] = v[i][3] * gs; }
    LDS_WAIT(); asm volatile("" ::: "memory");
    if (J.f8) {
        const int c4 = lane & 3;
#pragma unroll
        for (int j = 0; j < 4; ++j) { const int n = (lane >> 2) + 16 * j; const LAS float* s = scr + (16 * c4) * 65 + n;
            u32x4 o8;
            o8.x = pk4_fp8(s[0 * 65] * F8_WS, s[1 * 65] * F8_WS, s[2 * 65] * F8_WS, s[3 * 65] * F8_WS); o8.y = pk4_fp8(s[4 * 65] * F8_WS, s[5 * 65] * F8_WS, s[6 * 65] * F8_WS, s[7 * 65] * F8_WS);
            o8.z = pk4_fp8(s[8 * 65] * F8_WS, s[9 * 65] * F8_WS, s[10 * 65] * F8_WS, s[11 * 65] * F8_WS); o8.w = pk4_fp8(s[12 * 65] * F8_WS, s[13 * 65] * F8_WS, s[14 * 65] * F8_WS, s[15 * 65] * F8_WS);
            const int ng = n0 + n; const int row = J.mode == 0 ? ng : ((ng >> 7) * 256 + (ng & 127) + (J.mode == 2 ? 128 : 0));
            *(u32x4*)((unsigned char*)J.WT + (size_t)e * J.db + (size_t)row * J.ldt + k0 + 16 * c4) = o8; }
        LDS_WAIT(); asm volatile("" ::: "memory");
        return;
    }
    const int c = lane & 7;
#pragma unroll
    for (int j = 0; j < 8; ++j) { const int n = (lane >> 3) + 8 * j; const LAS float* s = scr + (8 * c) * 65 + n;
        u32x4 o; o.x = cvt_pk_bf16(s[0 * 65], s[1 * 65]); o.y = cvt_pk_bf16(s[2 * 65], s[3 * 65]); o.z = cvt_pk_bf16(s[4 * 65], s[5 * 65]); o.w = cvt_pk_bf16(s[6 * 65], s[7 * 65]);
        const int ng = n0 + n; const int row = J.mode == 0 ? ng : ((ng >> 7) * 256 + (ng & 127) + (J.mode == 2 ? 128 : 0));
        if (J.f8) { u32x2 o8; o8.x = pk4_fp8(s[0 * 65] * F8_WS, s[1 * 65] * F8_WS, s[2 * 65] * F8_WS, s[3 * 65] * F8_WS); o8.y = pk4_fp8(s[4 * 65] * F8_WS, s[5 * 65] * F8_WS, s[6 * 65] * F8_WS, s[7 * 65] * F8_WS);
            *(u32x2*)((unsigned char*)J.WT + (size_t)e * J.db + (size_t)row * J.ldt + k0 + 8 * c) = o8; }
        else if (ng < J.N) *(u32x4*)(WT + (size_t)row * J.ldt + k0 + 8 * c) = o; }
    LDS_WAIT(); asm volatile("" ::: "memory");
}
constexpr int NJT = 12;
__device__ __forceinline__ void make_job(int i, int t, const float* const* in, unsigned char* ws, XJob& J) {
    J.gain = nullptr; J.mode = 0; J.nb = 1; J.sb = 0; J.db = 0; J.istart = 0; J.f8 = 0;
    bf16_t* WE = (bf16_t*)(ws + WS_WE) + (size_t)i * E_SIZE; bf16_t* WO = (bf16_t*)(ws + WS_WO) + (size_t)i * O_SIZE;
    switch (t) {
    case 0: J.W = in[2] + (size_t)i * 1024 * 928; J.gain = in[1] + i * 1024; J.WT = WE + E_WIN; J.K = 1024; J.N = 928; J.ldt = 1024; break;
    case 1: J.W = in[6] + (size_t)i * 256 * 768; J.gain = in[5] + i * 256; J.WT = WE + E_WQ; J.K = 256; J.N = 768; J.ldt = 256; break;
    case 2: J.W = in[8] + (size_t)i * 128 * 1024; J.gain = in[7] + i * 128; J.WT = WE + E_WKV; J.K = 128; J.N = 1024; J.ldt = 256; break;
    case 3: J.W = in[9] + (size_t)i * 1024 * 1024 + (size_t)512 * 1024; J.WT = WE + E_WOUT + 512; J.K = 512; J.N = 1024; J.ldt = 1024; break;
    case 4: J.W = in[11] + (size_t)i * 1024 * FF; J.gain = in[10] + i * 1024; J.WT = WE + E_WGU; J.K = 1024; J.N = FF; J.ldt = 1024; J.mode = 1; J.f8 = FFN1_F8; break;
    case 5: J.W = in[12] + (size_t)i * 1024 * FF; J.gain = in[10] + i * 1024; J.WT = WE + E_WGU; J.K = 1024; J.N = FF; J.ldt = 1024; J.mode = 2; J.f8 = FFN1_F8; break;
    case 6: J.W = in[13] + (size_t)i * FF * 1024; J.WT = WE + E_WDN; J.K = FF; J.N = 1024; J.ldt = FF; break;
    case 7: J.W = in[15] + (size_t)i * 1024 * 2560; J.gain = in[14] + i * 1024; J.WT = WO + O_WIN; J.K = 1024; J.N = 2560; J.ldt = 1024; break;
    case 8: J.W = in[21] + (size_t)i * 1024 * 1024; J.WT = WO + O_WOUT; J.K = 1024; J.N = 1024; J.ldt = 1024; break;
    case 9: J.W = in[24] + (size_t)i * NEXP * 1024 * EFF; J.gain = in[22] + i * 1024; J.WT = WO + O_WGU; J.K = 1024; J.N = EFF; J.ldt = 1024; J.mode = 1; J.nb = NEXP; J.sb = (size_t)1024 * EFF; J.db = (size_t)2 * EFF * 1024; J.f8 = MOE_F8; break;
    case 10: J.W = in[25] + (size_t)i * NEXP * 1024 * EFF; J.gain = in[22] + i * 1024; J.WT = WO + O_WGU; J.K = 1024; J.N = EFF; J.ldt = 1024; J.mode = 2; J.nb = NEXP; J.sb = (size_t)1024 * EFF; J.db = (size_t)2 * EFF * 1024; J.f8 = MOE_F8; break;
    default: J.W = in[26] + (size_t)i * NEXP * EFF * 1024; J.WT = WO + O_WDN; J.K = EFF; J.N = 1024; J.ldt = EFF; J.nb = NEXP; J.sb = (size_t)EFF * 1024; J.db = (size_t)1024 * EFF; J.f8 = MOE_F8; break;
    }
}
__host__ __device__ constexpr int job_items_t(int t) {
    return t == 0 ? 16 * 15 : t == 1 ? 4 * 12 : t == 2 ? 2 * 16 : t == 3 ? 8 * 16 : t == 4 ? 16 * 44 : t == 5 ? 16 * 44 : t == 6 ? 44 * 16 : t == 7 ? 16 * 40 : t == 8 ? 16 * 16 : t == 9 ? 8 * 16 * 56 : t == 10 ? 8 * 16 * 56 : 8 * 56 * 16;
}
__host__ __device__ constexpr int job_start_t(int t) { int a = 0; for (int k = 0; k < t; ++k) a += job_items_t(k); return a; }
constexpr int ITEMS_PER_PAIR = job_start_t(NJT);

__device__ __forceinline__ void p0_prologue(Frame& F, const float* const* in, unsigned char* ws) {
    F.refresh();
    LAS float* scr = (LAS float*)(F.lds + F.wave * 16640);
    const int gw = F.vcu * NWAVES + F.wave, NGW = F.G * NWAVES;
#define XP_DECODE(it_, J_, r_) do { const int i_ = (it_) / ITEMS_PER_PAIR, rr_ = (it_) % ITEMS_PER_PAIR; int t_ = 0; \
        _Pragma("unroll") for (int k = 1; k < NJT; ++k) t_ += (rr_ >= job_start_t(k)) ? 1 : 0; int st_ = 0; \
        _Pragma("unroll") for (int k = 1; k < NJT; ++k) st_ = (t_ == k) ? job_start_t(k) : st_; make_job(i_, t_, in, ws, J_); r_ = rr_ - st_; } while (0)
    { constexpr int NIT = 2 * ITEMS_PER_PAIR; int it = gw; XJob Jc; int rc = 0; f32x4 vc[16];
      if (it < NIT) { XP_DECODE(it, Jc, rc); xpose_load(Jc, rc, vc, F.lane); }
      while (it < NIT) {
          const int itn = it + NGW; XJob Jn = Jc; int rn = 0; f32x4 vn[16];
          if (itn < NIT) { XP_DECODE(itn, Jn, rn); xpose_load(Jn, rn, vn, F.lane); }
          xpose_store(Jc, rc, vc, scr, F.lane);
          it = itn; Jc = Jn; rc = rn;
#pragma unroll
          for (int i = 0; i < 16; ++i) vc[i] = vn[i];
      } }
#undef XP_DECODE
    const int gt = F.vcu * 512 + F.tid, NGT = F.G * 512;
    for (int i = 0; i < 2; ++i) {
        bf16_t* WE = (bf16_t*)(ws + WS_WE) + (size_t)i * E_SIZE;
        for (int x = gt; x < 96 * 1024 / 8; x += NGT) *(u32x4*)(WE + E_WIN + (size_t)928 * 1024 + (size_t)x * 8) = zero4();
        for (int x = gt; x < 1024 * 16; x += NGT) { const int r = x >> 4, c = x & 15; *(u32x4*)(WE + E_WKV + (size_t)r * 256 + 128 + c * 8) = zero4(); }
    }
    for (int x = gt; x < 2 * 64 * 1024; x += NGT) {
        const int n = x & 1023, kg = __builtin_amdgcn_readfirstlane((x >> 10) & 63), i = __builtin_amdgcn_readfirstlane(x >> 16), g = kg >> 4, c0 = (8 * kg) & 127;
        const float* pr = in[3] + (size_t)i * 4 * 128 * 128 + ((size_t)g * 128 + c0) * 128; const float* sr = in[4] + (size_t)i * 512 + g * 128;
        const float* wr_ = in[9] + (size_t)i * 1024 * 1024 + (size_t)(g * 128) * 1024 + n;
        float a[8];
#pragma unroll
        for (int kk = 0; kk < 8; ++kk) a[kk] = 0.f;
        float wc[8], wn[8];
#pragma unroll
        for (int u = 0; u < 8; ++u) { wc[u] = wr_[(size_t)u * 1024]; wn[u] = 0.f; }
#pragma unroll 1
        for (int d0 = 0; d0 < 128; d0 += 8) {
            if (d0 + 8 < 128) {
#pragma unroll
                for (int u = 0; u < 8; ++u) wn[u] = wr_[(size_t)(d0 + 8 + u) * 1024]; }
#pragma unroll
            for (int u = 0; u < 8; ++u) { const float wv = wc[u] * sr[d0 + u];
#pragma unroll
                for (int kk = 0; kk < 8; ++kk) a[kk] += pr[kk * 128 + d0 + u] * wv; }
#pragma unroll
            for (int u = 0; u < 8; ++u) wc[u] = wn[u]; }
        u32x4 o; o.x = cvt_pk_bf16(a[0], a[1]); o.y = cvt_pk_bf16(a[2], a[3]); o.z = cvt_pk_bf16(a[4], a[5]); o.w = cvt_pk_bf16(a[6], a[7]);
        *(u32x4*)((bf16_t*)(ws + WS_WE) + (size_t)i * E_SIZE + E_WOUT + (size_t)n * 1024 + 8 * kg) = o;
    }
    { float* cosT = (float*)(ws + T_COS); float* sinT = (float*)(ws + T_SIN);
      for (int x = gt; x < SEQ * 16; x += NGT) { const int pos = x >> 4, j = x & 15;
          const float inv = 1.0f / powf(10000.0f, (float)(2 * j) / 32.0f); const float angf = (float)pos * inv;
          double a = (double)angf; const double twopi = 6.283185307179586476925; a -= twopi * rint(a / twopi);
          const double y = a * 0.125, y2 = y * y;
          double s = y * (1.0 + y2 * (-1.0 / 6 + y2 * (1.0 / 120 + y2 * (-1.0 / 5040 + y2 * (1.0 / 362880 + y2 * (-1.0 / 39916800 + y2 * (1.0 / 6227020800.0)))))));
          double c = 1.0 + y2 * (-0.5 + y2 * (1.0 / 24 + y2 * (-1.0 / 720 + y2 * (1.0 / 40320 + y2 * (-1.0 / 3628800 + y2 * (1.0 / 479001600.0 + y2 * (-1.0 / 87178291200.0)))))));
#pragma unroll
          for (int k = 0; k < 3; ++k) { const double s2 = 2.0 * s * c, c2 = c * c - s * s; s = s2; c = c2; }
          cosT[x] = (float)c; sinT[x] = (float)s; } }
    { const float* x = in[0]; bf16_t* XB = (bf16_t*)(ws + WS_XB); u64* ssq = (u64*)(ws + WS_SSQ);
      for (int m = gw; m < NTOK; m += NGW) { const f32x4* xr = (const f32x4*)(x + (size_t)m * DM) + F.lane; float s = 0.f;
#pragma unroll
          for (int j = 0; j < 4; ++j) { const f32x4 v = xr[64 * j]; s += (v[0] * v[0] + v[1] * v[1]) + (v[2] * v[2] + v[3] * v[3]);
              u32x2 w; w.x = cvt_pk_bf16(v[0], v[1]); w.y = cvt_pk_bf16(v[2], v[3]); *((u32x2*)(XB + (size_t)m * DM) + F.lane + 64 * j) = w; }
          s = wave_sum(s); if (F.lane == 0) ssq[m] = ssq_fix(s); } }
}

typedef float f32p2 __attribute__((ext_vector_type(2)));
__device__ __forceinline__ void p_pooled(Frame& F, unsigned char* ws, int bx) {
    F.refresh();
    const bf16_t* Z = (const bf16_t*)(ws + R_Z); bf16_t* MIX = (bf16_t*)(ws + R_MIX);
    const bool tailwg = F.G == 256; if (tailwg && bx < 192) return;
    const int gw = (tailwg ? bx - 192 : F.vcu) * NWAVES + F.wave, NGW = (tailwg ? 64 : F.G) * NWAVES;
    const int w = 2 << (F.lane >> 4);
    for (int g = gw; g < NTOK / 8; g += NGW) { const int t0 = 8 * g, p0 = t0 & (SEQ - 1);
        u32x4 R[23];
#pragma unroll
        for (int k = 0; k < 23; ++k) { const int d = 15 - k; const bool inseq = p0 - d >= 0; const int dd = (inseq && d < w) ? d : 0;
            u32x4 v = *((const u32x4*)(Z + (size_t)(t0 - dd) * 1024) + F.lane); const unsigned mk = inseq ? 0xFFFFFFFFu : 0u;
            if (d > 0) { v.x &= mk; v.y &= mk; v.z &= mk; v.w &= mk; }
            R[k] = v; }
        float ic[8];
#pragma unroll
        for (int r = 0; r < 8; ++r) { const int cnt = (p0 + r + 1 < w) ? (p0 + r + 1) : w; ic[r] = fast_rcp((float)cnt); }
        u32x4 out[8];
#pragma unroll
        for (int c = 0; c < 4; ++c) { f32p2 a[23], self[8], res[8];
#pragma unroll
            for (int k = 0; k < 23; ++k) a[k] = (f32p2){bflo(R[k][c]), bfhi(R[k][c])};
#pragma unroll
            for (int r = 0; r < 8; ++r) self[r] = a[15 + r];
#pragma unroll
            for (int k = 22; k >= 1; --k) a[k] += a[k - 1];
#pragma unroll
            for (int r = 0; r < 8; ++r) res[r] = a[15 + r];
#pragma unroll
            for (int k = 22; k >= 3; --k) a[k] += a[k - 2];
#pragma unroll
            for (int r = 0; r < 8; ++r) res[r] = w >= 4 ? a[15 + r] : res[r];
#pragma unroll
            for (int k = 22; k >= 7; --k) a[k] += a[k - 4];
#pragma unroll
            for (int r = 0; r < 8; ++r) res[r] = w >= 8 ? a[15 + r] : res[r];
#pragma unroll
            for (int k = 22; k >= 15; --k) a[k] += a[k - 8];
#pragma unroll
            for (int r = 0; r < 8; ++r) { res[r] = w >= 16 ? a[15 + r] : res[r]; const f32p2 o = res[r] * ic[r] - self[r]; out[r][c] = cvt_pk_bf16(o.x, o.y); } }
#pragma unroll
        for (int r = 0; r < 8; ++r) *((u32x4*)(MIX + (size_t)(t0 + r) * 1024) + F.lane) = out[r]; }
}

__device__ __forceinline__ int crow(int r, int hi) { return (r & 3) + 8 * (r >> 2) + 4 * hi; }
__device__ __forceinline__ s16x4 vtr(const LAS unsigned char* p) { return __builtin_bit_cast(s16x4, __builtin_amdgcn_ds_read_tr16_b64_v4i16((LAS s16x4*)p)); }

template <int DQK, bool BAND>
__device__ __forceinline__ void attn_unit(const bf16_t* __restrict__ Qp, int ldq, const bf16_t* __restrict__ Kp, int ldk, const bf16_t* __restrict__ Vp, int ldv,
                                          bf16_t* Op, int ldo, int b, int qb, LAS unsigned char* lds, const float* bias_g) {
    constexpr int KSTR = (DQK + 8) * 2, KBUF = 64 * KSTR, VBUF = 8192, KCH = DQK / 8, NKS = DQK / 16;
    const int tid = opaque_tid(), lane = tid & 63, wave = __builtin_amdgcn_readfirstlane(tid >> 6), r32 = lane & 31, hi = lane >> 5;
    LAS unsigned char* Kl = lds; LAS unsigned char* Vl = lds + 2 * KBUF;
    LAS float* sc = (LAS float*)(lds + 2 * KBUF + 2 * VBUF) + wave * 32;
    LAS float* biasL = (LAS float*)(lds + 2 * KBUF + 2 * VBUF + 1024);
    const int chunkw = 4 * qb + (wave >> 1), t1 = 4 * qb + 3, t0 = BAND ? ((4 * qb - 8) > 0 ? (4 * qb - 8) : 0) : 0;
    const size_t rowb = (size_t)b * SEQ;
    if (BAND) { if (tid < 257) biasL[tid] = bias_g[tid] * LOG2E; }
    if (wave < 4) __builtin_amdgcn_s_setprio(2);
    bf16x8 qf[NKS];
    { const bf16_t* qrow = Qp + (rowb + 256 * qb + 32 * wave + r32) * ldq + 8 * hi;
#pragma unroll
      for (int ks = 0; ks < NKS; ++ks) qf[ks] = *(const bf16x8*)(qrow + 16 * ks); }
    const int kkey0 = tid / KCH, kch0 = tid % KCH; const int idx1 = tid + 512; const bool has1 = idx1 < 64 * KCH; const int kkey1 = has1 ? idx1 / KCH : 0, kch1 = has1 ? idx1 % KCH : 0;
    const int vkey = tid >> 3, vch = tid & 7;
    const bf16_t* kg0 = Kp + (rowb + kkey0) * ldk + 8 * kch0; const bf16_t* kg1 = Kp + (rowb + kkey1) * ldk + 8 * kch1; const bf16_t* vg = Vp + (rowb + vkey) * ldv + 8 * vch;
    const int kl0 = kkey0 * KSTR + kch0 * 16, kl1 = kkey1 * KSTR + kch1 * 16, vl = (vch >> 2) * 4096 + vkey * 64 + (vch & 3) * 16;
    u32x4 st[2][3];
#pragma unroll
    for (int q = 0; q < 2; ++q) { st[q][0] = (u32x4){0u, 0u, 0u, 0u}; st[q][1] = (u32x4){0u, 0u, 0u, 0u}; st[q][2] = (u32x4){0u, 0u, 0u, 0u}; }
#define ATT_LOAD(set, tt) do { const size_t to_ = (size_t)(tt) * 64; st[set][0] = *(const u32x4*)(kg0 + to_ * ldk); if (has1) st[set][1] = *(const u32x4*)(kg1 + to_ * ldk); st[set][2] = *(const u32x4*)(vg + to_ * ldv); } while (0)
#define ATT_WRITE(set, buf) do { *(LAS u32x4*)(Kl + (buf) * KBUF + kl0) = st[set][0]; if (has1) *(LAS u32x4*)(Kl + (buf) * KBUF + kl1) = st[set][1]; *(LAS u32x4*)(Vl + (buf) * VBUF + vl) = st[set][2]; } while (0)
    ATT_LOAD(0, t0); ATT_WRITE(0, 0);
    if (t0 + 1 <= t1) ATT_LOAD(1, t0 + 1);
    __syncthreads();
    float m_run = 0.f; f32x16 o0 = {}, o1 = {}, lacc = {}, negm = {}; bool first = true;
    const bf16x8 ones8 = (bf16x8){0x3F80, 0x3F80, 0x3F80, 0x3F80, 0x3F80, 0x3F80, 0x3F80, 0x3F80};
    const int vtoff = (16 * ((lane >> 4) & 1) + 4 * (lane & 3)) * 2 + (4 * hi + ((lane & 15) >> 2)) * 64;
    for (int tb = t0; tb <= t1; tb += 2) {
#pragma unroll
      for (int ph = 0; ph < 2; ++ph) {
        const int t = tb + ph; if (t > t1) break;
        const int cur = (t - t0) & 1; const bool more = t < t1;
        if (t + 2 <= t1) ATT_LOAD(ph, t + 2);
        const bool active = BAND ? (t <= chunkw && t >= chunkw - 8) : (t <= chunkw);
        if (active) {
            const LAS unsigned char* Ks = Kl + cur * KBUF; const LAS unsigned char* Vs = Vl + cur * VBUF;
            f32x16 s0, s1;
#pragma unroll
            for (int ks = 0; ks < NKS; ++ks) {
                const bf16x8 k0 = *(const LAS bf16x8*)(Ks + r32 * KSTR + ks * 32 + hi * 16);
                const bf16x8 k1 = *(const LAS bf16x8*)(Ks + (32 + r32) * KSTR + ks * 32 + hi * 16);
                s0 = __builtin_amdgcn_mfma_f32_32x32x16_bf16(k0, qf[ks], ks == 0 ? negm : s0, 0, 0, 0);
                s1 = __builtin_amdgcn_mfma_f32_32x32x16_bf16(k1, qf[ks], ks == 0 ? negm : s1, 0, 0, 0);
            }
            if (BAND) {
                if (t <= chunkw - 3) { const float cb = biasL[256];
#pragma unroll
                    for (int r = 0; r < 16; ++r) { s0[r] += cb; s1[r] += cb; } }
                else { const int qpos = 256 * qb + 32 * wave + r32, kb0 = 64 * t;
#pragma unroll
                    for (int r = 0; r < 16; ++r) { const int rel = qpos - (kb0 + crow(r, hi)); int i0 = rel < -128 ? -128 : (rel > 128 ? 128 : rel); int rel1 = rel - 32; int i1 = rel1 < -128 ? -128 : (rel1 > 128 ? 128 : rel1);
                        s0[r] += biasL[i0 + 128]; s1[r] += biasL[i1 + 128]; } }
            }
            float mx = s0[0];
#pragma unroll
            for (int r = 1; r < 16; ++r) mx = fmaxf(mx, s0[r]);
#pragma unroll
            for (int r = 0; r < 16; ++r) mx = fmaxf(mx, s1[r]);
            { const auto rr_ = __builtin_amdgcn_permlane32_swap(__float_as_uint(mx), __float_as_uint(mx), false, false); mx = fmaxf(__uint_as_float(rr_[0]), __uint_as_float(rr_[1])); }
            if (first || __any(mx > 8.0f)) {
                const float dl = first ? mx : fmaxf(mx, 0.f); m_run += dl;
#pragma unroll
                for (int r = 0; r < 16; ++r) { s0[r] -= dl; s1[r] -= dl; }
                const float alpha = first ? 1.0f : fast_exp2(-dl);
#pragma unroll
                for (int r = 0; r < 16; ++r) negm[r] = -m_run;
                if (hi == 0) sc[r32] = alpha;
                LDS_WAIT();
#pragma unroll
                for (int r = 0; r < 16; ++r) { const float a = sc[crow(r, hi)]; o0[r] *= a; o1[r] *= a; lacc[r] *= a; }
                LDS_WAIT();
                first = false;
            }
#pragma unroll
            for (int r = 0; r < 16; ++r) { s0[r] = fast_exp2(s0[r]); s1[r] = fast_exp2(s1[r]); }
#pragma unroll
            for (int hf = 0; hf < 2; ++hf)
#pragma unroll
                for (int s2 = 0; s2 < 2; ++s2) {
                    u32x4 pw;
                    if (hf == 0) { pw.x = cvt_pk_bf16(s0[8 * s2 + 0], s0[8 * s2 + 1]); pw.y = cvt_pk_bf16(s0[8 * s2 + 2], s0[8 * s2 + 3]); pw.z = cvt_pk_bf16(s0[8 * s2 + 4], s0[8 * s2 + 5]); pw.w = cvt_pk_bf16(s0[8 * s2 + 6], s0[8 * s2 + 7]); }
                    else         { pw.x = cvt_pk_bf16(s1[8 * s2 + 0], s1[8 * s2 + 1]); pw.y = cvt_pk_bf16(s1[8 * s2 + 2], s1[8 * s2 + 3]); pw.z = cvt_pk_bf16(s1[8 * s2 + 4], s1[8 * s2 + 5]); pw.w = cvt_pk_bf16(s1[8 * s2 + 6], s1[8 * s2 + 7]); }
                    const bf16x8 pa = __builtin_bit_cast(bf16x8, pw);
                    lacc = __builtin_amdgcn_mfma_f32_32x32x16_bf16(pa, ones8, lacc, 0, 0, 0);
                    const LAS unsigned char* vb = Vs + (32 * hf + 16 * s2) * 64 + vtoff;
#pragma unroll
                    for (int dh = 0; dh < 2; ++dh) {
                        const s16x4 lo = vtr(vb + dh * 4096), hh = vtr(vb + dh * 4096 + 8 * 64);
                        const bf16x8 vf = (bf16x8){lo[0], lo[1], lo[2], lo[3], hh[0], hh[1], hh[2], hh[3]};
                        if (dh == 0) o0 = __builtin_amdgcn_mfma_f32_32x32x16_bf16(pa, vf, o0, 0, 0, 0);
                        else         o1 = __builtin_amdgcn_mfma_f32_32x32x16_bf16(pa, vf, o1, 0, 0, 0);
                    }
                }
        }
        if (more) ATT_WRITE(ph ^ 1, cur ^ 1);
        __syncthreads();
      }
    }
#undef ATT_LOAD
#undef ATT_WRITE
    __builtin_amdgcn_s_setprio(0);
    { bf16_t* orow = Op + (rowb + 256 * qb + 32 * wave) * ldo + r32;
#pragma unroll
      for (int r = 0; r < 16; ++r) { const int q = crow(r, hi); const float inv = fast_rcp(lacc[r]);
          orow[(size_t)q * ldo] = f2bf(o0[r] * inv); orow[(size_t)q * ldo + 32] = f2bf(o1[r] * inv); } }
}

__device__ __forceinline__ void sgu_unit(const bf16_t* UV, const float* ng, const float* nb, const float* W, const float* bs, bf16_t* MIX, int b, int n, int g, LAS unsigned char* lds) {
    const int tid = opaque_tid(), lane = tid & 63, wave = __builtin_amdgcn_readfirstlane(tid >> 6), r32 = lane & 31, hi = lane >> 5;
    const size_t t0 = (size_t)b * SEQ + (size_t)n * 128;
    { const int s = tid >> 2, qd = tid & 3; const bf16_t* src = UV + (t0 + s) * 1024 + 512 + g * 128 + 32 * qd;
      float x[32];
#pragma unroll
      for (int j = 0; j < 4; ++j) { const u32x4 v = *((const u32x4*)src + j); x[8 * j + 0] = bflo(v.x); x[8 * j + 1] = bfhi(v.x); x[8 * j + 2] = bflo(v.y); x[8 * j + 3] = bfhi(v.y); x[8 * j + 4] = bflo(v.z); x[8 * j + 5] = bfhi(v.z); x[8 * j + 6] = bflo(v.w); x[8 * j + 7] = bfhi(v.w); }
      float sm = 0.f;
#pragma unroll
      for (int j = 0; j < 32; ++j) sm += x[j];
      sm += __shfl_xor(sm, 1); sm += __shfl_xor(sm, 2);
      const float mu = sm * (1.0f / 128.0f); float vs = 0.f;
#pragma unroll
      for (int j = 0; j < 32; ++j) { x[j] -= mu; vs += x[j] * x[j]; }
      vs += __shfl_xor(vs, 1); vs += __shfl_xor(vs, 2);
      const float rstd = rsqrtf(vs * (1.0f / 128.0f) + EPS);
      const float* gp = ng + g * 128 + 32 * qd; const float* bp = nb + g * 128 + 32 * qd;
#pragma unroll
      for (int j = 0; j < 4; ++j) { float y[8];
#pragma unroll
          for (int i = 0; i < 8; ++i) y[i] = x[8 * j + i] * rstd * gp[8 * j + i] + bp[8 * j + i];
          u32x4 w; w.x = cvt_pk_bf16(y[0], y[1]); w.y = cvt_pk_bf16(y[2], y[3]); w.z = cvt_pk_bf16(y[4], y[5]); w.w = cvt_pk_bf16(y[6], y[7]);
          *(LAS u32x4*)(lds + qd * 8192 + s * 64 + j * 16) = w; } }
    __syncthreads();
    { const int tb = wave >> 1, cb0 = 2 * (wave & 1), trow = 32 * tb + r32;
      f32x16 acc0 = {}, acc1 = {};
      const float* wrow = W + ((size_t)g * 128 + trow) * 128 + 8 * hi;
      const int vto = (8 * hi + ((lane & 15) >> 2)) * 64 + (16 * ((lane >> 4) & 1) + 4 * (lane & 3)) * 2;
      for (int ks = 0; ks < 2 * (tb + 1); ++ks) {
          const f32x4 w0 = *(const f32x4*)(wrow + 16 * ks), w1 = *(const f32x4*)(wrow + 16 * ks + 4);
          const int s0 = 16 * ks + 8 * hi; float a[8];
#pragma unroll
          for (int j = 0; j < 4; ++j) { a[j] = (s0 + j <= trow) ? w0[j] : 0.f; a[4 + j] = (s0 + 4 + j <= trow) ? w1[j] : 0.f; }
          u32x4 aw; aw.x = cvt_pk_bf16(a[0], a[1]); aw.y = cvt_pk_bf16(a[2], a[3]); aw.z = cvt_pk_bf16(a[4], a[5]); aw.w = cvt_pk_bf16(a[6], a[7]);
          const bf16x8 af = __builtin_bit_cast(bf16x8, aw);
          const LAS unsigned char* vb = lds + (16 * ks) * 64 + vto;
          { const s16x4 lo = vtr(vb + cb0 * 8192), hh = vtr(vb + cb0 * 8192 + 4 * 64); const bf16x8 bfr = (bf16x8){lo[0], lo[1], lo[2], lo[3], hh[0], hh[1], hh[2], hh[3]};
            acc0 = __builtin_amdgcn_mfma_f32_32x32x16_bf16(af, bfr, acc0, 0, 0, 0); }
          { const s16x4 lo = vtr(vb + (cb0 + 1) * 8192), hh = vtr(vb + (cb0 + 1) * 8192 + 4 * 64); const bf16x8 bfr = (bf16x8){lo[0], lo[1], lo[2], lo[3], hh[0], hh[1], hh[2], hh[3]};
            acc1 = __builtin_amdgcn_mfma_f32_32x32x16_bf16(af, bfr, acc1, 0, 0, 0); }
      }
#pragma unroll
      for (int r = 0; r < 16; ++r) { const int t = 32 * tb + crow(r, hi); const float bias = bs[g * 128 + t];
          const size_t ro = (t0 + t) * 1024 + g * 128 + 32 * cb0 + r32;
          const float u0 = bf2f(UV[ro]), u1 = bf2f(UV[ro + 32]);
          MIX[ro + 512] = f2bf(u0 * (acc0[r] + bias)); MIX[ro + 512 + 32] = f2bf(u1 * (acc1[r] + bias)); } }
    __syncthreads();
}

__device__ __forceinline__ void p_route(Frame& F, unsigned char* ws, const bf16_t* XBr, const u64* ssq, const float* gain, const float* router, unsigned* cnt) {
    F.refresh();
    LAS int* hist = (LAS int*)(F.lds + 32768);
    LAS int* gbase = (LAS int*)(F.lds + 32768 + 64);
    LAS int* pe = (LAS int*)(F.lds + 32768 + 128);
    LAS float* pwt = (LAS float*)(F.lds + 32768 + 128 + 1024);
    int* TE = (int*)(ws + T_TE); int* TP = (int*)(ws + T_TP); float* TW = (float*)(ws + T_TW); int* HG = (int*)(ws + T_HG);
    float rw[8][16];
#pragma unroll
    for (int j = 0; j < 4; ++j)
#pragma unroll
        for (int i = 0; i < 4; ++i) { const int k = 256 * j + 4 * F.lane + i; const float gk = gain[k]; const f32x4 a = *(const f32x4*)(router + k * 8), b = *(const f32x4*)(router + k * 8 + 4);
            rw[0][j * 4 + i] = a[0] * gk; rw[1][j * 4 + i] = a[1] * gk; rw[2][j * 4 + i] = a[2] * gk; rw[3][j * 4 + i] = a[3] * gk;
            rw[4][j * 4 + i] = b[0] * gk; rw[5][j * 4 + i] = b[1] * gk; rw[6][j * 4 + i] = b[2] * gk; rw[7][j * 4 + i] = b[3] * gk; }
    for (int blk = F.vcu; blk < NTOK / 64; blk += F.G) {
        __syncthreads();
        u32x2 xc[4], xn[4];
#pragma unroll
        for (int j = 0; j < 4; ++j) { xc[j] = *((const u32x2*)(XBr + (size_t)(blk * 64 + F.wave) * DM) + F.lane + 64 * j); xn[j] = xc[j]; }
        for (int r = F.wave; r < 64; r += NWAVES) { const int t = blk * 64 + r;
            if (r + NWAVES < 64) {
#pragma unroll
                for (int j = 0; j < 4; ++j) xn[j] = *((const u32x2*)(XBr + (size_t)(t + NWAVES) * DM) + F.lane + 64 * j); }
            float lg[8];
#pragma unroll
            for (int e = 0; e < 8; ++e) lg[e] = 0.f;
#pragma unroll
            for (int j = 0; j < 4; ++j) { const u32x2 v2 = xc[j]; const f32x4 v = (f32x4){bflo(v2.x), bfhi(v2.x), bflo(v2.y), bfhi(v2.y)};
#pragma unroll
                for (int e = 0; e < 8; ++e) lg[e] += (v[0] * rw[e][j * 4 + 0] + v[1] * rw[e][j * 4 + 1]) + (v[2] * rw[e][j * 4 + 2] + v[3] * rw[e][j * 4 + 3]); }
#pragma unroll
            for (int e = 0; e < 8; ++e) lg[e] = wave_sum(lg[e]);
            if (F.lane == 0) { const float rs = rstd_of(ssq, t);
                int e1 = 0; float v1 = lg[0];
#pragma unroll
                for (int e = 1; e < 8; ++e) if (lg[e] > v1) { v1 = lg[e]; e1 = e; }
                int e2 = -1; float v2 = -INFINITY;
#pragma unroll
                for (int e = 0; e < 8; ++e) if (e != e1 && lg[e] > v2) { v2 = lg[e]; e2 = e; }
                const float w1 = 1.0f / (1.0f + __expf((v2 - v1) * rs)), w2 = 1.0f - w1;
                pe[r * 4 + 0] = e1; pe[r * 4 + 1] = e2; pwt[r * 2 + 0] = w1; pwt[r * 2 + 1] = w2; }
#pragma unroll
            for (int j = 0; j < 4; ++j) xc[j] = xn[j]; }
        __syncthreads();
        if (F.wave == 0) {
            const int r = F.lane, t = blk * 64 + r; const int e1 = pe[r * 4 + 0], e2 = pe[r * 4 + 1]; int p1 = 0, p2 = 0;
            const unsigned long long below = (1ull << r) - 1ull;
#pragma unroll
            for (int e = 0; e < 8; ++e) { const unsigned long long m = __ballot(e1 == e || e2 == e); const int pos = __popcll(m & below);
                if (e1 == e) p1 = pos; if (e2 == e) p2 = pos; if (r == 0) HG[blk * 8 + e] = __popcll(m); }
            TE[t] = e1 | (e2 << 8); TP[2 * t] = p1; TP[2 * t + 1] = p2; TW[2 * t] = pwt[r * 2 + 0]; TW[2 * t + 1] = pwt[r * 2 + 1]; }
        __syncthreads();
    }
}
__device__ __forceinline__ void moe_offsets(const unsigned* cnt, int (&off)[9], int (&cn)[8]) {
    int a = 0;
#pragma unroll
    for (int e = 0; e < 8; ++e) { cn[e] = (int)__hip_atomic_load(cnt + e, RLX_AGENT); off[e] = a; a += (cn[e] + 255) & ~255; }
    off[8] = a;
}
__device__ __forceinline__ void p_gather(Frame& F, unsigned char* ws, const u64* ssq, unsigned* cnt) {
    F.refresh();
    const bf16_t* XB = (const bf16_t*)(ws + WS_XB); bf16_t* HS = (bf16_t*)(ws + R_HS);
    const int* TE = (const int*)(ws + T_TE); const int* TP = (const int*)(ws + T_TP); const float* TW = (const float*)(ws + T_TW); const int* HG = (const int*)(ws + T_HG);
    int* PAIR = (int*)(ws + T_PAIR); float* DGATE = (float*)(ws + T_DGATE); float* DRS = (float*)(ws + T_DRS);
    LAS int* arr = (LAS int*)F.lds; LAS int* bt = arr + 2048;
    const int gw = F.vcu * NWAVES + F.wave, NGW = F.G * NWAVES;
    int off[9], cn[8], bse[8];
#pragma unroll
    for (int e = 0; e < 8; ++e) { off[e] = 0; cn[e] = 0; bse[e] = 0; }
    off[8] = 0;
    for (int blk = F.vcu; blk < NTOK / 64; blk += F.G) {
        __syncthreads();
        { const u32x4 hv = *((const u32x4*)HG + F.tid); *((LAS u32x4*)arr + F.tid) = hv; }
        __syncthreads();
        if (F.wave == 0) {
            int h[4][8], tot[8], inc[8];
#pragma unroll
            for (int k = 0; k < 4; ++k) { const u32x4 a = *((const LAS u32x4*)arr + (4 * F.lane + k) * 2), b = *((const LAS u32x4*)arr + (4 * F.lane + k) * 2 + 1);
                h[k][0] = (int)a.x; h[k][1] = (int)a.y; h[k][2] = (int)a.z; h[k][3] = (int)a.w; h[k][4] = (int)b.x; h[k][5] = (int)b.y; h[k][6] = (int)b.z; h[k][7] = (int)b.w; }
#pragma unroll
            for (int e = 0; e < 8; ++e) { tot[e] = (h[0][e] + h[1][e]) + (h[2][e] + h[3][e]); inc[e] = tot[e]; }
#pragma unroll
            for (int d = 1; d < 64; d <<= 1)
#pragma unroll
                for (int e = 0; e < 8; ++e) { const int v = __shfl_up(inc[e], d); inc[e] += (F.lane >= d) ? v : 0; }
            const int lb = blk >> 2, kb = blk & 3;
            if (F.lane == lb) {
#pragma unroll
                for (int e = 0; e < 8; ++e) { int bs = inc[e] - tot[e];
#pragma unroll
                    for (int k = 0; k < 3; ++k) bs += (k < kb) ? h[k][e] : 0;
                    bt[e] = bs; } }
            if (F.lane == 63) {
#pragma unroll
                for (int e = 0; e < 8; ++e) bt[8 + e] = inc[e]; } }
        __syncthreads();
        { int a = 0;
#pragma unroll
          for (int e = 0; e < 8; ++e) { bse[e] = bt[e]; cn[e] = bt[8 + e]; off[e] = a; a += (cn[e] + 255) & ~255; }
          off[8] = a; }
        if (blk == 0 && F.tid < 8) __hip_atomic_store(cnt + F.tid, (unsigned)bt[8 + F.tid], RLX_AGENT);
#define GT_LOAD(tt, TE_, TP0_, TP1_, TW0_, TW1_, SQ_, A0_, A1_) do { TE_ = TE[tt]; TP0_ = TP[2 * (tt)]; TP1_ = TP[2 * (tt) + 1]; TW0_ = TW[2 * (tt)]; TW1_ = TW[2 * (tt) + 1]; SQ_ = ssq[tt]; \
            A0_ = *((const u32x4*)(XB + (size_t)(tt) * DM) + 2 * F.lane); A1_ = *((const u32x4*)(XB + (size_t)(tt) * DM) + 2 * F.lane + 1); } while (0)
        int te, ten, tp0, tp0n, tp1, tp1n; float tw0, tw0n, tw1, tw1n; u64 sq, sqn; u32x4 a0, a0n, a1, a1n;
        GT_LOAD(blk * 64 + F.wave, te, tp0, tp1, tw0, tw1, sq, a0, a1);
        ten = te; tp0n = tp0; tp1n = tp1; tw0n = tw0; tw1n = tw1; sqn = sq; a0n = a0; a1n = a1;
        for (int r = F.wave; r < 64; r += NWAVES) { const int t = blk * 64 + r;
            if (r + NWAVES < 64) GT_LOAD(t + NWAVES, ten, tp0n, tp1n, tw0n, tw1n, sqn, a0n, a1n);
            const float rs = rstd_raw(sq);
#if MOE_F8
            u32x4 h8; h8.x = pk4_fp8(bflo(a0.x) * F8_HS, bfhi(a0.x) * F8_HS, bflo(a0.y) * F8_HS, bfhi(a0.y) * F8_HS); h8.y = pk4_fp8(bflo(a0.z) * F8_HS, bfhi(a0.z) * F8_HS, bflo(a0.w) * F8_HS, bfhi(a0.w) * F8_HS);
            h8.z = pk4_fp8(bflo(a1.x) * F8_HS, bfhi(a1.x) * F8_HS, bflo(a1.y) * F8_HS, bfhi(a1.y) * F8_HS); h8.w = pk4_fp8(bflo(a1.z) * F8_HS, bfhi(a1.z) * F8_HS, bflo(a1.w) * F8_HS, bfhi(a1.w) * F8_HS);
#endif
#pragma unroll
            for (int k = 0; k < 2; ++k) { const int e = (te >> (8 * k)) & 255; int o = 0;
#pragma unroll
                for (int q = 0; q < 8; ++q) o = (q == e) ? off[q] + bse[q] : o;
                const int dest = o + (k == 0 ? tp0 : tp1);
#if MOE_F8
                *((u32x4*)((unsigned char*)HS + (size_t)dest * DM) + F.lane) = h8;
#else
                *((u32x4*)(HS + (size_t)dest * DM) + 2 * F.lane) = a0; *((u32x4*)(HS + (size_t)dest * DM) + 2 * F.lane + 1) = a1;
#endif
                if (F.lane == 0) { PAIR[2 * t + k] = dest; DGATE[dest] = (k == 0 ? tw0 : tw1); DRS[dest] = rs; } }
            te = ten; tp0 = tp0n; tp1 = tp1n; tw0 = tw0n; tw1 = tw1n; sq = sqn; a0 = a0n; a1 = a1n; }
#undef GT_LOAD
    }
#pragma unroll
    for (int e = 0; e < 8; ++e) { const int lo = off[e] + cn[e], hi = off[e + 1];
        for (int r = lo + gw; r < hi; r += NGW) {
#if MOE_F8
            *((u32x4*)((unsigned char*)HS + (size_t)r * DM) + F.lane) = zero4();
#else
            *((u32x4*)(HS + (size_t)r * DM) + F.lane) = zero4(); *((u32x4*)(HS + (size_t)r * DM) + 64 + F.lane) = zero4();
#endif
            if (F.lane == 0) { DGATE[r] = 0.f; DRS[r] = 0.f; } } }
}
__device__ __forceinline__ void p_combine(Frame& F, unsigned char* ws, float* X, u64* ssq_next, const float* fnorm, bool final_) {
    F.refresh();
    const bf16_t* Y = (const bf16_t*)(ws + R_Y); const bf16_t* Yb = (const bf16_t*)(ws + R_Y1); bf16_t* XB = (bf16_t*)(ws + WS_XB); const int* PAIR = (const int*)(ws + T_PAIR);
    const int gw = F.vcu * NWAVES + F.wave, NGW = F.G * NWAVES;
#define CB_LOAD(tt, P1_, P2_, B_, A1_, A2_) do { const u32x2* xb_ = (const u32x2*)(XB + (size_t)(tt) * DM) + F.lane; \
        const u32x2* y1_ = (const u32x2*)(Y + (size_t)((MOE2_KSPLIT == 1 && (P1_) >= TAIL_M0 * 256) ? 0 : (P1_)) * DM) + F.lane; const u32x2* y2_ = (const u32x2*)(Y + (size_t)((MOE2_KSPLIT == 1 && (P2_) >= TAIL_M0 * 256) ? 0 : (P2_)) * DM) + F.lane; \
        _Pragma("unroll") for (int j = 0; j < 4; ++j) { B_[j] = xb_[64 * j]; A1_[j] = y1_[64 * j]; A2_[j] = y2_[64 * j]; } } while (0)
    u32x2 cb[4], c1[4], c2[4], nb[4], n1[4], n2[4];
#pragma unroll
    for (int j = 0; j < 4; ++j) { cb[j] = (u32x2){0u, 0u}; c1[j] = cb[j]; c2[j] = cb[j]; nb[j] = cb[j]; n1[j] = cb[j]; n2[j] = cb[j]; }
    int p1c = 0, p2c = 0, p1n = 0, p2n = 0;
    if (gw < NTOK) { p1c = PAIR[2 * gw]; p2c = PAIR[2 * gw + 1]; CB_LOAD(gw, p1c, p2c, cb, c1, c2); }
    if (gw + NGW < NTOK) { p1n = PAIR[2 * (gw + NGW)]; p2n = PAIR[2 * (gw + NGW) + 1]; }
    for (int t = gw; t < NTOK; t += NGW) { const int p1 = p1c, p2 = p2c; int p1nn = 0, p2nn = 0;
        if (t + NGW < NTOK) CB_LOAD(t + NGW, p1n, p2n, nb, n1, n2);
        if (t + 2 * NGW < NTOK) { p1nn = PAIR[2 * (t + 2 * NGW)]; p2nn = PAIR[2 * (t + 2 * NGW) + 1]; }
        f32x4* xr = (f32x4*)(X + (size_t)t * DM) + F.lane;
        f32x4 v[4]; float s = 0.f;
        const bool tail1 = MOE2_KSPLIT == 1 && p1 >= TAIL_M0 * 256, tail2 = MOE2_KSPLIT == 1 && p2 >= TAIL_M0 * 256;
        if (MOE2_KSPLIT == 1 && !tail1 && !tail2) {
#pragma unroll
            for (int j = 0; j < 4; ++j) { v[j][0] = (bflo(cb[j].x) + bflo(c1[j].x)) + bflo(c2[j].x); v[j][1] = (bfhi(cb[j].x) + bfhi(c1[j].x)) + bfhi(c2[j].x);
                v[j][2] = (bflo(cb[j].y) + bflo(c1[j].y)) + bflo(c2[j].y); v[j][3] = (bfhi(cb[j].y) + bfhi(c1[j].y)) + bfhi(c2[j].y); }
        } else {
#pragma unroll
        for (int j = 0; j < 4; ++j) { const u32x2 b2 = cb[j]; v[j] = (f32x4){bflo(b2.x), bfhi(b2.x), bflo(b2.y), bfhi(b2.y)}; }
#pragma unroll
        for (int k = 0; k < 2; ++k) { const int p = k == 0 ? p1 : p2;
            if (MOE2_KSPLIT == 1 && p >= TAIL_M0 * 256) {
                for (int ks = 0; ks < TAIL_KS; ++ks) { const u32x2* yp = (const u32x2*)(Yb + ((size_t)ks * TAIL_ROWS + (size_t)(p - TAIL_M0 * 256)) * DM) + F.lane;
#pragma unroll
                    for (int j = 0; j < 4; ++j) { const u32x2 a = yp[64 * j]; v[j][0] += bflo(a.x); v[j][1] += bfhi(a.x); v[j][2] += bflo(a.y); v[j][3] += bfhi(a.y); } }
            } else {
#pragma unroll
                for (int j = 0; j < 4; ++j) { const u32x2 a = k == 0 ? c1[j] : c2[j]; v[j][0] += bflo(a.x); v[j][1] += bfhi(a.x); v[j][2] += bflo(a.y); v[j][3] += bfhi(a.y); }
                if (MOE2_KSPLIT == 2) { const u32x2* y3 = (const u32x2*)(Yb + (size_t)p * DM) + F.lane;
#pragma unroll
                    for (int j = 0; j < 4; ++j) { const u32x2 a = y3[64 * j]; v[j][0] += bflo(a.x); v[j][1] += bfhi(a.x); v[j][2] += bflo(a.y); v[j][3] += bfhi(a.y); } } } }
        }
#pragma unroll
        for (int j = 0; j < 4; ++j) s += (v[j][0] * v[j][0] + v[j][1] * v[j][1]) + (v[j][2] * v[j][2] + v[j][3] * v[j][3]);
        s = wave_sum(s);
        if (!final_) {
#pragma unroll
            for (int j = 0; j < 4; ++j) { u32x2 w; w.x = cvt_pk_bf16(v[j][0], v[j][1]); w.y = cvt_pk_bf16(v[j][2], v[j][3]); *((u32x2*)(XB + (size_t)t * DM) + F.lane + 64 * j) = w; }
            if (F.lane == 0) ssq_next[t] = ssq_fix(s);
        } else { float rs = rsqrtf(s * (1.0f / DM) + EPS);
#ifdef TPROBE
            rs *= 1.0f + __uint_as_float(__hip_atomic_load((const unsigned*)(ws + WS_CTL) + 32, RLX_AGENT));
#endif
#pragma unroll
            for (int j = 0; j < 4; ++j) { const f32x4 g = *((const f32x4*)fnorm + F.lane + 64 * j); xr[64 * j] = v[j] * rs * g; } }
#pragma unroll
        for (int j = 0; j < 4; ++j) { cb[j] = nb[j]; c1[j] = n1[j]; c2[j] = n2[j]; }
        p1c = p1n; p2c = p2n; p1n = p1nn; p2n = p2nn;
    }
}

#undef CB_LOAD
constexpr int NPH = 31;
struct Args { const float* in[28]; float* out; unsigned char* ws; int ph_lo, ph_hi; };
__global__ void __launch_bounds__(NWAVES * 64, 2) mk_fwd(Args args) {
    extern __shared__ __attribute__((aligned(16))) unsigned char lds_raw[];
    Frame F;
    F.lds = (LAS unsigned char*)lds_raw;
    F.refresh();
    F.G = gridDim.x; { const int bx = blockIdx.x; F.vcu = (F.G % 8 == 0) ? (bx % 8) * (F.G / 8) + bx / 8 : bx; }
    unsigned char* ws = args.ws;
    F.ctl = (unsigned*)(ws + WS_CTL);
    volatile LAS unsigned* MISC = (volatile LAS unsigned*)(F.lds + MISC_OFF);
    for (int u = F.tid; u < (LDS_BYTES - LDSCTL_OFF) / 4; u += NWAVES * 64) ((LAS unsigned*)(F.lds + LDSCTL_OFF))[u] = 0u;
    __syncthreads();
    const int lo = args.ph_lo, hi = args.ph_hi;
    XcdBarrier bar = xcd_barrier_post(F.ctl + CW_BAR + lo * XCD_BAR_WORDS, MISC + 8);
#ifndef PH_MASK
#define PH_MASK 0xFFFF
#endif
#define PT(t) (((PH_MASK) >> (t)) & 1)
#ifndef REP_MASK
#define REP_MASK 0
#endif
#define NREP(t) ((((REP_MASK) >> (t)) & 1) ? 2 : 1)
#define REPEAT(t) for (int rep_ = 0; rep_ < NREP(t); ++rep_, (rep_ < NREP(t) ? xcd_barrier(bar) : (void)0))
#define IN(k) (lo <= (k) && (k) < hi)
#define SEAM(k) do { if ((k) + 1 < hi) xcd_barrier(bar); } while (0)
    const float* const* in = args.in;
    float* X = args.out;
    u64* SSQ = (u64*)(ws + WS_SSQ);
    bf16_t* XB = (bf16_t*)(ws + WS_XB);
    const int bx = (int)blockIdx.x;

    if (PT(0) && IN(0)) { asm volatile("; PHASE_MARK 0"); REPEAT(0) p0_prologue(F, in, ws); SEAM(0); }

    for (int lp = 0; lp < 2; ++lp) {
        const int pb = 1 + 15 * lp;
        bf16_t* WE = (bf16_t*)(ws + WS_WE) + (size_t)lp * E_SIZE; bf16_t* WO = (bf16_t*)(ws + WS_WO) + (size_t)lp * O_SIZE;
        u64* ssq0 = SSQ + (size_t)(4 * lp) * NTOK;
        u64* ssql = (u64*)(ws + WS_SSQL) + (size_t)(2 * lp) * NTOK;
        if (PT(1) && IN(pb + 0)) { asm volatile("; PHASE_MARK 1");
            pg8::DenseOrder S; S.init(XB, DM, WE + E_WIN, DM, NTOK, 1024, F.G, bx);
            pg8::EpiZ E{(bf16_t*)(ws + R_Z), 1024, ssq0, ssql, ssql + NTOK, (bf16_t*)(ws + R_K), (const float*)(ws + T_COS), (const float*)(ws + T_SIN)};
            REPEAT(1) pg8::GEMM_BF16(F.lds, pg8::Gemm{DM, DM, DM, 0, 0}, S, E);
            SEAM(pb + 0);
        }
        if (PT(2) && IN(pb + 1)) { asm volatile("; PHASE_MARK 2"); REPEAT(2) p_pooled(F, ws, bx); }
        if (PT(3) && IN(pb + 2)) { asm volatile("; PHASE_MARK 3");
            REPEAT(3) {
            { pg8::DenseOrder S; S.init((const bf16_t*)(ws + R_Z) + 512, 1024, WE + E_WQ, 256, NTOK, 768, F.G, bx);
              pg8::EpiQ E{(bf16_t*)(ws + R_Q), ssql, (const float*)(ws + T_COS), (const float*)(ws + T_SIN)};
              pg8::GEMM_BF16(F.lds, pg8::Gemm{1024, 256, 256, 0, 0}, S, E); }
            { pg8::DenseOrder S; S.init((const bf16_t*)(ws + R_Z) + 768, 1024, WE + E_WKV, 256, NTOK, 1024, F.G, bx);
              pg8::EpiKV E{(bf16_t*)(ws + R_K), (bf16_t*)(ws + R_V), ssql + NTOK};
              pg8::GEMM_BF16(F.lds, pg8::Gemm{1024, 256, 128, 0, 0}, S, E); }
            }
            SEAM(pb + 2);
        }
        if (PT(4) && IN(pb + 3)) { asm volatile("; PHASE_MARK 4");
            const bf16_t* Q = (const bf16_t*)(ws + R_Q); const bf16_t* Kb = (const bf16_t*)(ws + R_K); const bf16_t* Vb = (const bf16_t*)(ws + R_V); bf16_t* MIX = (bf16_t*)(ws + R_MIX);
            int pi0 = F.vcu; asm volatile("" : "+s"(pi0));
            REPEAT(4)
            for (int pi = pi0; pi < 256; pi += F.G) { const int bh = pi >> 3, s = pi & 7, b = bh >> 3, h = bh & 7;
#pragma unroll 1
                for (int k = 0; k < 2; ++k) { const int qb = k == 0 ? (15 - s) : s;
                    attn_unit<96, false>(Q + 96 * h, 768, Kb + 96 * h, 768, Vb + 64 * h, 512, MIX + 512 + 64 * h, 1024, b, qb, F.lds, nullptr); } }
            SEAM(pb + 3);
        }
        if (PT(5) && IN(pb + 4)) { asm volatile("; PHASE_MARK 5");
            pg8::DenseOrder S; S.init((const bf16_t*)(ws + R_MIX), 1024, WE + E_WOUT, 1024, NTOK, 1024, F.G, bx);
            pg8::EpiRes E{lp == 0 ? in[0] : nullptr, XB, ssq0 + NTOK, FFN1_F8 ? (unsigned char*)(ws + WS_XB8) : nullptr};
            pg8::GEMM_BF16(F.lds, pg8::Gemm{1024, 1024, 1024, 0, 0}, S, E);
            SEAM(pb + 4);
        }
        if (PT(6) && IN(pb + 5)) { asm volatile("; PHASE_MARK 6");
            pg8::EpiSwiGLU<0> E{(bf16_t*)(ws + R_ACT), FF, ssq0 + NTOK};
#if FFN1_F8
            pg8::DenseOrder S; S.init(ws + WS_XB8, DM, WE + E_WGU, DM, NTOK, 2 * FF, F.G, bx); S.esz = 1;
            REPEAT(6) pg8::gemm_phase<pg8::EpiSwiGLU<0>, pg8::DenseOrder, true, true>(F.lds, pg8::Gemm{DM, DM, DM, SC_HS, SC_W}, S, E);
#else
            pg8::DenseOrder S; S.init(XB, DM, WE + E_WGU, DM, NTOK, 2 * FF, F.G, bx);
            REPEAT(6) pg8::GEMM_BF16(F.lds, pg8::Gemm{DM, DM, DM, 0, 0}, S, E);
#endif
            SEAM(pb + 5);
        }
        if (PT(7) && IN(pb + 6)) { asm volatile("; PHASE_MARK 7");
            pg8::DenseOrder S; S.init((const bf16_t*)(ws + R_ACT), FF, WE + E_WDN, FF, NTOK, 1024, F.G, bx);
            pg8::EpiRes E{nullptr, XB, ssq0 + 2 * NTOK, nullptr};
            pg8::GEMM_BF16(F.lds, pg8::Gemm{FF, FF, FF, 0, 0}, S, E);
            SEAM(pb + 6);
        }
        if (PT(8) && IN(pb + 7)) { asm volatile("; PHASE_MARK 8");
            pg8::DenseOrder S; S.init(XB, DM, WO + O_WIN, DM, NTOK, 2560, F.G, bx);
            pg8::EpiOddIn E{(bf16_t*)(ws + R_QKV), (bf16_t*)(ws + R_UV), ssq0 + 2 * NTOK};
            REPEAT(8) pg8::GEMM_BF16(F.lds, pg8::Gemm{DM, DM, DM, 0, 0}, S, E);
            SEAM(pb + 7);
        }
        if (PT(9) && IN(pb + 8)) { asm volatile("; PHASE_MARK 9");
            const bf16_t* QKV = (const bf16_t*)(ws + R_QKV); const bf16_t* UV = (const bf16_t*)(ws + R_UV); bf16_t* MIX = (bf16_t*)(ws + R_MIX);
            const float* rb = in[16] + (size_t)lp * 8 * 257;
            int u0 = F.vcu; asm volatile("" : "+s"(u0));
            REPEAT(9)
            for (int u = u0; u < 512; u += F.G) { const int bh = u >> 4, qb = u & 15, b = bh >> 3, h = bh & 7;
                attn_unit<64, true>(QKV + 64 * h, 1536, QKV + 512 + 64 * h, 1536, QKV + 1024 + 64 * h, 1536, MIX + 64 * h, 1024, b, qb, F.lds, rb + h * 257); }
            REPEAT(10)
            for (int u = u0; u < 512; u += F.G) { const int g = u & 3, n = (u >> 2) & 31, b = u >> 7;
                sgu_unit(UV, in[17] + (size_t)lp * 512, in[18] + (size_t)lp * 512, in[19] + (size_t)lp * 4 * 128 * 128, in[20] + (size_t)lp * 512, MIX, b, n, g, F.lds); }
            SEAM(pb + 8);
        }
        if (PT(10) && IN(pb + 9)) { asm volatile("; PHASE_MARK 10");
            pg8::DenseOrder S; S.init((const bf16_t*)(ws + R_MIX), 1024, WO + O_WOUT, 1024, NTOK, 1024, F.G, bx);
            pg8::EpiRes E{nullptr, XB, ssq0 + 3 * NTOK, nullptr};
            pg8::GEMM_BF16(F.lds, pg8::Gemm{1024, 1024, 1024, 0, 0}, S, E);
            SEAM(pb + 9);
        }
        unsigned* cnt = F.ctl + CW_CNT + 64 * lp;
        if (PT(11) && IN(pb + 10)) { asm volatile("; PHASE_MARK 11"); p_route(F, ws, XB, ssq0 + 3 * NTOK, in[22] + (size_t)lp * 1024, in[23] + (size_t)lp * 8192, cnt); SEAM(pb + 10); }
        if (PT(12) && IN(pb + 11)) { asm volatile("; PHASE_MARK 12"); REPEAT(12) p_gather(F, ws, ssq0 + 3 * NTOK, cnt); SEAM(pb + 11); }
        if (PT(13) && IN(pb + 12)) { asm volatile("; PHASE_MARK 13");
            int off[9], cn[8]; moe_offsets(cnt, off, cn);
            pg8::MoeOrder S; S.A = (const char*)(ws + R_HS); S.Bt = (const char*)(WO + O_WGU); S.esz = MOE_F8 ? 1 : 2; S.bstride = (size_t)2 * EFF * 1024 * S.esz; S.lda = 1024; S.ldb = 1024; S.nM = off[8] >> 8; S.nN = 2 * EFF / 256; S.G = F.G; S.c = bx; asm volatile("" : "+s"(S.c)); S.ksplit = 1; S.khalf = 0; S.tailM0 = 1 << 20; S.tail_ks = 1; S.tail_kb = 256;
#pragma unroll
            for (int e = 0; e < 8; ++e) S.tend[e] = off[e + 1] >> 8;
            pg8::EpiSwiGLU<MOE_F8 ? 2 : 1> E{(bf16_t*)(ws + R_ACT2), EFF, (const float*)(ws + T_DRS)};
            REPEAT(13) pg8::gemm_phase<pg8::EpiSwiGLU<MOE_F8 ? 2 : 1>, pg8::MoeOrder, true, MOE_F8 != 0>(F.lds, pg8::Gemm{1024, 1024, 1024, SC_HS, SC_W, lp == 0 ? (float*)(F.ctl + 32) : nullptr}, S, E);
            SEAM(pb + 12);
        }
        if (PT(14) && IN(pb + 13)) { asm volatile("; PHASE_MARK 14");
            int off[9], cn[8]; moe_offsets(cnt, off, cn);
            pg8::MoeOrder S; S.A = (const char*)(ws + R_ACT2); S.Bt = (const char*)(WO + O_WDN); S.esz = MOE_F8 ? 1 : 2; S.bstride = (size_t)1024 * EFF * S.esz; S.lda = EFF; S.ldb = EFF; S.nM = off[8] >> 8; S.nN = 4; S.G = F.G; S.c = bx; asm volatile("" : "+s"(S.c)); S.ksplit = MOE2_KSPLIT; S.khalf = (EFF / 2) * S.esz; S.tailM0 = MOE2_KSPLIT == 1 ? TAIL_M0 : (1 << 20); S.tail_ks = TAIL_KS; S.tail_kb = EFF * S.esz / TAIL_KS;
#pragma unroll
            for (int e = 0; e < 8; ++e) S.tend[e] = off[e + 1] >> 8;
            pg8::EpiY E{(bf16_t*)(ws + R_Y), (const float*)(ws + T_DGATE), (size_t)(R_Y1 - R_Y) / 2, MOE2_KSPLIT == 1 ? (bf16_t*)(ws + R_Y1) : nullptr, TAIL_M0 * 256};
            REPEAT(14) pg8::gemm_phase<pg8::EpiY, pg8::MoeOrder, true, MOE_F8 != 0>(F.lds, pg8::Gemm{EFF, EFF, EFF / MOE2_KSPLIT, SC_ACT, SC_W}, S, E);
            SEAM(pb + 13);
        }
        if (PT(15) && IN(pb + 14)) { asm volatile("; PHASE_MARK 15"); p_combine(F, ws, X, ssq0 + 4 * NTOK, in[27], lp == 1); SEAM(pb + 14); }
    }
#undef IN
#undef SEAM
}

extern "C" void kernel_launch(void* const* d_in, const int* in_sizes, int n_in, void* d_out, int out_size, void* d_ws, size_t ws_size, hipStream_t stream) {
    static int grid = 0;
    if (grid == 0) {
        if (n_in != 28 || in_sizes[0] != NTOK * DM || out_size != NTOK * DM || ws_size < WS_END) { fprintf(stderr, "kernel_launch: unexpected shapes / workspace (%d inputs, ws %zu, need %zu); nothing launched\n", n_in, ws_size, (size_t)WS_END); grid = -1; return; }
        int dev = 0, cus = 0, per_cu = 0;
        if (hipGetDevice(&dev) != hipSuccess || hipDeviceGetAttribute(&cus, hipDeviceAttributeMultiprocessorCount, dev) != hipSuccess) { grid = -1; return; }
        if (hipFuncSetAttribute((const void*)mk_fwd, hipFuncAttributeMaxDynamicSharedMemorySize, LDS_BYTES) != hipSuccess) { fprintf(stderr, "kernel_launch: hipFuncSetAttribute failed\n"); grid = -1; return; }
        if (hipOccupancyMaxActiveBlocksPerMultiprocessor(&per_cu, (const void*)mk_fwd, NWAVES * 64, LDS_BYTES) != hipSuccess || per_cu < 1) fprintf(stderr, "kernel_launch: occupancy query reports %d\n", per_cu);
        (void)hipGetLastError();
        grid = cus;
        if (grid > 256) grid = 256;
        grid &= ~7;
    }
    if (grid <= 0) return;
    if (hipMemsetAsync((char*)d_ws + WS_CTL, 0, CTL_ZERO_BYTES, stream) != hipSuccess) return;
    Args a{};
    for (int i = 0; i < 28; ++i) a.in[i] = (const float*)d_in[i];
    a.out = (float*)d_out; a.ws = (unsigned char*)d_ws;
#if MK_N_LAUNCHES == 1
    a.ph_lo = 0; a.ph_hi = NPH;
    hipLaunchKernelGGL(mk_fwd, dim3(grid), dim3(NWAVES * 64), LDS_BYTES, stream, a);
#else
    for (int p = 0; p < NPH; ++p) { a.ph_lo = p; a.ph_hi = p + 1; hipLaunchKernelGGL(mk_fwd, dim3(grid), dim3(NWAVES * 64), LDS_BYTES, stream, a); }
#endif
}
```

```cpp
#include <hip/hip_runtime.h>
#include <cstdio>
#include <cstdint>

#ifndef MK_N_LAUNCHES
#define MK_N_LAUNCHES 1
#endif

#ifndef TPROBE_OFS
#define TPROBE_OFS 0.0f
#endif
#ifndef TPROBE_BLK
#define TPROBE_BLK 0
#define TPROBE_TID 0
#endif
#ifndef GEMM4
#define GEMM4 0
#endif
#if GEMM4
#define GEMM_BF16 gemm_phase4
#else
#define GEMM_BF16 gemm_phase
#endif
#ifndef MOE_F8
#define MOE_F8 1
#endif
constexpr int MOE2_KSPLIT = MOE_F8 ? 1 : 2;
#ifndef FFN1_F8
#define FFN1_F8 1
#endif
#define LAS __attribute__((address_space(3)))
#define GAS __attribute__((address_space(1)))
typedef unsigned short bf16_t;
typedef short bf16x8 __attribute__((ext_vector_type(8)));
typedef short s16x4 __attribute__((ext_vector_type(4)));
typedef float f32x4 __attribute__((ext_vector_type(4)));
typedef float f32x2 __attribute__((ext_vector_type(2)));
typedef float f32x16 __attribute__((ext_vector_type(16)));
typedef unsigned u32x4 __attribute__((ext_vector_type(4)));
typedef unsigned u32x2 __attribute__((ext_vector_type(2)));

constexpr int NTOK = 16384, DM = 1024, SEQ = 4096;
constexpr float EPS = 1e-6f;
constexpr float LOG2E = 1.4426950408889634f;
constexpr float QS_MLA = 0.10206207261596575f * LOG2E;
constexpr float QS_BAND = 0.125f * LOG2E;
constexpr int FF = 2816, EFF = 3584, NEXP = 8;
constexpr int MOE_ROWS = 34816, TAIL_M0 = 128, TAIL_KS = 7, TAIL_ROWS = MOE_ROWS - TAIL_M0 * 256;
constexpr int MOE_ROWS_ = 34816;

constexpr size_t MiB = 1u << 20, KiB = 1024;
constexpr size_t WS_CTL = 0, CTL_ZERO_BYTES = 3 * MiB;
constexpr int CW_TMO = 0, CW_CNT = 64, CW_BAR = 4096;
constexpr size_t WS_SSQL = 2 * MiB + 256 * KiB;
constexpr size_t WS_SSQ = 1 * MiB;
constexpr size_t WS_TAB = 3 * MiB;
constexpr size_t T_COS = WS_TAB, T_SIN = WS_TAB + 256 * KiB, T_RQ = WS_TAB + 512 * KiB, T_RKV = WS_TAB + 576 * KiB, T_TE = WS_TAB + 640 * KiB,
                 T_TP = WS_TAB + 704 * KiB, T_TW = WS_TAB + 832 * KiB, T_PAIR = WS_TAB + 960 * KiB, T_DGATE = WS_TAB + 1088 * KiB, T_DRS = WS_TAB + 1280 * KiB, T_HG = WS_TAB + 1472 * KiB;
constexpr size_t WS_W = 5 * MiB;
constexpr size_t E_WIN = 0, E_WQ = 1048576, E_WKV = 1245184, E_WOUT = 1507328, E_WGU = 2555904, E_WDN = 8323072, E_SIZE = 11206656;
constexpr size_t O_WIN = 0, O_WOUT = 2621440, O_WGU = 3670016, O_WDN = 62390272, O_SIZE = 91750400;
constexpr size_t WS_WE = WS_W, WS_WO = WS_W + 2 * E_SIZE * 2;
static_assert(WS_WO + 2 * O_SIZE * 2 <= 400 * MiB, "weights");
constexpr size_t WS_XB = 400 * MiB;
constexpr size_t WS_R = 432 * MiB;
constexpr size_t R_Z = WS_R, R_Q = WS_R + 32 * MiB, R_K = WS_R + 56 * MiB, R_V = WS_R + 80 * MiB, R_MIX = WS_R + 96 * MiB, R_ACT = WS_R;
constexpr size_t R_QKV = WS_R, R_UV = WS_R + 48 * MiB, R_HS = WS_R, R_ACT2 = WS_R + 68 * MiB, R_Y = WS_R, R_Y1 = WS_R + 306 * MiB;
constexpr size_t WS_XB8 = WS_R + 374 * MiB;
constexpr size_t WS_END = WS_XB8 + 16 * MiB;
static_assert((size_t)MOE_ROWS * EFF * 2 <= 238 * MiB && (size_t)MOE_ROWS * 1024 * 2 <= 68 * MiB, "moe buffers");

constexpr int RING_BYTES = 131072, LDSCTL_OFF = 135168, MISC_OFF = LDSCTL_OFF + 320, LDS_BYTES = 151552;
constexpr int NWAVES = 8;

#define RLX_AGENT __ATOMIC_RELAXED, __HIP_MEMORY_SCOPE_AGENT
#define LDS_WAIT() asm volatile("s_waitcnt lgkmcnt(0)" ::: "memory")
#define VM_WAIT() asm volatile("s_waitcnt vmcnt(0)" ::: "memory")

typedef __bf16 bf16x2_t __attribute__((ext_vector_type(2)));
__device__ __forceinline__ unsigned cvt_pk_bf16(float lo, float hi) { const f32x2 v = {lo, hi}; const bf16x2_t b = __builtin_convertvector(v, bf16x2_t); return __builtin_bit_cast(unsigned, b); }
__device__ __forceinline__ float bf2f(unsigned short b) { return __uint_as_float(((unsigned)b) << 16); }
__device__ __forceinline__ float bflo(unsigned w) { return __uint_as_float(w << 16); }
__device__ __forceinline__ float bfhi(unsigned w) { return __uint_as_float(w & 0xffff0000u); }
__device__ __forceinline__ unsigned short f2bf(float f) { return (unsigned short)(cvt_pk_bf16(f, 0.f) & 0xffffu); }
__device__ __forceinline__ u32x4 zero4() { unsigned z; asm volatile("v_mov_b32 %0, 0" : "=v"(z)); return (u32x4){z, z, z, z}; }
__device__ __forceinline__ float wave_sum(float v) {
#pragma unroll
    for (int o = 1; o < 64; o <<= 1) v += __shfl_xor(v, o);
    return v;
}
__device__ __forceinline__ float clamp448(float x) { return __builtin_amdgcn_fmed3f(x, -448.0f, 448.0f); }
__device__ __forceinline__ unsigned pk4_fp8(float a, float b, float c, float d) { unsigned w = 0; w = __builtin_amdgcn_cvt_pk_fp8_f32(clamp448(a), clamp448(b), w, false); w = __builtin_amdgcn_cvt_pk_fp8_f32(clamp448(c), clamp448(d), w, true); return w; }
constexpr float F8_WS = 64.0f, F8_HS = 4.0f, F8_ACT = 8.0f;
constexpr int SC_W = 0x79797979, SC_HS = 0x7D7D7D7D, SC_ACT = 0x7C7C7C7C;
#ifndef WT_STORES
#define WT_STORES 1
#endif
struct WtBuf {
    __amdgpu_buffer_rsrc_t r; unsigned char* base;
    __device__ __forceinline__ void init(void* p) { base = (unsigned char*)p; const unsigned long long b = (unsigned long long)p;
        const unsigned lo = (unsigned)__builtin_amdgcn_readfirstlane((int)(unsigned)b), hi = (unsigned)__builtin_amdgcn_readfirstlane((int)(unsigned)(b >> 32));
        r = __builtin_amdgcn_make_buffer_rsrc((void*)(((unsigned long long)hi << 32) | lo), 0, 0x7FFFFFFF, 0x00020000); }
    __device__ __forceinline__ void st16(size_t off, u32x4 v) const {
#if WT_STORES
        __builtin_amdgcn_raw_buffer_store_b128(v, r, (int)(unsigned)off, 0, 16);
#else
        *(u32x4*)(base + off) = v;
#endif
    }
    __device__ __forceinline__ void st8(size_t off, u32x2 v) const {
#if WT_STORES
        __builtin_amdgcn_raw_buffer_store_b64(v, r, (int)(unsigned)off, 0, 16);
#else
        *(u32x2*)(base + off) = v;
#endif
    }
};
typedef unsigned long long u64;
__device__ __forceinline__ u64 ssq_fix(float s) { return (u64)((double)s * 4294967296.0); }
__device__ __forceinline__ float ssq_get(const u64* p, int row) { const u64 v = p[row]; return (float)(unsigned)(v >> 32) + (float)(unsigned)v * (1.0f / 4294967296.0f); }
__device__ __forceinline__ float rstd_raw(u64 v) { const float f = (float)(unsigned)(v >> 32) + (float)(unsigned)v * (1.0f / 4294967296.0f); return rsqrtf(f * (1.0f / DM) + EPS); }
__device__ __forceinline__ float ssq_f32(u64 v) { return (float)(unsigned)(v >> 32) + (float)(unsigned)v * (1.0f / 4294967296.0f); }
__device__ __forceinline__ float rstd_of(const u64* p, int row) { return rsqrtf(ssq_get(p, row) * (1.0f / DM) + EPS); }
__device__ __forceinline__ float fast_exp2(float x) { return __builtin_amdgcn_exp2f(x); }
__device__ __forceinline__ float fast_rcp(float x) { return __builtin_amdgcn_rcpf(x); }
__device__ __forceinline__ float sigmoidf_(float x) { return fast_rcp(1.0f + fast_exp2(-x * LOG2E)); }

__device__ __forceinline__ int opaque_tid() { int t = threadIdx.x; asm volatile("" : "+v"(t)); return t; }

namespace pg8 {
constexpr int BM = 256, BK = 64, HALF = 128, HTB = HALF * BK * 2, STAGE_BYTES = 8 * HTB, NXCD = 8, WGM = 8;
__host__ __device__ __forceinline__ int lds_byte(int r, int c) { const int st = (r >> 4) * 2 + (c >> 5), rr = r & 15, cc = c & 31, ob = rr * 64 + cc * 2; return st * 1024 + (ob ^ (((ob >> 9) & 1) << 5)); }
__host__ __device__ __forceinline__ void stage_rc(int b, int& R, int& C) { const int st = b / 1024, sb = b % 1024, swz = sb ^ (((sb >> 9) & 1) << 5); R = (st >> 1) * 16 + swz / 64; C = (st & 1) * 32 + (swz % 64) / 2; }
__host__ __device__ __forceinline__ int perm32(int rho) { const int n = rho >> 4, i = rho & 15; return 8 * (i >> 2) + 4 * n + (i & 3); }

struct Unit { int pm, pn, kh, nt; const char* a; const char* b; };
struct Gemm { int lda, ldb, K, sA, sB; float* tp = nullptr; };
typedef int i32x8 __attribute__((ext_vector_type(8)));

__device__ __forceinline__ int idiv_small(int a, int d) {
    int q = (int)(((float)a + 0.5f) * __builtin_amdgcn_rcpf((float)d));
    q -= (q * d > a) ? 1 : 0; q += ((q + 1) * d <= a) ? 1 : 0; return q;
}
__device__ __forceinline__ void tile_of(int L, int nM, int nN, int& pm, int& pn) {
    const int nwg = nM * nN;
    int wgid = L; { const int q = nwg >> 3, r = nwg & 7, xcd = wgid & 7, off = wgid >> 3; wgid = (xcd < r ? xcd * (q + 1) : r * (q + 1) + (xcd - r) * q) + off; }
    const int nig = WGM * nN, gid = idiv_small(wgid, nig), rem = wgid - gid * nig, fm = gid * WGM, gsz = (nM - fm) < WGM ? (nM - fm) : WGM;
    const int pq = gsz == WGM ? (rem >> 3) : idiv_small(rem, gsz);
    pm = fm + (rem - pq * gsz); pn = pq;
}
struct DenseOrder {
    const char* A; const char* Bt; int lda, ldb, nM, nN, G, c, esz = 2;
    __device__ __forceinline__ void init(const void* A_, int lda_, const void* Bt_, int ldb_, int M, int N, int G_, int c_) { A = (const char*)A_; Bt = (const char*)Bt_; lda = lda_; ldb = ldb_; nM = M / BM; nN = N / BM; G = G_; c = c_; asm volatile("" : "+s"(c)); }
    __device__ __forceinline__ bool next(int i, Unit& u) const {
        const long L = (long)i * G + c; if (L >= (long)nM * nN) return false;
        tile_of((int)L, nM, nN, u.pm, u.pn); u.kh = 0; u.nt = 0;
        u.a = A + (size_t)u.pm * BM * lda * esz; u.b = Bt + (size_t)u.pn * BM * ldb * esz; return true;
    }
};
struct MoeOrder {
    const char* A; const char* Bt; size_t bstride; int lda, ldb, esz, nM, nN, G, c, ksplit, khalf, tailM0, tail_ks, tail_kb; int tend[8];
    __device__ __forceinline__ bool next(int i, Unit& u) const {
        const long L = (long)i * G + c; const int nMm = nM < tailM0 ? nM : tailM0, nmain = nMm * nN * ksplit, ntail = (nM - nMm) * nN * tail_ks;
        if (L >= (long)(nmain + ntail)) return false;
        size_t koff = 0;
        if (L < nmain) { const int nwg = nMm * nN; const int kh = (L >= nwg) ? 1 : 0; tile_of((int)(L - (long)kh * nwg), nMm, nN, u.pm, u.pn); u.kh = kh; u.nt = 0; koff = (size_t)kh * khalf; }
        else { const int t = (int)L - nmain, ks = t % tail_ks, tu = t / tail_ks; u.pm = nMm + tu / nN; u.pn = tu % nN; u.kh = 1 + ks; u.nt = tail_kb / (BK * 2); koff = (size_t)ks * tail_kb; }
        int e = 0;
#pragma unroll
        for (int k = 0; k < 7; ++k) e += (u.pm >= tend[k]) ? 1 : 0;
        u.a = A + (size_t)u.pm * BM * lda * esz + koff; u.b = Bt + (size_t)e * bstride + (size_t)u.pn * BM * ldb * esz + koff; return true;
    }
};

template <class Epi, class Sched, bool ALIGN_EPI = true, bool F8 = false>
__device__ __forceinline__ void gemm_phase(LAS unsigned char* lds, const Gemm g, const Sched& S, const Epi& E) {
    const int tid = opaque_tid(), wid = __builtin_amdgcn_readfirstlane(tid >> 6), lane = tid & 63, wr = wid >> 2, wc = wid & 3, fr = lane & 15, fq = lane >> 4;
    int K = g.K; asm volatile("" : "+s"(K));
    constexpr int ESZ = F8 ? 1 : 2;
    const int nt_def = K * ESZ / (BK * 2);
    unsigned voffA[2], voffB[2];
#pragma unroll
    for (int i = 0; i < 2; ++i) { int R, C; stage_rc(tid * 16 + i * 8192, R, C); const int Rb = Epi::PERM ? ((R & ~31) + perm32(R & 31)) : R;
        voffA[i] = (unsigned)(R * g.lda * ESZ + C * 2); voffB[i] = (unsigned)(Rb * g.ldb * ESZ + C * 2); }
    const size_t kstep = (size_t)(BK * 2);
    const size_t hstepA = (size_t)HALF * g.lda * ESZ, hstepB = (size_t)HALF * g.ldb * ESZ;
    const unsigned ldsw = (unsigned)wid * 1024u;
    const int aoff = lds_byte(wr * 64 + fr, fq * 8), boff = lds_byte(wc * 32 + fr, fq * 8);
    const int sclA = g.sA, sclB = g.sB;
#define PG8_SA(b, h) (((b) * 2 + (h)) * HTB)
#define PG8_SB(b, h) ((4 + (b) * 2 + (h)) * HTB)
#define PG8_STAGE(bufoff, gbase, voff) do { _Pragma("unroll") for (int _i = 0; _i < 2; ++_i) \
        __builtin_amdgcn_global_load_lds((const unsigned*)((const char*)(gbase) + (voff)[_i]), (LAS unsigned*)(lds + (bufoff) + ldsw + _i * 8192), 16, 0, 0); } while (0)
#define PG8_LD32(p_) ({ const u32x4 lo_ = *(const LAS u32x4*)(p_), hi_ = *(const LAS u32x4*)((p_) + 1024); (i32x8){(int)lo_.x, (int)lo_.y, (int)lo_.z, (int)lo_.w, (int)hi_.x, (int)hi_.y, (int)hi_.z, (int)hi_.w}; })
#define PG8_LDA(dst, b, h) do { if constexpr (F8) { _Pragma("unroll") for (int m = 0; m < 4; ++m) dst##8[m] = PG8_LD32(lds + PG8_SA(b, h) + aoff + m * 2048); } else { _Pragma("unroll") for (int m = 0; m < 4; ++m) _Pragma("unroll") for (int k = 0; k < 2; ++k) dst[m][k] = *(const LAS bf16x8*)(lds + PG8_SA(b, h) + aoff + m * 2048 + k * 1024); } } while (0)
#define PG8_LDB(dst, b, h) do { if constexpr (F8) { _Pragma("unroll") for (int n = 0; n < 2; ++n) dst##8[n] = PG8_LD32(lds + PG8_SB(b, h) + boff + n * 2048); } else { _Pragma("unroll") for (int n = 0; n < 2; ++n) _Pragma("unroll") for (int k = 0; k < 2; ++k) dst[n][k] = *(const LAS bf16x8*)(lds + PG8_SB(b, h) + boff + n * 2048 + k * 1024); } } while (0)
#define PG8_MMA(ai, bj, At, Bt, Z) do { __builtin_amdgcn_s_setprio(1); if constexpr (F8) { \
        if (Z) { _Pragma("unroll") for (int m = 0; m < 4; ++m) _Pragma("unroll") for (int n = 0; n < 2; ++n) \
            asm volatile("v_mfma_scale_f32_16x16x128_f8f6f4 %0, %1, %2, 0, %3, %4 op_sel_hi:[0,0,0]" : "=v"(acc[ai][bj][m][n]) : "v"(Bt##8[n]), "v"(At##8[m]), "v"(sclB), "v"(sclA)); } \
        else { _Pragma("unroll") for (int m = 0; m < 4; ++m) _Pragma("unroll") for (int n = 0; n < 2; ++n) \
            asm volatile("v_mfma_scale_f32_16x16x128_f8f6f4 %0, %1, %2, %0, %3, %4 op_sel_hi:[0,0,0]" : "+v"(acc[ai][bj][m][n]) : "v"(Bt##8[n]), "v"(At##8[m]), "v"(sclB), "v"(sclA)); } \
        } else { \
        _Pragma("unroll") for (int m = 0; m < 4; ++m) _Pragma("unroll") for (int n = 0; n < 2; ++n) _Pragma("unroll") for (int k = 0; k < 2; ++k) \
            acc[ai][bj][m][n] = __builtin_amdgcn_mfma_f32_16x16x32_bf16(Bt[n][k], At[m][k], acc[ai][bj][m][n], 0, 0, 0); } __builtin_amdgcn_s_setprio(0); } while (0)
#define PG8_WAIT_V(n) asm volatile("s_waitcnt vmcnt(" #n ")" ::: "memory")
#define PG8_WAIT_L(n) asm volatile("s_waitcnt lgkmcnt(" #n ")" ::: "memory")
#define PG8_BAR __builtin_amdgcn_s_barrier()
#define PG8_SCHED __builtin_amdgcn_sched_barrier(0)
    Unit cur, nxt; int ui = 0;
    if (!S.next(0, cur)) return;
    float ers[8]; int epm = -1;
#pragma unroll
    for (int q = 0; q < 8; ++q) ers[q] = 0.f;
#ifdef TPROBE
    unsigned long long tp_s1 = 0, tp_s2 = 0, tp_s3 = 0, tp_s4 = 0, tp_t0 = __builtin_amdgcn_s_memtime(), tp_e = tp_t0;
#endif
    f32x4 acc[2][2][4][2];
    if constexpr (!F8) {
#pragma unroll
    for (int a = 0; a < 2; ++a)
#pragma unroll
        for (int b = 0; b < 2; ++b)
#pragma unroll
            for (int m = 0; m < 4; ++m)
#pragma unroll
                for (int n = 0; n < 2; ++n) acc[a][b][m][n] = (f32x4){0.f, 0.f, 0.f, 0.f};
    }
    bf16x8 At[4][2], B0[2][2], B1[2][2]; i32x8 At8[4], B08[2], B18[2];
    const char* cA = cur.a; const char* cB = cur.b;
    PG8_STAGE(PG8_SB(0, 0), cB, voffB); PG8_STAGE(PG8_SB(0, 1), cB + hstepB, voffB); PG8_STAGE(PG8_SA(0, 0), cA, voffA); PG8_STAGE(PG8_SA(0, 1), cA + hstepA, voffA);
    if (wr == 1) PG8_BAR;
    PG8_WAIT_V(2); PG8_BAR;
    PG8_STAGE(PG8_SB(1, 0), cB + kstep, voffB); PG8_STAGE(PG8_SA(1, 0), cA + kstep, voffA); PG8_STAGE(PG8_SB(1, 1), cB + hstepB + kstep, voffB);
    PG8_WAIT_V(6); PG8_BAR;
    for (;;) {
        const bool has_next = S.next(ui + 1, nxt);
        const char* nA = has_next ? nxt.a : cA; const char* nB = has_next ? nxt.b : cB;
        const int nt = cur.nt ? cur.nt : nt_def;
        if constexpr (Epi::HASPRE) { if constexpr (Epi::PRE_EARLY) { if (cur.pm != epm) { int fr_ = fr; asm volatile("" : "+v"(fr_)); E.pre(cur, wr, fr_, ers); epm = cur.pm; } } }
        for (int t = 0; t < nt; t += 2) {
            const bool last = (t == nt - 2), z0 = (t == 0);
            const char* a1 = cA + (size_t)(t + 1) * kstep;
            const char* a2 = last ? nA : cA + (size_t)(t + 2) * kstep; const char* b2 = last ? nB : cB + (size_t)(t + 2) * kstep;
            const char* a3 = a2 + kstep; const char* b3 = b2 + kstep;
            PG8_LDB(B0, 0, 0); PG8_LDB(B1, 0, 1); PG8_SCHED; PG8_LDA(At, 0, 0); PG8_STAGE(PG8_SA(1, 1), a1 + hstepA, voffA);
            PG8_WAIT_V(8); PG8_WAIT_L(0); PG8_BAR; PG8_MMA(0, 0, At, B0, z0); PG8_MMA(0, 1, At, B1, z0); PG8_BAR; PG8_SCHED;
            PG8_LDA(At, 0, 1); PG8_STAGE(PG8_SB(0, 0), b2, voffB); PG8_STAGE(PG8_SB(0, 1), b2 + hstepB, voffB); PG8_STAGE(PG8_SA(0, 0), a2, voffA);
            PG8_WAIT_V(8); PG8_WAIT_L(0); PG8_BAR; PG8_MMA(1, 0, At, B0, z0); PG8_MMA(1, 1, At, B1, z0); PG8_BAR; PG8_SCHED;
            PG8_LDB(B0, 1, 0); PG8_LDB(B1, 1, 1); PG8_SCHED; PG8_LDA(At, 1, 0); PG8_STAGE(PG8_SA(0, 1), a2 + hstepA, voffA);
            PG8_WAIT_V(8); PG8_WAIT_L(0); PG8_BAR; PG8_MMA(0, 0, At, B0, false); PG8_MMA(0, 1, At, B1, false); PG8_BAR; PG8_SCHED;
            PG8_LDA(At, 1, 1); PG8_STAGE(PG8_SB(1, 0), b3, voffB); PG8_STAGE(PG8_SB(1, 1), b3 + hstepB, voffB); PG8_STAGE(PG8_SA(1, 0), a3, voffA);
            PG8_WAIT_V(8); PG8_WAIT_L(0); PG8_BAR; PG8_MMA(1, 0, At, B0, false); PG8_MMA(1, 1, At, B1, false); PG8_BAR; PG8_SCHED;
        }
#ifdef TPROBE
        const unsigned long long tp_a = __builtin_amdgcn_s_memtime(); tp_s3 += tp_a - tp_e;
#endif
        if constexpr (F8) asm volatile("s_nop 15\n\ts_nop 7" ::: "memory");
        if constexpr (ALIGN_EPI) { if (wr == 0) PG8_BAR; }
#ifdef TPROBE
        const unsigned long long tp_b = __builtin_amdgcn_s_memtime(); tp_s1 += tp_b - tp_a;
#endif
        { int fr_ = fr, fq_ = fq; asm volatile("" : "+v"(fr_), "+v"(fq_));
          if constexpr (Epi::HASPRE) { if constexpr (!Epi::PRE_EARLY) { if (cur.pm != epm) { E.pre(cur, wr, fr_, ers); epm = cur.pm; } } E(acc, cur, wr, wc, fr_, fq_, ers); } else E(acc, cur, wr, wc, fr_, fq_);
#ifdef EPI_REP
          if constexpr (Epi::PROBE2) { asm volatile("" : "+v"(fr_), "+v"(fq_)); E(acc, cur, wr, wc, fr_, fq_); }
#endif
        }
#ifdef TPROBE
        { asm volatile("s_waitcnt vmcnt(0)" ::: "memory"); const unsigned long long tp_c = __builtin_amdgcn_s_memtime(); tp_s2 += tp_c - tp_b; tp_e = tp_c; }
#endif
        if (!has_next) break;
        if constexpr (!F8) {
#pragma unroll
        for (int a = 0; a < 2; ++a)
#pragma unroll
            for (int b = 0; b < 2; ++b)
#pragma unroll
                for (int m = 0; m < 4; ++m)
#pragma unroll
                    for (int n = 0; n < 2; ++n) acc[a][b][m][n] = (f32x4){0.f, 0.f, 0.f, 0.f};
        }
        cur = nxt; cA = nA; cB = nB; ++ui;
        if constexpr (ALIGN_EPI) { if (wr == 1) PG8_BAR; }
    }
    PG8_WAIT_V(0);
    if constexpr (!ALIGN_EPI) { if (wr == 0) PG8_BAR; }
    PG8_BAR;
#ifdef TPROBE
    if (g.tp && blockIdx.x == TPROBE_BLK && tid == TPROBE_TID) { const unsigned long long tt = __builtin_amdgcn_s_memtime() - tp_t0; const unsigned long long sel = TPROBE == 1 ? tp_s1 : TPROBE == 2 ? tp_s2 : tp_s3; const float f_ = (float)((double)sel / (double)tt); *g.tp = 0.02f * rintf(f_ * 20.0f + TPROBE_OFS); }
#endif
#undef PG8_SA
#undef PG8_SB
#undef PG8_STAGE
#undef PG8_LDA
#undef PG8_LD32
#undef PG8_LDB
#undef PG8_MMA
#undef PG8_WAIT_V
#undef PG8_WAIT_L
#undef PG8_BAR
#undef PG8_SCHED
}


__host__ __device__ __forceinline__ int lds_byte32(int r, int c) { const int rr = r & 15, ob = rr * 64 + c * 2; return (r >> 4) * 1024 + (ob ^ (((ob >> 9) & 1) << 5)); }
__host__ __device__ __forceinline__ void stage_rc32(int b, int& R, int& C) { const int st = b / 1024, sb = b % 1024, swz = sb ^ (((sb >> 9) & 1) << 5); R = st * 16 + swz / 64; C = (swz % 64) / 2; }
template <class Epi, class Sched>
__device__ __forceinline__ void gemm_phase4(LAS unsigned char* lds, const Gemm g, const Sched& S, const Epi& E) {
    const int tid = opaque_tid(), wid = __builtin_amdgcn_readfirstlane(tid >> 6), lane = tid & 63, wr = wid >> 2, wc = wid & 3, fr = lane & 15, fq = lane >> 4;
    int K = g.K; asm volatile("" : "+s"(K));
    const int nt = K / 32;
    constexpr int HT = 8192;
    unsigned voffA, voffB;
    { int R, C; stage_rc32(tid * 16, R, C); const int Rb = Epi::PERM ? ((R & ~31) + perm32(R & 31)) : R; voffA = (unsigned)(R * g.lda + C) * 2u; voffB = (unsigned)(Rb * g.ldb + C) * 2u; }
    const size_t kstep = 64, hstepA = (size_t)HALF * g.lda * 2, hstepB = (size_t)HALF * g.ldb * 2;
    const unsigned ldsw = (unsigned)wid * 1024u;
    const int aoff = lds_byte32(wr * 64 + fr, fq * 8), boff = lds_byte32(wc * 32 + fr, fq * 8);
#define G4_SA(s, h) ((((s) & 3) * 2 + (h)) * HT)
#define G4_SB(s, h) ((8 + ((s) & 3) * 2 + (h)) * HT)
#define G4_STAGE(bufoff, gptr, voff) __builtin_amdgcn_global_load_lds((const unsigned*)((const char*)(gptr) + (voff)), (LAS unsigned*)(lds + (bufoff) + ldsw), 16, 0, 0)
#define G4_LDA(s, h) do { _Pragma("unroll") for (int m = 0; m < 4; ++m) At[m] = *(const LAS bf16x8*)(lds + G4_SA(s, h) + aoff + m * 1024); } while (0)
#define G4_LDB(dst, s, h) do { _Pragma("unroll") for (int n = 0; n < 2; ++n) dst[n] = *(const LAS bf16x8*)(lds + G4_SB(s, h) + boff + n * 1024); } while (0)
#define G4_MMA(ai, bj, Bt) do { __builtin_amdgcn_s_setprio(1); _Pragma("unroll") for (int m = 0; m < 4; ++m) _Pragma("unroll") for (int n = 0; n < 2; ++n) \
        acc[ai][bj][m][n] = __builtin_amdgcn_mfma_f32_16x16x32_bf16(Bt[n], At[m], acc[ai][bj][m][n], 0, 0, 0); __builtin_amdgcn_s_setprio(0); } while (0)
#define G4_WAIT_V(n) asm volatile("s_waitcnt vmcnt(" #n ")" ::: "memory")
#define G4_WAIT_L0 asm volatile("s_waitcnt lgkmcnt(0)" ::: "memory")
#define G4_BAR __builtin_amdgcn_s_barrier()
#define G4_SCHED __builtin_amdgcn_sched_barrier(0)
#define G4_PA(tt) ((tt) < nt ? cA + (size_t)(tt) * kstep : nA + (size_t)((tt) - nt) * kstep)
#define G4_PB(tt) ((tt) < nt ? cB + (size_t)(tt) * kstep : nB + (size_t)((tt) - nt) * kstep)
#define G4_TILE(t_, s) do { \
        G4_LDB(B0, s, 0); G4_LDB(B1, s, 1); G4_SCHED; G4_LDA(s, 0); { const char* pa_ = G4_PA((t_) + 3); G4_STAGE(G4_SA((s) + 3, 1), pa_ + hstepA, voffA); } \
        G4_WAIT_V(12); G4_WAIT_L0; G4_BAR; G4_MMA(0, 0, B0); G4_MMA(0, 1, B1); G4_BAR; G4_SCHED; \
        G4_LDA(s, 1); { const char* pb_ = G4_PB((t_) + 4); const char* pa_ = G4_PA((t_) + 4); G4_STAGE(G4_SB(s, 0), pb_, voffB); G4_STAGE(G4_SB(s, 1), pb_ + hstepB, voffB); G4_STAGE(G4_SA(s, 0), pa_, voffA); } \
        G4_WAIT_V(12); G4_WAIT_L0; G4_BAR; G4_MMA(1, 0, B0); G4_MMA(1, 1, B1); G4_BAR; G4_SCHED; } while (0)
    Unit cur, nxt; int ui = 0;
    if (!S.next(0, cur)) return;
    f32x4 acc[2][2][4][2];
#pragma unroll
    for (int a = 0; a < 2; ++a)
#pragma unroll
        for (int b = 0; b < 2; ++b)
#pragma unroll
            for (int m = 0; m < 4; ++m)
#pragma unroll
                for (int n = 0; n < 2; ++n) { float z_; asm volatile("v_mov_b32 %0, 0" : "=v"(z_)); acc[a][b][m][n] = (f32x4){z_, z_, z_, z_}; }
    bf16x8 At[4], B0[2], B1[2];
    const char* cA = cur.a; const char* cB = cur.b;
    G4_STAGE(G4_SB(0, 0), cB, voffB); G4_STAGE(G4_SB(0, 1), cB + hstepB, voffB); G4_STAGE(G4_SA(0, 0), cA, voffA); G4_STAGE(G4_SA(0, 1), cA + hstepA, voffA);
    if (wr == 1) G4_BAR;
    G4_WAIT_V(1); G4_BAR;
    G4_STAGE(G4_SB(1, 0), cB + kstep, voffB); G4_STAGE(G4_SB(1, 1), cB + kstep + hstepB, voffB); G4_STAGE(G4_SA(1, 0), cA + kstep, voffA); G4_STAGE(G4_SA(1, 1), cA + kstep + hstepA, voffA);
    G4_STAGE(G4_SB(2, 0), cB + 2 * kstep, voffB); G4_STAGE(G4_SB(2, 1), cB + 2 * kstep + hstepB, voffB); G4_STAGE(G4_SA(2, 0), cA + 2 * kstep, voffA); G4_STAGE(G4_SA(2, 1), cA + 2 * kstep + hstepA, voffA);
    G4_STAGE(G4_SB(3, 0), cB + 3 * kstep, voffB); G4_STAGE(G4_SB(3, 1), cB + 3 * kstep + hstepB, voffB); G4_STAGE(G4_SA(3, 0), cA + 3 * kstep, voffA);
    G4_WAIT_V(12); G4_BAR;
    for (;;) {
        const bool has_next = S.next(ui + 1, nxt);
        const char* nA = has_next ? nxt.a : cA; const char* nB = has_next ? nxt.b : cB;
        for (int t = 0; t < nt; t += 4) { G4_TILE(t, 0); G4_TILE(t + 1, 1); G4_TILE(t + 2, 2); G4_TILE(t + 3, 3); }
        if (wr == 0) G4_BAR;
        { int fr_ = fr, fq_ = fq; asm volatile("" : "+v"(fr_), "+v"(fq_)); if constexpr (Epi::HASPRE) { float ers_[8]; E.pre(cur, wr, fr_, ers_); E(acc, cur, wr, wc, fr_, fq_, ers_); } else E(acc, cur, wr, wc, fr_, fq_); }
        if (!has_next) break;
#pragma unroll
        for (int a = 0; a < 2; ++a)
#pragma unroll
            for (int b = 0; b < 2; ++b)
#pragma unroll
                for (int m = 0; m < 4; ++m)
#pragma unroll
                    for (int n = 0; n < 2; ++n) { float z_; asm volatile("v_mov_b32 %0, 0" : "=v"(z_)); acc[a][b][m][n] = (f32x4){z_, z_, z_, z_}; }
        cur = nxt; cA = nA; cB = nB; ++ui;
        if (wr == 1) G4_BAR;
    }
    G4_WAIT_V(0);
    G4_BAR;
#undef G4_SA
#undef G4_SB
#undef G4_STAGE
#undef G4_LDA
#undef G4_LDB
#undef G4_MMA
#undef G4_WAIT_V
#undef G4_WAIT_L0
#undef G4_BAR
#undef G4_SCHED
#undef G4_PA
#undef G4_PB
#undef G4_TILE
}

typedef f32x4 Acc[2][2][4][2];

struct EpiZ { static constexpr bool PERM = true, PROBE2 = false, HASPRE = false;
    bf16_t* O; int ldc; const u64* ssq; u64* sq_q; u64* sq_kv; bf16_t* Kb; const float* cosT; const float* sinT;
    static __device__ __forceinline__ float sq8(const u32x4& w) { return (bflo(w.x) * bflo(w.x) + bfhi(w.x) * bfhi(w.x)) + (bflo(w.y) * bflo(w.y) + bfhi(w.y) * bfhi(w.y)) + (bflo(w.z) * bflo(w.z) + bfhi(w.z) * bfhi(w.z)) + (bflo(w.w) * bflo(w.w) + bfhi(w.w) * bfhi(w.w)); }
    __device__ __forceinline__ void operator()(const Acc& acc, const Unit& u, int wr, int wc, int fr, int fq) const {
        const int row0 = u.pm * BM + wr * 64 + fr, col0 = u.pn * BM + wc * 32 + 8 * fq;
        WtBuf ob; ob.init(O);
        u64 raw[8];
#pragma unroll
        for (int q = 0; q < 8; ++q) raw[q] = ssq[row0 + (q >> 2) * HALF + (q & 3) * 16];
#pragma unroll
        for (int ai = 0; ai < 2; ++ai)
#pragma unroll
            for (int m = 0; m < 4; ++m) { const int row = row0 + ai * HALF + m * 16; const float rs = rstd_raw(raw[ai * 4 + m]);
                const size_t ro = ((size_t)row * ldc + col0) * 2;
                u32x4 wv[2];
#pragma unroll
                for (int bj = 0; bj < 2; ++bj) { const f32x4 v0 = acc[ai][bj][m][0] * rs, v1 = acc[ai][bj][m][1] * rs;
                    u32x4 w; w.x = cvt_pk_bf16(v0[0], v0[1]); w.y = cvt_pk_bf16(v0[2], v0[3]); w.z = cvt_pk_bf16(v1[0], v1[1]); w.w = cvt_pk_bf16(v1[2], v1[3]);
                    ob.st16(ro + bj * HALF * 2, w); wv[bj] = w; }
                if (u.pn >= 2) {
                    float s = sq8(wv[0]); if (u.pn == 2) s += sq8(wv[1]);
                    s += __shfl_xor(s, 16); s += __shfl_xor(s, 32);
                    if (fq == 0) __hip_atomic_fetch_add((u.pn == 2 ? sq_q : sq_kv) + row, ssq_fix(s), RLX_AGENT);
                    if (u.pn == 3 && wc == 0) {
                        const u32x4 w = wv[1]; u32x4 pw; pw.x = __shfl_xor(w.x, 32); pw.y = __shfl_xor(w.y, 32); pw.z = __shfl_xor(w.z, 32); pw.w = __shfl_xor(w.w, 32);
                        const int pos = row & (SEQ - 1), jj = 8 * (fq & 1); const float sg = fq < 2 ? -1.0f : 1.0f;
                        const f32x4 c0 = *(const f32x4*)(cosT + pos * 16 + jj), c1 = *(const f32x4*)(cosT + pos * 16 + jj + 4);
                        const f32x4 s0 = *(const f32x4*)(sinT + pos * 16 + jj) * sg, s1 = *(const f32x4*)(sinT + pos * 16 + jj + 4) * sg;
                        u32x4 o;
                        o.x = cvt_pk_bf16(bflo(w.x) * c0[0] + bflo(pw.x) * s0[0], bfhi(w.x) * c0[1] + bfhi(pw.x) * s0[1]);
                        o.y = cvt_pk_bf16(bflo(w.y) * c0[2] + bflo(pw.y) * s0[2], bfhi(w.y) * c0[3] + bfhi(pw.y) * s0[3]);
                        o.z = cvt_pk_bf16(bflo(w.z) * c1[0] + bflo(pw.z) * s1[0], bfhi(w.z) * c1[1] + bfhi(pw.z) * s1[1]);
                        o.w = cvt_pk_bf16(bflo(w.w) * c1[2] + bflo(pw.w) * s1[2], bfhi(w.w) * c1[3] + bfhi(pw.w) * s1[3]);
                        bf16_t* kr = Kb + (size_t)row * 768 + 64 + 8 * fq;
#pragma unroll
                        for (int h = 0; h < 8; ++h) *(u32x4*)(kr + 96 * h) = o; } } }
    }
};
struct EpiQ { static constexpr bool PERM = false, PROBE2 = false, HASPRE = false;
    bf16_t* O; const u64* rq; const float* cosT; const float* sinT;
    __device__ __forceinline__ void operator()(const Acc& acc, const Unit& u, int wr, int wc, int fr, int fq) const {
        const int row0 = u.pm * BM + wr * 64 + fr;
        float rsv[8];
#pragma unroll
        for (int q = 0; q < 8; ++q) rsv[q] = rsqrtf(ssq_f32(rq[row0 + (q >> 2) * HALF + (q & 3) * 16]) * (1.0f / 256.0f) + EPS);
#pragma unroll
        for (int ai = 0; ai < 2; ++ai)
#pragma unroll
            for (int m = 0; m < 4; ++m) { const int row = row0 + ai * HALF + m * 16; const float rs = rsv[ai * 4 + m] * QS_MLA; const int pos = row & (SEQ - 1);
                const f32x4 cs = *(const f32x4*)(cosT + pos * 16 + 4 * fq), sn = *(const f32x4*)(sinT + pos * 16 + 4 * fq);
#pragma unroll
                for (int bj = 0; bj < 2; ++bj) { const int cb = u.pn * BM + bj * HALF + wc * 32; const bool rope = ((cb >> 5) % 3) == 2;
                    f32x4 v0 = acc[ai][bj][m][0] * rs, v1 = acc[ai][bj][m][1] * rs;
                    if (rope) { const f32x4 o0 = v0 * cs - v1 * sn, o1 = v1 * cs + v0 * sn; v0 = o0; v1 = o1; }
                    u32x2 w0, w1; w0.x = cvt_pk_bf16(v0[0], v0[1]); w0.y = cvt_pk_bf16(v0[2], v0[3]); w1.x = cvt_pk_bf16(v1[0], v1[1]); w1.y = cvt_pk_bf16(v1[2], v1[3]);
                    bf16_t* p = O + (size_t)row * 768 + cb + 4 * fq;
                    *(u32x2*)(p) = w0; *(u32x2*)(p + 16) = w1; } }
    }
};
struct EpiKV { static constexpr bool PERM = true, PROBE2 = false, HASPRE = false;
    bf16_t* Kb; bf16_t* Vb; const u64* rkv;
    __device__ __forceinline__ void operator()(const Acc& acc, const Unit& u, int wr, int wc, int fr, int fq) const {
        const int row0 = u.pm * BM + wr * 64 + fr;
        float rsv[8];
#pragma unroll
        for (int q = 0; q < 8; ++q) rsv[q] = rsqrtf(ssq_f32(rkv[row0 + (q >> 2) * HALF + (q & 3) * 16]) * (1.0f / 128.0f) + EPS);
#pragma unroll
        for (int ai = 0; ai < 2; ++ai)
#pragma unroll
            for (int m = 0; m < 4; ++m) { const int row = row0 + ai * HALF + m * 16; const float rs = rsv[ai * 4 + m];
#pragma unroll
                for (int bj = 0; bj < 2; ++bj) { const int h = 2 * u.pn + bj; const f32x4 v0 = acc[ai][bj][m][0] * rs, v1 = acc[ai][bj][m][1] * rs;
                    u32x4 w; w.x = cvt_pk_bf16(v0[0], v0[1]); w.y = cvt_pk_bf16(v0[2], v0[3]); w.z = cvt_pk_bf16(v1[0], v1[1]); w.w = cvt_pk_bf16(v1[2], v1[3]);
                    bf16_t* p = (wc < 2) ? (Kb + (size_t)row * 768 + 96 * h + 32 * wc + 8 * fq) : (Vb + (size_t)row * 512 + 64 * h + 32 * (wc - 2) + 8 * fq);
                    *(u32x4*)p = w; } }
    }
};
struct EpiRes { static constexpr bool PERM = true, PROBE2 = false, HASPRE = false;
    const float* base32; bf16_t* XB; u64* ssq_next; unsigned char* X8;
    __device__ __forceinline__ void finish(const f32x4 (&o)[2][2], int row, size_t off, int fq) const {
        f32x2 s2 = (f32x2){0.f, 0.f};
#pragma unroll
        for (int bj = 0; bj < 2; ++bj) { u32x4 w; u32x2 w8;
#pragma unroll
            for (int n = 0; n < 2; ++n) { const f32x4 v = o[bj][n]; const f32x2 va = (f32x2){v[0], v[1]}, vb = (f32x2){v[2], v[3]}; s2 = va * va + s2; s2 = vb * vb + s2;
                const unsigned lo = cvt_pk_bf16(v[0], v[1]), hi = cvt_pk_bf16(v[2], v[3]); if (n == 0) { w.x = lo; w.y = hi; } else { w.z = lo; w.w = hi; }
                if (X8) { const f32x2 qa = va * F8_HS, qb = vb * F8_HS; const unsigned q = pk4_fp8(qa.x, qa.y, qb.x, qb.y); if (n == 0) w8.x = q; else w8.y = q; } }
            *(u32x4*)(XB + off + bj * HALF) = w;
            if (X8) *(u32x2*)(X8 + off + bj * HALF) = w8; }
        float s = s2.x + s2.y;
        s += __shfl_xor(s, 16); s += __shfl_xor(s, 32);
        if (fq == 0) __hip_atomic_fetch_add(ssq_next + row, ssq_fix(s), RLX_AGENT);
    }
    __device__ __forceinline__ void operator()(const Acc& acc, const Unit& u, int wr, int wc, int fr, int fq) const {
        const int row0 = u.pm * BM + wr * 64 + fr, col0 = u.pn * BM + wc * 32 + 8 * fq;
        if (base32) {
#pragma unroll
            for (int ai = 0; ai < 2; ++ai)
#pragma unroll
                for (int mp = 0; mp < 2; ++mp) { f32x4 bs[2][2][2];
#pragma unroll
                    for (int mm = 0; mm < 2; ++mm) { const size_t off = (size_t)(row0 + ai * HALF + (2 * mp + mm) * 16) * DM + col0;
#pragma unroll
                        for (int bj = 0; bj < 2; ++bj)
#pragma unroll
                            for (int n = 0; n < 2; ++n) bs[mm][bj][n] = *(const f32x4*)(base32 + off + bj * HALF + n * 4); }
#pragma unroll
                    for (int mm = 0; mm < 2; ++mm) { const int m = 2 * mp + mm; const int row = row0 + ai * HALF + m * 16; f32x4 o[2][2];
#pragma unroll
                        for (int bj = 0; bj < 2; ++bj)
#pragma unroll
                            for (int n = 0; n < 2; ++n) o[bj][n] = bs[mm][bj][n] + acc[ai][bj][m][n];
                        finish(o, row, (size_t)row * DM + col0, fq); }
                    asm volatile("" ::: "memory"); }
        } else {
#pragma unroll
            for (int ai = 0; ai < 2; ++ai) { u32x4 raw[4][2];
#pragma unroll
                for (int m = 0; m < 4; ++m) { const size_t off = (size_t)(row0 + ai * HALF + m * 16) * DM + col0;
#pragma unroll
                    for (int bj = 0; bj < 2; ++bj) raw[m][bj] = *(const u32x4*)(XB + off + bj * HALF); }
#pragma unroll
                for (int m = 0; m < 4; ++m) { const int row = row0 + ai * HALF + m * 16; f32x4 o[2][2];
#pragma unroll
                    for (int bj = 0; bj < 2; ++bj) { const u32x4 b4 = raw[m][bj];
                        o[bj][0] = (f32x4){bflo(b4.x), bfhi(b4.x), bflo(b4.y), bfhi(b4.y)} + acc[ai][bj][m][0]; o[bj][1] = (f32x4){bflo(b4.z), bfhi(b4.z), bflo(b4.w), bfhi(b4.w)} + acc[ai][bj][m][1]; }
                    finish(o, row, (size_t)row * DM + col0, fq); }
                asm volatile("" ::: "memory"); }
        }
    }
};
template <int MODE> struct EpiSwiGLU { static constexpr bool PERM = true, PROBE2 = false, HASPRE = true, PRE_EARLY = (MODE == 1 || MODE == 2);
    bf16_t* O; int ldc; const void* rsrc;
    __device__ __forceinline__ void pre(const Unit& u, int wr, int fr, float (&rsv)[8]) const {
        const int row0 = u.pm * BM + wr * 64 + fr;
        if (MODE == 0 || MODE == 3) { u64 raw[8];
#pragma unroll
            for (int q = 0; q < 8; ++q) raw[q] = ((const u64*)rsrc)[row0 + (q >> 2) * HALF + (q & 3) * 16];
#pragma unroll
            for (int q = 0; q < 8; ++q) rsv[q] = rstd_raw(raw[q]);
        } else {
#pragma unroll
            for (int q = 0; q < 8; ++q) rsv[q] = ((const float*)rsrc)[row0 + (q >> 2) * HALF + (q & 3) * 16]; }
    }
    __device__ __forceinline__ void operator()(const Acc& acc, const Unit& u, int wr, int wc, int fr, int fq, const float (&rsv)[8]) const {
        const int row0 = u.pm * BM + wr * 64 + fr, col0 = u.pn * HALF + wc * 32 + 8 * fq;
        WtBuf ob; ob.init(O);
#pragma unroll
        for (int ai = 0; ai < 2; ++ai)
#pragma unroll
            for (int m = 0; m < 4; ++m) { const int row = row0 + ai * HALF + m * 16; const float rs = rsv[ai * 4 + m];
                float o[8];
                const float rsu = rs * (MODE == 2 ? F8_ACT : 1.0f), rsl = rs * (-LOG2E);
#pragma unroll
                for (int n = 0; n < 2; ++n)
#pragma unroll
                    for (int hh = 0; hh < 2; ++hh) { const f32x2 g2 = (f32x2){acc[ai][0][m][n][2 * hh], acc[ai][0][m][n][2 * hh + 1]}, u2 = (f32x2){acc[ai][1][m][n][2 * hh], acc[ai][1][m][n][2 * hh + 1]};
                        const f32x2 gg = g2 * rs, uu = u2 * rsu; f32x2 ee = g2 * rsl;
                        ee.x = fast_exp2(ee.x); ee.y = fast_exp2(ee.y); f32x2 dd = ee + 1.0f; dd.x = fast_rcp(dd.x); dd.y = fast_rcp(dd.y);
                        const f32x2 oo = (gg * dd) * uu; o[n * 4 + 2 * hh] = oo.x; o[n * 4 + 2 * hh + 1] = oo.y; }
                if (MODE == 2) { u32x2 w8; w8.x = pk4_fp8(o[0], o[1], o[2], o[3]); w8.y = pk4_fp8(o[4], o[5], o[6], o[7]);
                    ob.st8((size_t)row * ldc + col0, w8); }
                else { u32x4 w; w.x = cvt_pk_bf16(o[0], o[1]); w.y = cvt_pk_bf16(o[2], o[3]); w.z = cvt_pk_bf16(o[4], o[5]); w.w = cvt_pk_bf16(o[6], o[7]);
                    ob.st16(((size_t)row * ldc + col0) * 2, w); } }
    }
};
struct EpiOddIn { static constexpr bool PERM = true, PROBE2 = false, HASPRE = true, PRE_EARLY = false;
    bf16_t* QKV; bf16_t* UV; const u64* ssq;
    __device__ __forceinline__ void pre(const Unit& u, int wr, int fr, float (&rsv)[8]) const {
        const int row0 = u.pm * BM + wr * 64 + fr; u64 raw[8];
#pragma unroll
        for (int q = 0; q < 8; ++q) raw[q] = ssq[row0 + (q >> 2) * HALF + (q & 3) * 16];
#pragma unroll
        for (int q = 0; q < 8; ++q) rsv[q] = rstd_raw(raw[q]);
    }
    __device__ __forceinline__ void operator()(const Acc& acc, const Unit& u, int wr, int wc, int fr, int fq, const float (&rsv)[8]) const {
        const int row0 = u.pm * BM + wr * 64 + fr; const bool isuv = u.pn >= 6; const float qsc = u.pn < 2 ? QS_BAND : 1.0f;
#pragma unroll
        for (int ai = 0; ai < 2; ++ai)
#pragma unroll
            for (int m = 0; m < 4; ++m) { const int row = row0 + ai * HALF + m * 16; const float rs = rsv[ai * 4 + m];
#pragma unroll
                for (int bj = 0; bj < 2; ++bj) { float o[8];
#pragma unroll
                    for (int n = 0; n < 2; ++n)
#pragma unroll
                        for (int hh = 0; hh < 2; ++hh) { f32x2 v = (f32x2){acc[ai][bj][m][n][2 * hh], acc[ai][bj][m][n][2 * hh + 1]} * rs;
                            if (isuv) { constexpr float K0 = -2.0f * 0.7978845608028654f * LOG2E, K1 = K0 * 0.044715f;
                                f32x2 e = v * (v * v * K1 + K0); e.x = fast_exp2(e.x); e.y = fast_exp2(e.y); f32x2 d = e + 1.0f; d.x = fast_rcp(d.x); d.y = fast_rcp(d.y); v = v * d; }
                            else v = v * qsc;
                            o[n * 4 + 2 * hh] = v.x; o[n * 4 + 2 * hh + 1] = v.y; }
                    u32x4 w; w.x = cvt_pk_bf16(o[0], o[1]); w.y = cvt_pk_bf16(o[2], o[3]); w.z = cvt_pk_bf16(o[4], o[5]); w.w = cvt_pk_bf16(o[6], o[7]);
                    bf16_t* p = isuv ? (UV + (size_t)row * 1024 + (u.pn - 6) * BM + bj * HALF + wc * 32 + 8 * fq) : (QKV + (size_t)row * 1536 + u.pn * BM + bj * HALF + wc * 32 + 8 * fq);
                    *(u32x4*)p = w; } }
    }
};
struct EpiY { static constexpr bool PERM = true, PROBE2 = false, HASPRE = true, PRE_EARLY = true;
    bf16_t* O; const float* gate; size_t ys; bf16_t* YP; int tail_row0;
    __device__ __forceinline__ void pre(const Unit& u, int wr, int fr, float (&rsv)[8]) const {
        const int row0 = u.pm * BM + wr * 64 + fr;
#pragma unroll
        for (int q = 0; q < 8; ++q) rsv[q] = gate[row0 + (q >> 2) * HALF + (q & 3) * 16];
    }
    __device__ __forceinline__ void operator()(const Acc& acc, const Unit& u, int wr, int wc, int fr, int fq, const float (&rsv)[8]) const {
        const int row0 = u.pm * BM + wr * 64 + fr, col0 = u.pn * BM + wc * 32 + 8 * fq;
        WtBuf ob, oy; ob.init(O); oy.init(YP ? YP : O);
#pragma unroll
        for (int ai = 0; ai < 2; ++ai)
#pragma unroll
            for (int m = 0; m < 4; ++m) { const int row = row0 + ai * HALF + m * 16; const float rs = rsv[ai * 4 + m];
                const bool tl = YP && u.kh; const size_t ro = (tl ? (((size_t)(u.kh - 1) * TAIL_ROWS + (size_t)(row - tail_row0)) * DM + col0) : ((size_t)u.kh * ys + (size_t)row * DM + col0)) * 2;
#pragma unroll
                for (int bj = 0; bj < 2; ++bj) { const f32x4 v0 = acc[ai][bj][m][0] * rs, v1 = acc[ai][bj][m][1] * rs;
                    u32x4 w; w.x = cvt_pk_bf16(v0[0], v0[1]); w.y = cvt_pk_bf16(v0[2], v0[3]); w.z = cvt_pk_bf16(v1[0], v1[1]); w.w = cvt_pk_bf16(v1[2], v1[3]);
                    if (tl) oy.st16(ro + bj * HALF * 2, w); else ob.st16(ro + bj * HALF * 2, w); } }
    }
};
}

#define XB_TMO      128
#define XB_XCNT(j)  (256  + 64 * (j))
#define XB_XSUB(j)  (1280 + 64 * (j))
#define XB_XGEN(j)  (2304 + 64 * (j))
#define XB_TOP      3328
#define XB_TOPGEN   3392
#define XCD_BAR_WORDS 3456
#define XB_SPIN_CAP (1u << 18)
__device__ __forceinline__ unsigned xb_ld(unsigned* p)              { return __hip_atomic_load(p, __ATOMIC_RELAXED, __HIP_MEMORY_SCOPE_AGENT); }
__device__ __forceinline__ unsigned xb_add(unsigned* p, unsigned v) { return __hip_atomic_fetch_add(p, v, __ATOMIC_RELAXED, __HIP_MEMORY_SCOPE_AGENT); }
__device__ __forceinline__ unsigned xb_xcc_id() { return (unsigned)__builtin_amdgcn_s_getreg((3 << 11) | 20) & 0xFu; }
#define XB_SPIN(cond, bar) do { unsigned _sp = 0; while (cond) { __builtin_amdgcn_s_sleep(1); \
    if ((++_sp & 255u) == 0u) { if (xb_ld(&(bar)[XB_TMO])) break; if (_sp > XB_SPIN_CAP) { atomicAdd(&(bar)[XB_TMO], 1u); break; } } } } while (0)
struct XcdBarrier { unsigned* bar; unsigned x; volatile LAS unsigned* st; };
__device__ __forceinline__ XcdBarrier xcd_barrier_post(unsigned* bar, volatile LAS unsigned* st) {
    XcdBarrier b; b.bar = bar; b.x = xb_xcc_id(); b.st = st;
    if (threadIdx.x == 0) (void)xb_add(&bar[XB_XCNT(b.x)], 1u);
    return b;
}
__device__ __forceinline__ void xcd_barrier_complete(unsigned* bar, unsigned x, unsigned& nloc, unsigned& nx) {
    const unsigned G = gridDim.x * gridDim.y * gridDim.z;
    unsigned sum, cnt, mine, sp = 0u;
    for (;;) {
        sum = 0u; cnt = 0u; mine = 0u;
#pragma unroll
        for (unsigned j = 0; j < 16; ++j) { const unsigned c = xb_ld(&bar[XB_XCNT(j)]); sum += c; cnt += (c > 0u) ? 1u : 0u; mine = (j == x) ? c : mine; }
        if (sum == G) break;
        __builtin_amdgcn_s_sleep(1);
        if ((++sp & 255u) == 0u) { if (xb_ld(&bar[XB_TMO])) break; if (sp > XB_SPIN_CAP) { atomicAdd(&bar[XB_TMO], 1u); break; } }
    }
    nloc = mine > 0u ? mine : 1u; nx = cnt > 0u ? cnt : 1u;
}
__device__ __forceinline__ void xcd_barrier(const XcdBarrier& b) {
    asm volatile("s_waitcnt vmcnt(0)" ::: "memory");
    __syncthreads();
    if (threadIdx.x == 0) {
        unsigned* bar = b.bar;
        __builtin_amdgcn_s_waitcnt(0);
        unsigned nloc = b.st[0], nx = b.st[1];
        if (nloc == 0u) { xcd_barrier_complete(bar, b.x, nloc, nx); b.st[0] = nloc; b.st[1] = nx; }
        const unsigned old = xb_add(&bar[XB_XSUB(b.x)], 1u);
        const unsigned gen = old / nloc;
        if (old + 1u == (gen + 1u) * nloc) {
            __builtin_amdgcn_fence(__ATOMIC_RELEASE, "agent");
            asm volatile("s_waitcnt vmcnt(0)" ::: "memory");
            const unsigned og = xb_add(&bar[XB_TOP], 1u);
            const unsigned tg = og / nx;
            if (og + 1u == (tg + 1u) * nx) xb_add(&bar[XB_TOPGEN], 1u);
            else XB_SPIN(xb_ld(&bar[XB_TOPGEN]) == tg, bar);
            __builtin_amdgcn_fence(__ATOMIC_ACQUIRE, "agent");
            xb_add(&bar[XB_XGEN(b.x)], 1u);
            asm volatile("s_waitcnt vmcnt(0)" ::: "memory");
        } else {
            XB_SPIN(xb_ld(&bar[XB_XGEN(b.x)]) == gen, bar);
            __builtin_amdgcn_fence(__ATOMIC_ACQUIRE, "agent");
            asm volatile("s_waitcnt vmcnt(0)" ::: "memory");
        }
    }
    __syncthreads();
}

struct Frame {
    LAS unsigned char* lds;
    unsigned* ctl;
    int tid, lane, wave, vcu, G;
    __device__ __forceinline__ void refresh() { tid = opaque_tid(); lane = tid & 63; wave = __builtin_amdgcn_readfirstlane(tid >> 6); }
};

struct XJob { const float* W; const float* gain; bf16_t* WT; int K, N, ldt, mode, nb; size_t sb, db; int istart, f8; };
__device__ __forceinline__ void xpose_load(const XJob& J, int item, f32x4 (&v)[16], int lane) {
    const int nblk = (J.N + 63) / 64, nkb = J.K / 64, per = nkb * nblk, e = item / per, r = item % per, kb = r % nkb, nbk = r / nkb, k0 = 64 * kb, n0 = 64 * nbk;
    const float* W = J.W + (size_t)e * J.sb;
    const int lr = lane >> 4, lc = 4 * (lane & 15);
    const bool colok = (n0 + lc) < J.N;
#pragma unroll
    for (int i = 0; i < 16; ++i) v[i] = colok ? __builtin_nontemporal_load((const f32x4*)(W + (size_t)(k0 + 4 * i + lr) * J.N + n0 + lc)) : (f32x4){0.f, 0.f, 0.f, 0.f};
}
__device__ __forceinline__ void xpose_store(const XJob& J, int item, const f32x4 (&v)[16], LAS float* scr, int lane) {
    const int nblk = (J.N + 63) / 64, nkb = J.K / 64, per = nkb * nblk, e = item / per, r = item % per, kb = r % nkb, nbk = r / nkb, k0 = 64 * kb, n0 = 64 * nbk;
    bf16_t* WT = J.WT + (size_t)e * J.db;
    const int lr = lane >> 4, lc = 4 * (lane & 15);
#pragma unroll
    for (int i = 0; i < 16; ++i) { const int kk = 4 * i + lr; const float gs = J.gain ? J.gain[k0 + kk] : 1.0f; LAS float* d = scr + kk * 65 + lc;
        d[0] = v[i][0] * gs; d[1] = v[i][1] * gs; d[2] = v[i][2] * gs; d[3] = v[i][3] * gs; }
    LDS_WAIT(); asm volatile("" ::: "memory");
    if (J.f8) {
        const int c4 = lane & 3;
#pragma unroll
        for (int j = 0; j < 4; ++j) { const int n = (lane >> 2) + 16 * j; const LAS float* s = scr + (16 * c4) * 65 + n;
            u32x4 o8;
            o8.x = pk4_fp8(s[0 * 65] * F8_WS, s[1 * 65] * F8_WS, s[2 * 65] * F8_WS, s[3 * 65] * F8_WS); o8.y = pk4_fp8(s[4 * 65] * F8_WS, s[5 * 65] * F8_WS, s[6 * 65] * F8_WS, s[7 * 65] * F8_WS);
            o8.z = pk4_fp8(s[8 * 65] * F8_WS, s[9 * 65] * F8_WS, s[10 * 65] * F8_WS, s[11 * 65] * F8_WS); o8.w = pk4_fp8(s[12 * 65] * F8_WS, s[13 * 65] * F8_WS, s[14 * 65] * F8_WS, s[15 * 65] * F8_WS);
            const int ng = n0 + n; const int row = J.mode == 0 ? ng : ((ng >> 7) * 256 + (ng & 127) + (J.mode == 2 ? 128 : 0));
            *(u32x4*)((unsigned char*)J.WT + (size_t)e * J.db + (size_t)row * J.ldt + k0 + 16 * c4) = o8; }
        LDS_WAIT(); asm volatile("" ::: "memory");
        return;
    }
    const int c = lane & 7;
#pragma unroll
    for (int j = 0; j < 8; ++j) { const int n = (lane >> 3) + 8 * j; const LAS float* s = scr + (8 * c) * 65 + n;
        u32x4 o; o.x = cvt_pk_bf16(s[0 * 65], s[1 * 65]); o.y = cvt_pk_bf16(s[2 * 65], s[3 * 65]); o.z = cvt_pk_bf16(s[4 * 65], s[5 * 65]); o.w = cvt_pk_bf16(s[6 * 65], s[7 * 65]);
        const int ng = n0 + n; const int row = J.mode == 0 ? ng : ((ng >> 7) * 256 + (ng & 127) + (J.mode == 2 ? 128 : 0));
        if (J.f8) { u32x2 o8; o8.x = pk4_fp8(s[0 * 65] * F8_WS, s[1 * 65] * F8_WS, s[2 * 65] * F8_WS, s[3 * 65] * F8_WS); o8.y = pk4_fp8(s[4 * 65] * F8_WS, s[5 * 65] * F8_WS, s[6 * 65] * F8_WS, s[7 * 65] * F8_WS);
            *(u32x2*)((unsigned char*)J.WT + (size_t)e * J.db + (size_t)row * J.ldt + k0 + 8 * c) = o8; }
        else if (ng < J.N) *(u32x4*)(WT + (size_t)row * J.ldt + k0 + 8 * c) = o; }
    LDS_WAIT(); asm volatile("" ::: "memory");
}
constexpr int NJT = 12;
__device__ __forceinline__ void make_job(int i, int t, const float* const* in, unsigned char* ws, XJob& J) {
    J.gain = nullptr; J.mode = 0; J.nb = 1; J.sb = 0; J.db = 0; J.istart = 0; J.f8 = 0;
    bf16_t* WE = (bf16_t*)(ws + WS_WE) + (size_t)i * E_SIZE; bf16_t* WO = (bf16_t*)(ws + WS_WO) + (size_t)i * O_SIZE;
    switch (t) {
    case 0: J.W = in[2] + (size_t)i * 1024 * 928; J.gain = in[1] + i * 1024; J.WT = WE + E_WIN; J.K = 1024; J.N = 928; J.ldt = 1024; break;
    case 1: J.W = in[6] + (size_t)i * 256 * 768; J.gain = in[5] + i * 256; J.WT = WE + E_WQ; J.K = 256; J.N = 768; J.ldt = 256; break;
    case 2: J.W = in[8] + (size_t)i * 128 * 1024; J.gain = in[7] + i * 128; J.WT = WE + E_WKV; J.K = 128; J.N = 1024; J.ldt = 256; break;
    case 3: J.W = in[9] + (size_t)i * 1024 * 1024 + (size_t)512 * 1024; J.WT = WE + E_WOUT + 512; J.K = 512; J.N = 1024; J.ldt = 1024; break;
    case 4: J.W = in[11] + (size_t)i * 1024 * FF; J.gain = in[10] + i * 1024; J.WT = WE + E_WGU; J.K = 1024; J.N = FF; J.ldt = 1024; J.mode = 1; J.f8 = FFN1_F8; break;
    case 5: J.W = in[12] + (size_t)i * 1024 * FF; J.gain = in[10] + i * 1024; J.WT = WE + E_WGU; J.K = 1024; J.N = FF; J.ldt = 1024; J.mode = 2; J.f8 = FFN1_F8; break;
    case 6: J.W = in[13] + (size_t)i * FF * 1024; J.WT = WE + E_WDN; J.K = FF; J.N = 1024; J.ldt = FF; break;
    case 7: J.W = in[15] + (size_t)i * 1024 * 2560; J.gain = in[14] + i * 1024; J.WT = WO + O_WIN; J.K = 1024; J.N = 2560; J.ldt = 1024; break;
    case 8: J.W = in[21] + (size_t)i * 1024 * 1024; J.WT = WO + O_WOUT; J.K = 1024; J.N = 1024; J.ldt = 1024; break;
    case 9: J.W = in[24] + (size_t)i * NEXP * 1024 * EFF; J.gain = in[22] + i * 1024; J.WT = WO + O_WGU; J.K = 1024; J.N = EFF; J.ldt = 1024; J.mode = 1; J.nb = NEXP; J.sb = (size_t)1024 * EFF; J.db = (size_t)2 * EFF * 1024; J.f8 = MOE_F8; break;
    case 10: J.W = in[25] + (size_t)i * NEXP * 1024 * EFF; J.gain = in[22] + i * 1024; J.WT = WO + O_WGU; J.K = 1024; J.N = EFF; J.ldt = 1024; J.mode = 2; J.nb = NEXP; J.sb = (size_t)1024 * EFF; J.db = (size_t)2 * EFF * 1024; J.f8 = MOE_F8; break;
    default: J.W = in[26] + (size_t)i * NEXP * EFF * 1024; J.WT = WO + O_WDN; J.K = EFF; J.N = 1024; J.ldt = EFF; J.nb = NEXP; J.sb = (size_t)EFF * 1024; J.db = (size_t)1024 * EFF; J.f8 = MOE_F8; break;
    }
}
__host__ __device__ constexpr int job_items_t(int t) {
    return t == 0 ? 16 * 15 : t == 1 ? 4 * 12 : t == 2 ? 2 * 16 : t == 3 ? 8 * 16 : t == 4 ? 16 * 44 : t == 5 ? 16 * 44 : t == 6 ? 44 * 16 : t == 7 ? 16 * 40 : t == 8 ? 16 * 16 : t == 9 ? 8 * 16 * 56 : t == 10 ? 8 * 16 * 56 : 8 * 56 * 16;
}
__host__ __device__ constexpr int job_start_t(int t) { int a = 0; for (int k = 0; k < t; ++k) a += job_items_t(k); return a; }
constexpr int ITEMS_PER_PAIR = job_start_t(NJT);

__device__ __forceinline__ void p0_prologue(Frame& F, const float* const* in, unsigned char* ws) {
    F.refresh();
    LAS float* scr = (LAS float*)(F.lds + F.wave * 16640);
    const int gw = F.vcu * NWAVES + F.wave, NGW = F.G * NWAVES;
#define XP_DECODE(it_, J_, r_) do { const int i_ = (it_) / ITEMS_PER_PAIR, rr_ = (it_) % ITEMS_PER_PAIR; int t_ = 0; \
        _Pragma("unroll") for (int k = 1; k < NJT; ++k) t_ += (rr_ >= job_start_t(k)) ? 1 : 0; int st_ = 0; \
        _Pragma("unroll") for (int k = 1; k < NJT; ++k) st_ = (t_ == k) ? job_start_t(k) : st_; make_job(i_, t_, in, ws, J_); r_ = rr_ - st_; } while (0)
    { constexpr int NIT = 2 * ITEMS_PER_PAIR; int it = gw; XJob Jc; int rc = 0; f32x4 vc[16];
      if (it < NIT) { XP_DECODE(it, Jc, rc); xpose_load(Jc, rc, vc, F.lane); }
      while (it < NIT) {
          const int itn = it + NGW; XJob Jn = Jc; int rn = 0; f32x4 vn[16];
          if (itn < NIT) { XP_DECODE(itn, Jn, rn); xpose_load(Jn, rn, vn, F.lane); }
          xpose_store(Jc, rc, vc, scr, F.lane);
          it = itn; Jc = Jn; rc = rn;
#pragma unroll
          for (int i = 0; i < 16; ++i) vc[i] = vn[i];
      } }
#undef XP_DECODE
    const int gt = F.vcu * 512 + F.tid, NGT = F.G * 512;
    for (int i = 0; i < 2; ++i) {
        bf16_t* WE = (bf16_t*)(ws + WS_WE) + (size_t)i * E_SIZE;
        for (int x = gt; x < 96 * 1024 / 8; x += NGT) *(u32x4*)(WE + E_WIN + (size_t)928 * 1024 + (size_t)x * 8) = zero4();
        for (int x = gt; x < 1024 * 16; x += NGT) { const int r = x >> 4, c = x & 15; *(u32x4*)(WE + E_WKV + (size_t)r * 256 + 128 + c * 8) = zero4(); }
    }
    for (int x = gt; x < 2 * 64 * 1024; x += NGT) {
        const int n = x & 1023, kg = __builtin_amdgcn_readfirstlane((x >> 10) & 63), i = __builtin_amdgcn_readfirstlane(x >> 16), g = kg >> 4, c0 = (8 * kg) & 127;
        const float* pr = in[3] + (size_t)i * 4 * 128 * 128 + ((size_t)g * 128 + c0) * 128; const float* sr = in[4] + (size_t)i * 512 + g * 128;
        const float* wr_ = in[9] + (size_t)i * 1024 * 1024 + (size_t)(g * 128) * 1024 + n;
        float a[8];
#pragma unroll
        for (int kk = 0; kk < 8; ++kk) a[kk] = 0.f;
        float wc[8], wn[8];
#pragma unroll
        for (int u = 0; u < 8; ++u) { wc[u] = wr_[(size_t)u * 1024]; wn[u] = 0.f; }
#pragma unroll 1
        for (int d0 = 0; d0 < 128; d0 += 8) {
            if (d0 + 8 < 128) {
#pragma unroll
                for (int u = 0; u < 8; ++u) wn[u] = wr_[(size_t)(d0 + 8 + u) * 1024]; }
#pragma unroll
            for (int u = 0; u < 8; ++u) { const float wv = wc[u] * sr[d0 + u];
#pragma unroll
                for (int kk = 0; kk < 8; ++kk) a[kk] += pr[kk * 128 + d0 + u] * wv; }
#pragma unroll
            for (int u = 0; u < 8; ++u) wc[u] = wn[u]; }
        u32x4 o; o.x = cvt_pk_bf16(a[0], a[1]); o.y = cvt_pk_bf16(a[2], a[3]); o.z = cvt_pk_bf16(a[4], a[5]); o.w = cvt_pk_bf16(a[6], a[7]);
        *(u32x4*)((bf16_t*)(ws + WS_WE) + (size_t)i * E_SIZE + E_WOUT + (size_t)n * 1024 + 8 * kg) = o;
    }
    { float* cosT = (float*)(ws + T_COS); float* sinT = (float*)(ws + T_SIN);
      for (int x = gt; x < SEQ * 16; x += NGT) { const int pos = x >> 4, j = x & 15;
          const float inv = 1.0f / powf(10000.0f, (float)(2 * j) / 32.0f); const float angf = (float)pos * inv;
          double a = (double)angf; const double twopi = 6.283185307179586476925; a -= twopi * rint(a / twopi);
          const double y = a * 0.125, y2 = y * y;
          double s = y * (1.0 + y2 * (-1.0 / 6 + y2 * (1.0 / 120 + y2 * (-1.0 / 5040 + y2 * (1.0 / 362880 + y2 * (-1.0 / 39916800 + y2 * (1.0 / 6227020800.0)))))));
          double c = 1.0 + y2 * (-0.5 + y2 * (1.0 / 24 + y2 * (-1.0 / 720 + y2 * (1.0 / 40320 + y2 * (-1.0 / 3628800 + y2 * (1.0 / 479001600.0 + y2 * (-1.0 / 87178291200.0)))))));
#pragma unroll
          for (int k = 0; k < 3; ++k) { const double s2 = 2.0 * s * c, c2 = c * c - s * s; s = s2; c = c2; }
          cosT[x] = (float)c; sinT[x] = (float)s; } }
    { const float* x = in[0]; bf16_t* XB = (bf16_t*)(ws + WS_XB); u64* ssq = (u64*)(ws + WS_SSQ);
      for (int m = gw; m < NTOK; m += NGW) { const f32x4* xr = (const f32x4*)(x + (size_t)m * DM) + 2 * F.lane; float s = 0.f;
#pragma unroll
          for (int j = 0; j < 2; ++j) { const f32x4 v = xr[128 * j], v2 = xr[128 * j + 1]; s += (v[0] * v[0] + v[1] * v[1]) + (v[2] * v[2] + v[3] * v[3]); s += (v2[0] * v2[0] + v2[1] * v2[1]) + (v2[2] * v2[2] + v2[3] * v2[3]);
              u32x4 w; w.x = cvt_pk_bf16(v[0], v[1]); w.y = cvt_pk_bf16(v[2], v[3]); w.z = cvt_pk_bf16(v2[0], v2[1]); w.w = cvt_pk_bf16(v2[2], v2[3]); *((u32x4*)(XB + (size_t)m * DM) + F.lane + 64 * j) = w; }
          s = wave_sum(s); if (F.lane == 0) ssq[m] = ssq_fix(s); } }
}

typedef float f32p2 __attribute__((ext_vector_type(2)));
__device__ __forceinline__ void p_pooled(Frame& F, unsigned char* ws, int bx) {
    F.refresh();
    const bf16_t* Z = (const bf16_t*)(ws + R_Z); bf16_t* MIX = (bf16_t*)(ws + R_MIX);
    const bool tailwg = F.G == 256; if (tailwg && bx < 192) return;
    const int gw = (tailwg ? bx - 192 : F.vcu) * NWAVES + F.wave, NGW = (tailwg ? 64 : F.G) * NWAVES;
    const int w = 2 << (F.lane >> 4);
    for (int g = gw; g < NTOK / 8; g += NGW) { const int t0 = 8 * g, p0 = t0 & (SEQ - 1);
        u32x4 R[23];
#pragma unroll
        for (int k = 0; k < 23; ++k) { const int d = 15 - k; const bool inseq = p0 - d >= 0; const int dd = (inseq && d < w) ? d : 0;
            u32x4 v = *((const u32x4*)(Z + (size_t)(t0 - dd) * 1024) + F.lane); const unsigned mk = inseq ? 0xFFFFFFFFu : 0u;
            if (d > 0) { v.x &= mk; v.y &= mk; v.z &= mk; v.w &= mk; }
            R[k] = v; }
        float ic[8];
#pragma unroll
        for (int r = 0; r < 8; ++r) { const int cnt = (p0 + r + 1 < w) ? (p0 + r + 1) : w; ic[r] = fast_rcp((float)cnt); }
        u32x4 out[8];
#pragma unroll
        for (int c = 0; c < 4; ++c) { f32p2 a[23], self[8], res[8];
#pragma unroll
            for (int k = 0; k < 23; ++k) a[k] = (f32p2){bflo(R[k][c]), bfhi(R[k][c])};
#pragma unroll
            for (int r = 0; r < 8; ++r) self[r] = a[15 + r];
#pragma unroll
            for (int k = 22; k >= 1; --k) a[k] += a[k - 1];
#pragma unroll
            for (int r = 0; r < 8; ++r) res[r] = a[15 + r];
#pragma unroll
            for (int k = 22; k >= 3; --k) a[k] += a[k - 2];
#pragma unroll
            for (int r = 0; r < 8; ++r) res[r] = w >= 4 ? a[15 + r] : res[r];
#pragma unroll
            for (int k = 22; k >= 7; --k) a[k] += a[k - 4];
#pragma unroll
            for (int r = 0; r < 8; ++r) res[r] = w >= 8 ? a[15 + r] : res[r];
#pragma unroll
            for (int k = 22; k >= 15; --k) a[k] += a[k - 8];
#pragma unroll
            for (int r = 0; r < 8; ++r) { res[r] = w >= 16 ? a[15 + r] : res[r]; const f32p2 o = res[r] * ic[r] - self[r]; out[r][c] = cvt_pk_bf16(o.x, o.y); } }
#pragma unroll
        for (int r = 0; r < 8; ++r) *((u32x4*)(MIX + (size_t)(t0 + r) * 1024) + F.lane) = out[r]; }
}

__device__ __forceinline__ int crow(int r, int hi) { return (r & 3) + 8 * (r >> 2) + 4 * hi; }
__device__ __forceinline__ s16x4 vtr(const LAS unsigned char* p) { return __builtin_bit_cast(s16x4, __builtin_amdgcn_ds_read_tr16_b64_v4i16((LAS s16x4*)p)); }

template <int DQK, bool BAND>
__device__ __forceinline__ void attn_unit(const bf16_t* __restrict__ Qp, int ldq, const bf16_t* __restrict__ Kp, int ldk, const bf16_t* __restrict__ Vp, int ldv,
                                          bf16_t* Op, int ldo, int b, int qb, LAS unsigned char* lds, const float* bias_g) {
    constexpr int KSTR = (DQK + 8) * 2, KBUF = 64 * KSTR, VBUF = 8192, KCH = DQK / 8, NKS = DQK / 16;
    const int tid = opaque_tid(), lane = tid & 63, wave = __builtin_amdgcn_readfirstlane(tid >> 6), r32 = lane & 31, hi = lane >> 5;
    LAS unsigned char* Kl = lds; LAS unsigned char* Vl = lds + 2 * KBUF;
    LAS float* sc = (LAS float*)(lds + 2 * KBUF + 2 * VBUF) + wave * 32;
    LAS float* biasL = (LAS float*)(lds + 2 * KBUF + 2 * VBUF + 1024);
    const int chunkw = 4 * qb + (wave >> 1), t1 = 4 * qb + 3, t0 = BAND ? ((4 * qb - 8) > 0 ? (4 * qb - 8) : 0) : 0;
    const size_t rowb = (size_t)b * SEQ;
    if (BAND) { if (tid < 257) biasL[tid] = bias_g[tid] * LOG2E; }
    if (wave < 4) __builtin_amdgcn_s_setprio(2);
    bf16x8 qf[NKS];
    { const bf16_t* qrow = Qp + (rowb + 256 * qb + 32 * wave + r32) * ldq + 8 * hi;
#pragma unroll
      for (int ks = 0; ks < NKS; ++ks) qf[ks] = *(const bf16x8*)(qrow + 16 * ks); }
    const int kkey0 = tid / KCH, kch0 = tid % KCH; const int idx1 = tid + 512; const bool has1 = idx1 < 64 * KCH; const int kkey1 = has1 ? idx1 / KCH : 0, kch1 = has1 ? idx1 % KCH : 0;
    const int vkey = tid >> 3, vch = tid & 7;
    const bf16_t* kg0 = Kp + (rowb + kkey0) * ldk + 8 * kch0; const bf16_t* kg1 = Kp + (rowb + kkey1) * ldk + 8 * kch1; const bf16_t* vg = Vp + (rowb + vkey) * ldv + 8 * vch;
    const int kl0 = kkey0 * KSTR + kch0 * 16, kl1 = kkey1 * KSTR + kch1 * 16, vl = (vch >> 2) * 4096 + vkey * 64 + (vch & 3) * 16;
    u32x4 st[2][3];
#pragma unroll
    for (int q = 0; q < 2; ++q) { st[q][0] = (u32x4){0u, 0u, 0u, 0u}; st[q][1] = (u32x4){0u, 0u, 0u, 0u}; st[q][2] = (u32x4){0u, 0u, 0u, 0u}; }
#define ATT_LOAD(set, tt) do { const size_t to_ = (size_t)(tt) * 64; st[set][0] = *(const u32x4*)(kg0 + to_ * ldk); if (has1) st[set][1] = *(const u32x4*)(kg1 + to_ * ldk); st[set][2] = *(const u32x4*)(vg + to_ * ldv); } while (0)
#define ATT_WRITE(set, buf) do { *(LAS u32x4*)(Kl + (buf) * KBUF + kl0) = st[set][0]; if (has1) *(LAS u32x4*)(Kl + (buf) * KBUF + kl1) = st[set][1]; *(LAS u32x4*)(Vl + (buf) * VBUF + vl) = st[set][2]; } while (0)
    ATT_LOAD(0, t0); ATT_WRITE(0, 0);
    if (t0 + 1 <= t1) ATT_LOAD(1, t0 + 1);
    __syncthreads();
    float m_run = 0.f; f32x16 o0 = {}, o1 = {}, lacc = {}, negm = {}; bool first = true;
    const bf16x8 ones8 = (bf16x8){0x3F80, 0x3F80, 0x3F80, 0x3F80, 0x3F80, 0x3F80, 0x3F80, 0x3F80};
    const int vtoff = (16 * ((lane >> 4) & 1) + 4 * (lane & 3)) * 2 + (4 * hi + ((lane & 15) >> 2)) * 64;
    for (int tb = t0; tb <= t1; tb += 2) {
#pragma unroll
      for (int ph = 0; ph < 2; ++ph) {
        const int t = tb + ph; if (t > t1) break;
        const int cur = (t - t0) & 1; const bool more = t < t1;
        if (t + 2 <= t1) ATT_LOAD(ph, t + 2);
        const bool active = BAND ? (t <= chunkw && t >= chunkw - 8) : (t <= chunkw);
        if (active) {
            const LAS unsigned char* Ks = Kl + cur * KBUF; const LAS unsigned char* Vs = Vl + cur * VBUF;
            f32x16 s0, s1;
#pragma unroll
            for (int ks = 0; ks < NKS; ++ks) {
                const bf16x8 k0 = *(const LAS bf16x8*)(Ks + r32 * KSTR + ks * 32 + hi * 16);
                const bf16x8 k1 = *(const LAS bf16x8*)(Ks + (32 + r32) * KSTR + ks * 32 + hi * 16);
                s0 = __builtin_amdgcn_mfma_f32_32x32x16_bf16(k0, qf[ks], ks == 0 ? negm : s0, 0, 0, 0);
                s1 = __builtin_amdgcn_mfma_f32_32x32x16_bf16(k1, qf[ks], ks == 0 ? negm : s1, 0, 0, 0);
            }
            if (BAND) {
                if (t <= chunkw - 3) { const float cb = biasL[256];
#pragma unroll
                    for (int r = 0; r < 16; ++r) { s0[r] += cb; s1[r] += cb; } }
                else { const int qpos = 256 * qb + 32 * wave + r32, kb0 = 64 * t;
#pragma unroll
                    for (int r = 0; r < 16; ++r) { const int rel = qpos - (kb0 + crow(r, hi)); int i0 = rel < -128 ? -128 : (rel > 128 ? 128 : rel); int rel1 = rel - 32; int i1 = rel1 < -128 ? -128 : (rel1 > 128 ? 128 : rel1);
                        s0[r] += biasL[i0 + 128]; s1[r] += biasL[i1 + 128]; } }
            }
            float mx = s0[0];
#pragma unroll
            for (int r = 1; r < 16; ++r) mx = fmaxf(mx, s0[r]);
#pragma unroll
            for (int r = 0; r < 16; ++r) mx = fmaxf(mx, s1[r]);
            { const auto rr_ = __builtin_amdgcn_permlane32_swap(__float_as_uint(mx), __float_as_uint(mx), false, false); mx = fmaxf(__uint_as_float(rr_[0]), __uint_as_float(rr_[1])); }
            if (first || __any(mx > 8.0f)) {
                const float dl = first ? mx : fmaxf(mx, 0.f); m_run += dl;
#pragma unroll
                for (int r = 0; r < 16; ++r) { s0[r] -= dl; s1[r] -= dl; }
                const float alpha = first ? 1.0f : fast_exp2(-dl);
#pragma unroll
                for (int r = 0; r < 16; ++r) negm[r] = -m_run;
                if (hi == 0) sc[r32] = alpha;
                LDS_WAIT();
#pragma unroll
                for (int r = 0; r < 16; ++r) { const float a = sc[crow(r, hi)]; o0[r] *= a; o1[r] *= a; lacc[r] *= a; }
                LDS_WAIT();
                first = false;
            }
#pragma unroll
            for (int r = 0; r < 16; ++r) { s0[r] = fast_exp2(s0[r]); s1[r] = fast_exp2(s1[r]); }
#pragma unroll
            for (int hf = 0; hf < 2; ++hf)
#pragma unroll
                for (int s2 = 0; s2 < 2; ++s2) {
                    u32x4 pw;
                    if (hf == 0) { pw.x = cvt_pk_bf16(s0[8 * s2 + 0], s0[8 * s2 + 1]); pw.y = cvt_pk_bf16(s0[8 * s2 + 2], s0[8 * s2 + 3]); pw.z = cvt_pk_bf16(s0[8 * s2 + 4], s0[8 * s2 + 5]); pw.w = cvt_pk_bf16(s0[8 * s2 + 6], s0[8 * s2 + 7]); }
                    else         { pw.x = cvt_pk_bf16(s1[8 * s2 + 0], s1[8 * s2 + 1]); pw.y = cvt_pk_bf16(s1[8 * s2 + 2], s1[8 * s2 + 3]); pw.z = cvt_pk_bf16(s1[8 * s2 + 4], s1[8 * s2 + 5]); pw.w = cvt_pk_bf16(s1[8 * s2 + 6], s1[8 * s2 + 7]); }
                    const bf16x8 pa = __builtin_bit_cast(bf16x8, pw);
                    lacc = __builtin_amdgcn_mfma_f32_32x32x16_bf16(pa, ones8, lacc, 0, 0, 0);
                    const LAS unsigned char* vb = Vs + (32 * hf + 16 * s2) * 64 + vtoff;
#pragma unroll
                    for (int dh = 0; dh < 2; ++dh) {
                        const s16x4 lo = vtr(vb + dh * 4096), hh = vtr(vb + dh * 4096 + 8 * 64);
                        const bf16x8 vf = (bf16x8){lo[0], lo[1], lo[2], lo[3], hh[0], hh[1], hh[2], hh[3]};
                        if (dh == 0) o0 = __builtin_amdgcn_mfma_f32_32x32x16_bf16(pa, vf, o0, 0, 0, 0);
                        else         o1 = __builtin_amdgcn_mfma_f32_32x32x16_bf16(pa, vf, o1, 0, 0, 0);
                    }
                }
        }
        if (more) ATT_WRITE(ph ^ 1, cur ^ 1);
        __syncthreads();
      }
    }
#undef ATT_LOAD
#undef ATT_WRITE
    __builtin_amdgcn_s_setprio(0);
    { bf16_t* orow = Op + (rowb + 256 * qb + 32 * wave) * ldo + r32;
#pragma unroll
      for (int r = 0; r < 16; ++r) { const int q = crow(r, hi); const float inv = fast_rcp(lacc[r]);
          orow[(size_t)q * ldo] = f2bf(o0[r] * inv); orow[(size_t)q * ldo + 32] = f2bf(o1[r] * inv); } }
}

__device__ __forceinline__ void sgu_unit(const bf16_t* UV, const float* ng, const float* nb, const float* W, const float* bs, bf16_t* MIX, int b, int n, int g, LAS unsigned char* lds) {
    const int tid = opaque_tid(), lane = tid & 63, wave = __builtin_amdgcn_readfirstlane(tid >> 6), r32 = lane & 31, hi = lane >> 5;
    const size_t t0 = (size_t)b * SEQ + (size_t)n * 128;
    { const int s = tid >> 2, qd = tid & 3; const bf16_t* src = UV + (t0 + s) * 1024 + 512 + g * 128 + 32 * qd;
      float x[32];
#pragma unroll
      for (int j = 0; j < 4; ++j) { const u32x4 v = *((const u32x4*)src + j); x[8 * j + 0] = bflo(v.x); x[8 * j + 1] = bfhi(v.x); x[8 * j + 2] = bflo(v.y); x[8 * j + 3] = bfhi(v.y); x[8 * j + 4] = bflo(v.z); x[8 * j + 5] = bfhi(v.z); x[8 * j + 6] = bflo(v.w); x[8 * j + 7] = bfhi(v.w); }
      float sm = 0.f;
#pragma unroll
      for (int j = 0; j < 32; ++j) sm += x[j];
      sm += __shfl_xor(sm, 1); sm += __shfl_xor(sm, 2);
      const float mu = sm * (1.0f / 128.0f); float vs = 0.f;
#pragma unroll
      for (int j = 0; j < 32; ++j) { x[j] -= mu; vs += x[j] * x[j]; }
      vs += __shfl_xor(vs, 1); vs += __shfl_xor(vs, 2);
      const float rstd = rsqrtf(vs * (1.0f / 128.0f) + EPS);
      const float* gp = ng + g * 128 + 32 * qd; const float* bp = nb + g * 128 + 32 * qd;
#pragma unroll
      for (int j = 0; j < 4; ++j) { float y[8];
#pragma unroll
          for (int i = 0; i < 8; ++i) y[i] = x[8 * j + i] * rstd * gp[8 * j + i] + bp[8 * j + i];
          u32x4 w; w.x = cvt_pk_bf16(y[0], y[1]); w.y = cvt_pk_bf16(y[2], y[3]); w.z = cvt_pk_bf16(y[4], y[5]); w.w = cvt_pk_bf16(y[6], y[7]);
          *(LAS u32x4*)(lds + qd * 8192 + s * 64 + j * 16) = w; } }
    __syncthreads();
    { const int tb = wave >> 1, cb0 = 2 * (wave & 1), trow = 32 * tb + r32;
      f32x16 acc0 = {}, acc1 = {};
      const float* wrow = W + ((size_t)g * 128 + trow) * 128 + 8 * hi;
      const int vto = (8 * hi + ((lane & 15) >> 2)) * 64 + (16 * ((lane >> 4) & 1) + 4 * (lane & 3)) * 2;
      for (int ks = 0; ks < 2 * (tb + 1); ++ks) {
          const f32x4 w0 = *(const f32x4*)(wrow + 16 * ks), w1 = *(const f32x4*)(wrow + 16 * ks + 4);
          const int s0 = 16 * ks + 8 * hi; float a[8];
#pragma unroll
          for (int j = 0; j < 4; ++j) { a[j] = (s0 + j <= trow) ? w0[j] : 0.f; a[4 + j] = (s0 + 4 + j <= trow) ? w1[j] : 0.f; }
          u32x4 aw; aw.x = cvt_pk_bf16(a[0], a[1]); aw.y = cvt_pk_bf16(a[2], a[3]); aw.z = cvt_pk_bf16(a[4], a[5]); aw.w = cvt_pk_bf16(a[6], a[7]);
          const bf16x8 af = __builtin_bit_cast(bf16x8, aw);
          const LAS unsigned char* vb = lds + (16 * ks) * 64 + vto;
          { const s16x4 lo = vtr(vb + cb0 * 8192), hh = vtr(vb + cb0 * 8192 + 4 * 64); const bf16x8 bfr = (bf16x8){lo[0], lo[1], lo[2], lo[3], hh[0], hh[1], hh[2], hh[3]};
            acc0 = __builtin_amdgcn_mfma_f32_32x32x16_bf16(af, bfr, acc0, 0, 0, 0); }
          { const s16x4 lo = vtr(vb + (cb0 + 1) * 8192), hh = vtr(vb + (cb0 + 1) * 8192 + 4 * 64); const bf16x8 bfr = (bf16x8){lo[0], lo[1], lo[2], lo[3], hh[0], hh[1], hh[2], hh[3]};
            acc1 = __builtin_amdgcn_mfma_f32_32x32x16_bf16(af, bfr, acc1, 0, 0, 0); }
      }
#pragma unroll
      for (int r = 0; r < 16; ++r) { const int t = 32 * tb + crow(r, hi); const float bias = bs[g * 128 + t];
          const size_t ro = (t0 + t) * 1024 + g * 128 + 32 * cb0 + r32;
          const float u0 = bf2f(UV[ro]), u1 = bf2f(UV[ro + 32]);
          MIX[ro + 512] = f2bf(u0 * (acc0[r] + bias)); MIX[ro + 512 + 32] = f2bf(u1 * (acc1[r] + bias)); } }
    __syncthreads();
}

__device__ __forceinline__ void p_route(Frame& F, unsigned char* ws, const bf16_t* XBr, const u64* ssq, const float* gain, const float* router, unsigned* cnt) {
    F.refresh();
    LAS int* hist = (LAS int*)(F.lds + 32768);
    LAS int* gbase = (LAS int*)(F.lds + 32768 + 64);
    LAS int* pe = (LAS int*)(F.lds + 32768 + 128);
    LAS float* pwt = (LAS float*)(F.lds + 32768 + 128 + 1024);
    int* TE = (int*)(ws + T_TE); int* TP = (int*)(ws + T_TP); float* TW = (float*)(ws + T_TW); int* HG = (int*)(ws + T_HG);
    float rw[8][16];
#pragma unroll
    for (int j = 0; j < 4; ++j)
#pragma unroll
        for (int i = 0; i < 4; ++i) { const int k = 256 * j + 4 * F.lane + i; const float gk = gain[k]; const f32x4 a = *(const f32x4*)(router + k * 8), b = *(const f32x4*)(router + k * 8 + 4);
            rw[0][j * 4 + i] = a[0] * gk; rw[1][j * 4 + i] = a[1] * gk; rw[2][j * 4 + i] = a[2] * gk; rw[3][j * 4 + i] = a[3] * gk;
            rw[4][j * 4 + i] = b[0] * gk; rw[5][j * 4 + i] = b[1] * gk; rw[6][j * 4 + i] = b[2] * gk; rw[7][j * 4 + i] = b[3] * gk; }
    for (int blk = F.vcu; blk < NTOK / 64; blk += F.G) {
        __syncthreads();
        u32x2 xc[4], xn[4];
#pragma unroll
        for (int j = 0; j < 4; ++j) { xc[j] = *((const u32x2*)(XBr + (size_t)(blk * 64 + F.wave) * DM) + F.lane + 64 * j); xn[j] = xc[j]; }
        for (int r = F.wave; r < 64; r += NWAVES) { const int t = blk * 64 + r;
            if (r + NWAVES < 64) {
#pragma unroll
                for (int j = 0; j < 4; ++j) xn[j] = *((const u32x2*)(XBr + (size_t)(t + NWAVES) * DM) + F.lane + 64 * j); }
            float lg[8];
#pragma unroll
            for (int e = 0; e < 8; ++e) lg[e] = 0.f;
#pragma unroll
            for (int j = 0; j < 4; ++j) { const u32x2 v2 = xc[j]; const f32x4 v = (f32x4){bflo(v2.x), bfhi(v2.x), bflo(v2.y), bfhi(v2.y)};
#pragma unroll
                for (int e = 0; e < 8; ++e) lg[e] += (v[0] * rw[e][j * 4 + 0] + v[1] * rw[e][j * 4 + 1]) + (v[2] * rw[e][j * 4 + 2] + v[3] * rw[e][j * 4 + 3]); }
#pragma unroll
            for (int e = 0; e < 8; ++e) lg[e] = wave_sum(lg[e]);
            if (F.lane == 0) { const float rs = rstd_of(ssq, t);
                int e1 = 0; float v1 = lg[0];
#pragma unroll
                for (int e = 1; e < 8; ++e) if (lg[e] > v1) { v1 = lg[e]; e1 = e; }
                int e2 = -1; float v2 = -INFINITY;
#pragma unroll
                for (int e = 0; e < 8; ++e) if (e != e1 && lg[e] > v2) { v2 = lg[e]; e2 = e; }
                const float w1 = 1.0f / (1.0f + __expf((v2 - v1) * rs)), w2 = 1.0f - w1;
                pe[r * 4 + 0] = e1; pe[r * 4 + 1] = e2; pwt[r * 2 + 0] = w1; pwt[r * 2 + 1] = w2; }
#pragma unroll
            for (int j = 0; j < 4; ++j) xc[j] = xn[j]; }
        __syncthreads();
        if (F.wave == 0) {
            const int r = F.lane, t = blk * 64 + r; const int e1 = pe[r * 4 + 0], e2 = pe[r * 4 + 1]; int p1 = 0, p2 = 0;
            const unsigned long long below = (1ull << r) - 1ull;
#pragma unroll
            for (int e = 0; e < 8; ++e) { const unsigned long long m = __ballot(e1 == e || e2 == e); const int pos = __popcll(m & below);
                if (e1 == e) p1 = pos; if (e2 == e) p2 = pos; if (r == 0) HG[blk * 8 + e] = __popcll(m); }
            TE[t] = e1 | (e2 << 8); TP[2 * t] = p1; TP[2 * t + 1] = p2; TW[2 * t] = pwt[r * 2 + 0]; TW[2 * t + 1] = pwt[r * 2 + 1]; }
        __syncthreads();
    }
}
__device__ __forceinline__ void moe_offsets(const unsigned* cnt, int (&off)[9], int (&cn)[8]) {
    int a = 0;
#pragma unroll
    for (int e = 0; e < 8; ++e) { cn[e] = (int)__hip_atomic_load(cnt + e, RLX_AGENT); off[e] = a; a += (cn[e] + 255) & ~255; }
    off[8] = a;
}
__device__ __forceinline__ void p_gather(Frame& F, unsigned char* ws, const u64* ssq, unsigned* cnt) {
    F.refresh();
    const bf16_t* XB = (const bf16_t*)(ws + WS_XB); bf16_t* HS = (bf16_t*)(ws + R_HS);
    const int* TE = (const int*)(ws + T_TE); const int* TP = (const int*)(ws + T_TP); const float* TW = (const float*)(ws + T_TW); const int* HG = (const int*)(ws + T_HG);
    int* PAIR = (int*)(ws + T_PAIR); float* DGATE = (float*)(ws + T_DGATE); float* DRS = (float*)(ws + T_DRS);
    LAS int* arr = (LAS int*)F.lds; LAS int* bt = arr + 2048;
    const int gw = F.vcu * NWAVES + F.wave, NGW = F.G * NWAVES;
    int off[9], cn[8], bse[8];
#pragma unroll
    for (int e = 0; e < 8; ++e) { off[e] = 0; cn[e] = 0; bse[e] = 0; }
    off[8] = 0;
    for (int blk = F.vcu; blk < NTOK / 64; blk += F.G) {
        __syncthreads();
        { const u32x4 hv = *((const u32x4*)HG + F.tid); *((LAS u32x4*)arr + F.tid) = hv; }
        __syncthreads();
        if (F.wave == 0) {
            int h[4][8], tot[8], inc[8];
#pragma unroll
            for (int k = 0; k < 4; ++k) { const u32x4 a = *((const LAS u32x4*)arr + (4 * F.lane + k) * 2), b = *((const LAS u32x4*)arr + (4 * F.lane + k) * 2 + 1);
                h[k][0] = (int)a.x; h[k][1] = (int)a.y; h[k][2] = (int)a.z; h[k][3] = (int)a.w; h[k][4] = (int)b.x; h[k][5] = (int)b.y; h[k][6] = (int)b.z; h[k][7] = (int)b.w; }
#pragma unroll
            for (int e = 0; e < 8; ++e) { tot[e] = (h[0][e] + h[1][e]) + (h[2][e] + h[3][e]); inc[e] = tot[e]; }
#pragma unroll
            for (int d = 1; d < 64; d <<= 1)
#pragma unroll
                for (int e = 0; e < 8; ++e) { const int v = __shfl_up(inc[e], d); inc[e] += (F.lane >= d) ? v : 0; }
            const int lb = blk >> 2, kb = blk & 3;
            if (F.lane == lb) {
#pragma unroll
                for (int e = 0; e < 8; ++e) { int bs = inc[e] - tot[e];
#pragma unroll
                    for (int k = 0; k < 3; ++k) bs += (k < kb) ? h[k][e] : 0;
                    bt[e] = bs; } }
            if (F.lane == 63) {
#pragma unroll
                for (int e = 0; e < 8; ++e) bt[8 + e] = inc[e]; } }
        __syncthreads();
        { int a = 0;
#pragma unroll
          for (int e = 0; e < 8; ++e) { bse[e] = bt[e]; cn[e] = bt[8 + e]; off[e] = a; a += (cn[e] + 255) & ~255; }
          off[8] = a; }
        if (blk == 0 && F.tid < 8) __hip_atomic_store(cnt + F.tid, (unsigned)bt[8 + F.tid], RLX_AGENT);
#define GT_LOAD(tt, TE_, TP0_, TP1_, TW0_, TW1_, SQ_, A0_, A1_) do { TE_ = TE[tt]; TP0_ = TP[2 * (tt)]; TP1_ = TP[2 * (tt) + 1]; TW0_ = TW[2 * (tt)]; TW1_ = TW[2 * (tt) + 1]; SQ_ = ssq[tt]; \
            A0_ = *((const u32x4*)(XB + (size_t)(tt) * DM) + 2 * F.lane); A1_ = *((const u32x4*)(XB + (size_t)(tt) * DM) + 2 * F.lane + 1); } while (0)
        int te, ten, tp0, tp0n, tp1, tp1n; float tw0, tw0n, tw1, tw1n; u64 sq, sqn; u32x4 a0, a0n, a1, a1n;
        GT_LOAD(blk * 64 + F.wave, te, tp0, tp1, tw0, tw1, sq, a0, a1);
        ten = te; tp0n = tp0; tp1n = tp1; tw0n = tw0; tw1n = tw1; sqn = sq; a0n = a0; a1n = a1;
        for (int r = F.wave; r < 64; r += NWAVES) { const int t = blk * 64 + r;
            if (r + NWAVES < 64) GT_LOAD(t + NWAVES, ten, tp0n, tp1n, tw0n, tw1n, sqn, a0n, a1n);
            const float rs = rstd_raw(sq);
#if MOE_F8
            u32x4 h8; h8.x = pk4_fp8(bflo(a0.x) * F8_HS, bfhi(a0.x) * F8_HS, bflo(a0.y) * F8_HS, bfhi(a0.y) * F8_HS); h8.y = pk4_fp8(bflo(a0.z) * F8_HS, bfhi(a0.z) * F8_HS, bflo(a0.w) * F8_HS, bfhi(a0.w) * F8_HS);
            h8.z = pk4_fp8(bflo(a1.x) * F8_HS, bfhi(a1.x) * F8_HS, bflo(a1.y) * F8_HS, bfhi(a1.y) * F8_HS); h8.w = pk4_fp8(bflo(a1.z) * F8_HS, bfhi(a1.z) * F8_HS, bflo(a1.w) * F8_HS, bfhi(a1.w) * F8_HS);
#endif
#pragma unroll
            for (int k = 0; k < 2; ++k) { const int e = (te >> (8 * k)) & 255; int o = 0;
#pragma unroll
                for (int q = 0; q < 8; ++q) o = (q == e) ? off[q] + bse[q] : o;
                const int dest = o + (k == 0 ? tp0 : tp1);
#if MOE_F8
                *((u32x4*)((unsigned char*)HS + (size_t)dest * DM) + F.lane) = h8;
#else
                *((u32x4*)(HS + (size_t)dest * DM) + 2 * F.lane) = a0; *((u32x4*)(HS + (size_t)dest * DM) + 2 * F.lane + 1) = a1;
#endif
                if (F.lane == 0) { PAIR[2 * t + k] = dest; DGATE[dest] = (k == 0 ? tw0 : tw1); DRS[dest] = rs; } }
            te = ten; tp0 = tp0n; tp1 = tp1n; tw0 = tw0n; tw1 = tw1n; sq = sqn; a0 = a0n; a1 = a1n; }
#undef GT_LOAD
    }
#pragma unroll
    for (int e = 0; e < 8; ++e) { const int lo = off[e] + cn[e], hi = off[e + 1];
        for (int r = lo + gw; r < hi; r += NGW) {
#if MOE_F8
            *((u32x4*)((unsigned char*)HS + (size_t)r * DM) + F.lane) = zero4();
#else
            *((u32x4*)(HS + (size_t)r * DM) + F.lane) = zero4(); *((u32x4*)(HS + (size_t)r * DM) + 64 + F.lane) = zero4();
#endif
            if (F.lane == 0) { DGATE[r] = 0.f; DRS[r] = 0.f; } } }
}
__device__ __forceinline__ void p_combine(Frame& F, unsigned char* ws, float* X, u64* ssq_next, const float* fnorm, bool final_) {
    F.refresh();
    const bf16_t* Y = (const bf16_t*)(ws + R_Y); const bf16_t* Yb = (const bf16_t*)(ws + R_Y1); bf16_t* XB = (bf16_t*)(ws + WS_XB); const int* PAIR = (const int*)(ws + T_PAIR);
    const int gw = F.vcu * NWAVES + F.wave, NGW = F.G * NWAVES;
#define CB_LOAD(tt, P1_, P2_, B_, A1_, A2_) do { const u32x2* xb_ = (const u32x2*)(XB + (size_t)(tt) * DM) + F.lane; \
        const u32x2* y1_ = (const u32x2*)(Y + (size_t)((MOE2_KSPLIT == 1 && (P1_) >= TAIL_M0 * 256) ? 0 : (P1_)) * DM) + F.lane; const u32x2* y2_ = (const u32x2*)(Y + (size_t)((MOE2_KSPLIT == 1 && (P2_) >= TAIL_M0 * 256) ? 0 : (P2_)) * DM) + F.lane; \
        _Pragma("unroll") for (int j = 0; j < 4; ++j) { B_[j] = xb_[64 * j]; A1_[j] = y1_[64 * j]; A2_[j] = y2_[64 * j]; } } while (0)
    u32x2 cb[4], c1[4], c2[4], nb[4], n1[4], n2[4];
#pragma unroll
    for (int j = 0; j < 4; ++j) { cb[j] = (u32x2){0u, 0u}; c1[j] = cb[j]; c2[j] = cb[j]; nb[j] = cb[j]; n1[j] = cb[j]; n2[j] = cb[j]; }
    int p1c = 0, p2c = 0, p1n = 0, p2n = 0;
    if (gw < NTOK) { p1c = PAIR[2 * gw]; p2c = PAIR[2 * gw + 1]; CB_LOAD(gw, p1c, p2c, cb, c1, c2); }
    if (gw + NGW < NTOK) { p1n = PAIR[2 * (gw + NGW)]; p2n = PAIR[2 * (gw + NGW) + 1]; }
    for (int t = gw; t < NTOK; t += NGW) { const int p1 = p1c, p2 = p2c; int p1nn = 0, p2nn = 0;
        if (t + NGW < NTOK) CB_LOAD(t + NGW, p1n, p2n, nb, n1, n2);
        if (t + 2 * NGW < NTOK) { p1nn = PAIR[2 * (t + 2 * NGW)]; p2nn = PAIR[2 * (t + 2 * NGW) + 1]; }
        f32x4* xr = (f32x4*)(X + (size_t)t * DM) + F.lane;
        f32x4 v[4]; float s = 0.f;
        const bool tail1 = MOE2_KSPLIT == 1 && p1 >= TAIL_M0 * 256, tail2 = MOE2_KSPLIT == 1 && p2 >= TAIL_M0 * 256;
        if (MOE2_KSPLIT == 1 && !tail1 && !tail2) {
#pragma unroll
            for (int j = 0; j < 4; ++j) { v[j][0] = (bflo(cb[j].x) + bflo(c1[j].x)) + bflo(c2[j].x); v[j][1] = (bfhi(cb[j].x) + bfhi(c1[j].x)) + bfhi(c2[j].x);
                v[j][2] = (bflo(cb[j].y) + bflo(c1[j].y)) + bflo(c2[j].y); v[j][3] = (bfhi(cb[j].y) + bfhi(c1[j].y)) + bfhi(c2[j].y); }
        } else {
#pragma unroll
        for (int j = 0; j < 4; ++j) { const u32x2 b2 = cb[j]; v[j] = (f32x4){bflo(b2.x), bfhi(b2.x), bflo(b2.y), bfhi(b2.y)}; }
#pragma unroll
        for (int k = 0; k < 2; ++k) { const int p = k == 0 ? p1 : p2;
            if (MOE2_KSPLIT == 1 && p >= TAIL_M0 * 256) {
                for (int ks = 0; ks < TAIL_KS; ++ks) { const u32x2* yp = (const u32x2*)(Yb + ((size_t)ks * TAIL_ROWS + (size_t)(p - TAIL_M0 * 256)) * DM) + F.lane;
#pragma unroll
                    for (int j = 0; j < 4; ++j) { const u32x2 a = yp[64 * j]; v[j][0] += bflo(a.x); v[j][1] += bfhi(a.x); v[j][2] += bflo(a.y); v[j][3] += bfhi(a.y); } }
            } else {
#pragma unroll
                for (int j = 0; j < 4; ++j) { const u32x2 a = k == 0 ? c1[j] : c2[j]; v[j][0] += bflo(a.x); v[j][1] += bfhi(a.x); v[j][2] += bflo(a.y); v[j][3] += bfhi(a.y); }
                if (MOE2_KSPLIT == 2) { const u32x2* y3 = (const u32x2*)(Yb + (size_t)p * DM) + F.lane;
#pragma unroll
                    for (int j = 0; j < 4; ++j) { const u32x2 a = y3[64 * j]; v[j][0] += bflo(a.x); v[j][1] += bfhi(a.x); v[j][2] += bflo(a.y); v[j][3] += bfhi(a.y); } } } }
        }
#pragma unroll
        for (int j = 0; j < 4; ++j) s += (v[j][0] * v[j][0] + v[j][1] * v[j][1]) + (v[j][2] * v[j][2] + v[j][3] * v[j][3]);
        s = wave_sum(s);
        if (!final_) {
#pragma unroll
            for (int j = 0; j < 4; ++j) { u32x2 w; w.x = cvt_pk_bf16(v[j][0], v[j][1]); w.y = cvt_pk_bf16(v[j][2], v[j][3]); *((u32x2*)(XB + (size_t)t * DM) + F.lane + 64 * j) = w; }
            if (F.lane == 0) ssq_next[t] = ssq_fix(s);
        } else { float rs = rsqrtf(s * (1.0f / DM) + EPS);
#ifdef TPROBE
            rs *= 1.0f + __uint_as_float(__hip_atomic_load((const unsigned*)(ws + WS_CTL) + 32, RLX_AGENT));
#endif
#pragma unroll
            for (int j = 0; j < 4; ++j) { const f32x4 g = *((const f32x4*)fnorm + F.lane + 64 * j); xr[64 * j] = v[j] * rs * g; } }
#pragma unroll
        for (int j = 0; j < 4; ++j) { cb[j] = nb[j]; c1[j] = n1[j]; c2[j] = n2[j]; }
        p1c = p1n; p2c = p2n; p1n = p1nn; p2n = p2nn;
    }
}

#undef CB_LOAD
constexpr int NPH = 31;
struct Args { const float* in[28]; float* out; unsigned char* ws; int ph_lo, ph_hi; };
__global__ void __launch_bounds__(NWAVES * 64, 2) mk_fwd(Args args) {
    extern __shared__ __attribute__((aligned(16))) unsigned char lds_raw[];
    Frame F;
    F.lds = (LAS unsigned char*)lds_raw;
    F.refresh();
    F.G = gridDim.x; { const int bx = blockIdx.x; F.vcu = (F.G % 8 == 0) ? (bx % 8) * (F.G / 8) + bx / 8 : bx; }
    unsigned char* ws = args.ws;
    F.ctl = (unsigned*)(ws + WS_CTL);
    volatile LAS unsigned* MISC = (volatile LAS unsigned*)(F.lds + MISC_OFF);
    for (int u = F.tid; u < (LDS_BYTES - LDSCTL_OFF) / 4; u += NWAVES * 64) ((LAS unsigned*)(F.lds + LDSCTL_OFF))[u] = 0u;
    __syncthreads();
    const int lo = args.ph_lo, hi = args.ph_hi;
    XcdBarrier bar = xcd_barrier_post(F.ctl + CW_BAR + lo * XCD_BAR_WORDS, MISC + 8);
#ifndef PH_MASK
#define PH_MASK 0xFFFF
#endif
#define PT(t) (((PH_MASK) >> (t)) & 1)
#ifndef REP_MASK
#define REP_MASK 0
#endif
#define NREP(t) ((((REP_MASK) >> (t)) & 1) ? 2 : 1)
#define REPEAT(t) for (int rep_ = 0; rep_ < NREP(t); ++rep_, (rep_ < NREP(t) ? xcd_barrier(bar) : (void)0))
#define IN(k) (lo <= (k) && (k) < hi)
#define SEAM(k) do { if ((k) + 1 < hi) xcd_barrier(bar); } while (0)
    const float* const* in = args.in;
    float* X = args.out;
    u64* SSQ = (u64*)(ws + WS_SSQ);
    bf16_t* XB = (bf16_t*)(ws + WS_XB);
    const int bx = (int)blockIdx.x;

    if (PT(0) && IN(0)) { asm volatile("; PHASE_MARK 0"); REPEAT(0) p0_prologue(F, in, ws); SEAM(0); }

    for (int lp = 0; lp < 2; ++lp) {
        const int pb = 1 + 15 * lp;
        bf16_t* WE = (bf16_t*)(ws + WS_WE) + (size_t)lp * E_SIZE; bf16_t* WO = (bf16_t*)(ws + WS_WO) + (size_t)lp * O_SIZE;
        u64* ssq0 = SSQ + (size_t)(4 * lp) * NTOK;
        u64* ssql = (u64*)(ws + WS_SSQL) + (size_t)(2 * lp) * NTOK;
        if (PT(1) && IN(pb + 0)) { asm volatile("; PHASE_MARK 1");
            pg8::DenseOrder S; S.init(XB, DM, WE + E_WIN, DM, NTOK, 1024, F.G, bx);
            pg8::EpiZ E{(bf16_t*)(ws + R_Z), 1024, ssq0, ssql, ssql + NTOK, (bf16_t*)(ws + R_K), (const float*)(ws + T_COS), (const float*)(ws + T_SIN)};
            REPEAT(1) pg8::GEMM_BF16(F.lds, pg8::Gemm{DM, DM, DM, 0, 0}, S, E);
            SEAM(pb + 0);
        }
        if (PT(2) && IN(pb + 1)) { asm volatile("; PHASE_MARK 2"); REPEAT(2) p_pooled(F, ws, bx); }
        if (PT(3) && IN(pb + 2)) { asm volatile("; PHASE_MARK 3");
            REPEAT(3) {
            { pg8::DenseOrder S; S.init((const bf16_t*)(ws + R_Z) + 512, 1024, WE + E_WQ, 256, NTOK, 768, F.G, bx);
              pg8::EpiQ E{(bf16_t*)(ws + R_Q), ssql, (const float*)(ws + T_COS), (const float*)(ws + T_SIN)};
              pg8::GEMM_BF16(F.lds, pg8::Gemm{1024, 256, 256, 0, 0}, S, E); }
            { pg8::DenseOrder S; S.init((const bf16_t*)(ws + R_Z) + 768, 1024, WE + E_WKV, 256, NTOK, 1024, F.G, bx);
              pg8::EpiKV E{(bf16_t*)(ws + R_K), (bf16_t*)(ws + R_V), ssql + NTOK};
              pg8::GEMM_BF16(F.lds, pg8::Gemm{1024, 256, 128, 0, 0}, S, E); }
            }
            SEAM(pb + 2);
        }
        if (PT(4) && IN(pb + 3)) { asm volatile("; PHASE_MARK 4");
            const bf16_t* Q = (const bf16_t*)(ws + R_Q); const bf16_t* Kb = (const bf16_t*)(ws + R_K); const bf16_t* Vb = (const bf16_t*)(ws + R_V); bf16_t* MIX = (bf16_t*)(ws + R_MIX);
            int pi0 = F.vcu; asm volatile("" : "+s"(pi0));
            REPEAT(4)
            for (int pi = pi0; pi < 256; pi += F.G) { const int bh = pi >> 3, s = pi & 7, b = bh >> 3, h = bh & 7;
#pragma unroll 1
                for (int k = 0; k < 2; ++k) { const int qb = k == 0 ? (15 - s) : s;
                    attn_unit<96, false>(Q + 96 * h, 768, Kb + 96 * h, 768, Vb + 64 * h, 512, MIX + 512 + 64 * h, 1024, b, qb, F.lds, nullptr); } }
            SEAM(pb + 3);
        }
        if (PT(5) && IN(pb + 4)) { asm volatile("; PHASE_MARK 5");
            pg8::DenseOrder S; S.init((const bf16_t*)(ws + R_MIX), 1024, WE + E_WOUT, 1024, NTOK, 1024, F.G, bx);
            pg8::EpiRes E{lp == 0 ? in[0] : nullptr, XB, ssq0 + NTOK, FFN1_F8 ? (unsigned char*)(ws + WS_XB8) : nullptr};
            pg8::GEMM_BF16(F.lds, pg8::Gemm{1024, 1024, 1024, 0, 0}, S, E);
            SEAM(pb + 4);
        }
        if (PT(6) && IN(pb + 5)) { asm volatile("; PHASE_MARK 6");
            pg8::EpiSwiGLU<0> E{(bf16_t*)(ws + R_ACT), FF, ssq0 + NTOK};
#if FFN1_F8
            pg8::DenseOrder S; S.init(ws + WS_XB8, DM, WE + E_WGU, DM, NTOK, 2 * FF, F.G, bx); S.esz = 1;
            REPEAT(6) pg8::gemm_phase<pg8::EpiSwiGLU<0>, pg8::DenseOrder, true, true>(F.lds, pg8::Gemm{DM, DM, DM, SC_HS, SC_W}, S, E);
#else
            pg8::DenseOrder S; S.init(XB, DM, WE + E_WGU, DM, NTOK, 2 * FF, F.G, bx);
            REPEAT(6) pg8::GEMM_BF16(F.lds, pg8::Gemm{DM, DM, DM, 0, 0}, S, E);
#endif
            SEAM(pb + 5);
        }
        if (PT(7) && IN(pb + 6)) { asm volatile("; PHASE_MARK 7");
            pg8::DenseOrder S; S.init((const bf16_t*)(ws + R_ACT), FF, WE + E_WDN, FF, NTOK, 1024, F.G, bx);
            pg8::EpiRes E{nullptr, XB, ssq0 + 2 * NTOK, nullptr};
            pg8::GEMM_BF16(F.lds, pg8::Gemm{FF, FF, FF, 0, 0}, S, E);
            SEAM(pb + 6);
        }
        if (PT(8) && IN(pb + 7)) { asm volatile("; PHASE_MARK 8");
            pg8::DenseOrder S; S.init(XB, DM, WO + O_WIN, DM, NTOK, 2560, F.G, bx);
            pg8::EpiOddIn E{(bf16_t*)(ws + R_QKV), (bf16_t*)(ws + R_UV), ssq0 + 2 * NTOK};
            REPEAT(8) pg8::GEMM_BF16(F.lds, pg8::Gemm{DM, DM, DM, 0, 0}, S, E);
            SEAM(pb + 7);
        }
        if (PT(9) && IN(pb + 8)) { asm volatile("; PHASE_MARK 9");
            const bf16_t* QKV = (const bf16_t*)(ws + R_QKV); const bf16_t* UV = (const bf16_t*)(ws + R_UV); bf16_t* MIX = (bf16_t*)(ws + R_MIX);
            const float* rb = in[16] + (size_t)lp * 8 * 257;
            int u0 = F.vcu; asm volatile("" : "+s"(u0));
            REPEAT(9)
            for (int u = u0; u < 512; u += F.G) { const int bh = u >> 4, qb = u & 15, b = bh >> 3, h = bh & 7;
                attn_unit<64, true>(QKV + 64 * h, 1536, QKV + 512 + 64 * h, 1536, QKV + 1024 + 64 * h, 1536, MIX + 64 * h, 1024, b, qb, F.lds, rb + h * 257); }
            REPEAT(10)
            for (int u = u0; u < 512; u += F.G) { const int g = u & 3, n = (u >> 2) & 31, b = u >> 7;
                sgu_unit(UV, in[17] + (size_t)lp * 512, in[18] + (size_t)lp * 512, in[19] + (size_t)lp * 4 * 128 * 128, in[20] + (size_t)lp * 512, MIX, b, n, g, F.lds); }
            SEAM(pb + 8);
        }
        if (PT(10) && IN(pb + 9)) { asm volatile("; PHASE_MARK 10");
            pg8::DenseOrder S; S.init((const bf16_t*)(ws + R_MIX), 1024, WO + O_WOUT, 1024, NTOK, 1024, F.G, bx);
            pg8::EpiRes E{nullptr, XB, ssq0 + 3 * NTOK, nullptr};
            pg8::GEMM_BF16(F.lds, pg8::Gemm{1024, 1024, 1024, 0, 0}, S, E);
            SEAM(pb + 9);
        }
        unsigned* cnt = F.ctl + CW_CNT + 64 * lp;
        if (PT(11) && IN(pb + 10)) { asm volatile("; PHASE_MARK 11"); p_route(F, ws, XB, ssq0 + 3 * NTOK, in[22] + (size_t)lp * 1024, in[23] + (size_t)lp * 8192, cnt); SEAM(pb + 10); }
        if (PT(12) && IN(pb + 11)) { asm volatile("; PHASE_MARK 12"); REPEAT(12) p_gather(F, ws, ssq0 + 3 * NTOK, cnt); SEAM(pb + 11); }
        if (PT(13) && IN(pb + 12)) { asm volatile("; PHASE_MARK 13");
            int off[9], cn[8]; moe_offsets(cnt, off, cn);
            pg8::MoeOrder S; S.A = (const char*)(ws + R_HS); S.Bt = (const char*)(WO + O_WGU); S.esz = MOE_F8 ? 1 : 2; S.bstride = (size_t)2 * EFF * 1024 * S.esz; S.lda = 1024; S.ldb = 1024; S.nM = off[8] >> 8; S.nN = 2 * EFF / 256; S.G = F.G; S.c = bx; asm volatile("" : "+s"(S.c)); S.ksplit = 1; S.khalf = 0; S.tailM0 = 1 << 20; S.tail_ks = 1; S.tail_kb = 256;
#pragma unroll
            for (int e = 0; e < 8; ++e) S.tend[e] = off[e + 1] >> 8;
            pg8::EpiSwiGLU<MOE_F8 ? 2 : 1> E{(bf16_t*)(ws + R_ACT2), EFF, (const float*)(ws + T_DRS)};
            REPEAT(13) pg8::gemm_phase<pg8::EpiSwiGLU<MOE_F8 ? 2 : 1>, pg8::MoeOrder, true, MOE_F8 != 0>(F.lds, pg8::Gemm{1024, 1024, 1024, SC_HS, SC_W, lp == 0 ? (float*)(F.ctl + 32) : nullptr}, S, E);
            SEAM(pb + 12);
        }
        if (PT(14) && IN(pb + 13)) { asm volatile("; PHASE_MARK 14");
            int off[9], cn[8]; moe_offsets(cnt, off, cn);
            pg8::MoeOrder S; S.A = (const char*)(ws + R_ACT2); S.Bt = (const char*)(WO + O_WDN); S.esz = MOE_F8 ? 1 : 2; S.bstride = (size_t)1024 * EFF * S.esz; S.lda = EFF; S.ldb = EFF; S.nM = off[8] >> 8; S.nN = 4; S.G = F.G; S.c = bx; asm volatile("" : "+s"(S.c)); S.ksplit = MOE2_KSPLIT; S.khalf = (EFF / 2) * S.esz; S.tailM0 = MOE2_KSPLIT == 1 ? TAIL_M0 : (1 << 20); S.tail_ks = TAIL_KS; S.tail_kb = EFF * S.esz / TAIL_KS;
#pragma unroll
            for (int e = 0; e < 8; ++e) S.tend[e] = off[e + 1] >> 8;
            pg8::EpiY E{(bf16_t*)(ws + R_Y), (const float*)(ws + T_DGATE), (size_t)(R_Y1 - R_Y) / 2, MOE2_KSPLIT == 1 ? (bf16_t*)(ws + R_Y1) : nullptr, TAIL_M0 * 256};
            REPEAT(14) pg8::gemm_phase<pg8::EpiY, pg8::MoeOrder, true, MOE_F8 != 0>(F.lds, pg8::Gemm{EFF, EFF, EFF / MOE2_KSPLIT, SC_ACT, SC_W}, S, E);
            SEAM(pb + 13);
        }
        if (PT(15) && IN(pb + 14)) { asm volatile("; PHASE_MARK 15"); p_combine(F, ws, X, ssq0 + 4 * NTOK, in[27], lp == 1); SEAM(pb + 14); }
    }
#undef IN
#undef SEAM
}

extern "C" void kernel_launch(void* const* d_in, const int* in_sizes, int n_in, void* d_out, int out_size, void* d_ws, size_t ws_size, hipStream_t stream) {
    static int grid = 0;
    if (grid == 0) {
        if (n_in != 28 || in_sizes[0] != NTOK * DM || out_size != NTOK * DM || ws_size < WS_END) { fprintf(stderr, "kernel_launch: unexpected shapes / workspace (%d inputs, ws %zu, need %zu); nothing launched\n", n_in, ws_size, (size_t)WS_END); grid = -1; return; }
        int dev = 0, cus = 0, per_cu = 0;
        if (hipGetDevice(&dev) != hipSuccess || hipDeviceGetAttribute(&cus, hipDeviceAttributeMultiprocessorCount, dev) != hipSuccess) { grid = -1; return; }
        if (hipFuncSetAttribute((const void*)mk_fwd, hipFuncAttributeMaxDynamicSharedMemorySize, LDS_BYTES) != hipSuccess) { fprintf(stderr, "kernel_launch: hipFuncSetAttribute failed\n"); grid = -1; return; }
        if (hipOccupancyMaxActiveBlocksPerMultiprocessor(&per_cu, (const void*)mk_fwd, NWAVES * 64, LDS_BYTES) != hipSuccess || per_cu < 1) fprintf(stderr, "kernel_launch: occupancy query reports %d\n", per_cu);
        (void)hipGetLastError();
        grid = cus;
        if (grid > 256) grid = 256;
        grid &= ~7;
    }
    if (grid <= 0) return;
    if (hipMemsetAsync((char*)d_ws + WS_CTL, 0, CTL_ZERO_BYTES, stream) != hipSuccess) return;
    Args a{};
    for (int i = 0; i < 28; ++i) a.in[i] = (const float*)d_in[i];
    a.out = (float*)d_out; a.ws = (unsigned char*)d_ws;
#if MK_N_LAUNCHES == 1
    a.ph_lo = 0; a.ph_hi = NPH;
    hipLaunchKernelGGL(mk_fwd, dim3(grid), dim3(NWAVES * 64), LDS_BYTES, stream, a);
#else
    for (int p = 0; p < NPH; ++p) { a.ph_lo = p; a.ph_hi = p + 1; hipLaunchKernelGGL(mk_fwd, dim3(grid), dim3(NWAVES * 64), LDS_BYTES, stream, a); }
#endif
}
```
